# Optimizing an MI355X kernel written in HIP

```python
import math
import jax, jax.numpy as jnp
from jax import lax
import numpy as np

D_MODEL = 1024
BATCH = 32
SEQ = 2048
DEPTH = 1

CHUNK = 64
N_META = 16
Q_BLOCK = 128
HEAD_DIM = 64
H_SB = 8
H_DIFF = 4
D_SB = H_SB * HEAD_DIM
D_DIFF = H_DIFF * 2 * HEAD_DIM
D_MIX = D_SB + D_DIFF
D_IN = 3 * D_SB + 3 * D_DIFF
N_BUCKETS = 32
MAX_DISTANCE = 128
N_EXPERTS = 32
TOP_K = 4
D_FF = D_MODEL
SWIGLU_ALPHA = 1.702
SWIGLU_LIMIT = 7.0
EXPERT_BLOCK = 128
NORM_EPS = 1e-6
SUBLN_EPS = 1e-5
NEG_BIG = -1e30

kernel_name = "hymba_stickbreak_diffattn_gptoss_moe"


def rmsnorm(x, g, eps=NORM_EPS):
    xf = x.astype(jnp.float32)
    y = xf * lax.rsqrt(jnp.mean(xf * xf, axis=-1, keepdims=True) + eps)
    return (y * g.astype(jnp.float32)).astype(x.dtype)


def chunk_id(pos):
    return jnp.where(pos < N_META, 0, 1 + (pos - N_META) // CHUNK)


def chunk_end(p):
    return N_META if p < N_META else N_META + CHUNK * (1 + (p - N_META) // CHUNK)


def t5_bucket(rel):
    half = N_BUCKETS // 2
    max_exact = half // 2
    ret = jnp.where(rel > 0, half, 0)
    n = jnp.abs(rel)
    nf = jnp.maximum(n, 1).astype(jnp.float32)
    large = max_exact + (jnp.log(nf / max_exact) / math.log(MAX_DISTANCE / max_exact)
                         * (half - max_exact)).astype(jnp.int32)
    large = jnp.minimum(large, half - 1)
    return ret + jnp.where(n < max_exact, n, large)


def stick_breaking_attention(q, k, v):
    Lp = q.shape[1]
    scale = HEAD_DIM ** -0.5
    outs = []
    for start in range(0, Lp, Q_BLOCK):
        stop = start + Q_BLOCK
        z = jnp.einsum('bqhd,bkhd->bhqk', q[:, start:stop], k[:, :stop]).astype(jnp.float32) * scale
        qpos = start + jnp.arange(Q_BLOCK)
        kpos = jnp.arange(stop)
        earlier = kpos[None, :] < qpos[:, None]
        log_stay = jnp.where(earlier, jax.nn.log_sigmoid(-z), 0.0)
        between = lax.cumsum(log_stay, axis=3, reverse=True) - log_stay
        w = jnp.where(earlier, jnp.exp(jax.nn.log_sigmoid(z) + between), 0.0)
        outs.append(jnp.einsum('bhqk,bkhd->bqhd', w.astype(v.dtype), v[:, :stop]))
    return jnp.concatenate(outs, axis=1)


def differential_attention(q, k, v, rel_bias, lam, subln_gain, lambda_init):
    B_, Lp = q.shape[0], q.shape[1]
    scale = HEAD_DIM ** -0.5
    outs = []
    for start in range(0, Lp, Q_BLOCK):
        stop = start + Q_BLOCK
        kend = min(Lp, chunk_end(stop - 1))
        z = jnp.einsum('bqhd,bkhd->bhqk', q[:, start:stop], k[:, :kend]).astype(jnp.float32) * scale
        z = z.reshape(B_, H_DIFF, 2, Q_BLOCK, kend)
        qpos = start + jnp.arange(Q_BLOCK)
        kpos = jnp.arange(kend)
        bias = jnp.transpose(rel_bias[t5_bucket(kpos[None, :] - qpos[:, None])], (2, 0, 1))
        visible = chunk_id(kpos)[None, :] <= chunk_id(qpos)[:, None]
        z = jnp.where(visible, z + bias.astype(jnp.float32)[None, :, None], NEG_BIG)
        p = jax.nn.softmax(z, axis=-1)
        a = p[:, :, 0] - lam * p[:, :, 1]
        outs.append(jnp.einsum('bhqk,bkhe->bqhe', a.astype(v.dtype), v[:, :kend]))
    o = jnp.concatenate(outs, axis=1)
    return rmsnorm(o, subln_gain, SUBLN_EPS) * (1.0 - lambda_init)


def clamped_swiglu(hu):
    gate, lin = hu[..., :D_FF], hu[..., D_FF:]
    gate = jnp.minimum(gate, SWIGLU_LIMIT)
    lin = jnp.clip(lin, -SWIGLU_LIMIT, SWIGLU_LIMIT)
    return gate * jax.nn.sigmoid(SWIGLU_ALPHA * gate) * (lin + 1.0)


def moe(h, w_router, b_router, w1, b1, w2, b2):
    D_ = h.shape[-1]
    xf = h.reshape(-1, D_)
    T = xf.shape[0]
    logits = (xf @ w_router).astype(jnp.float32) + b_router.astype(jnp.float32)
    top_val, top_idx = lax.top_k(logits, TOP_K)
    gates = jax.nn.softmax(top_val, axis=-1)
    A = T * TOP_K
    flat_e = top_idx.reshape(-1)
    flat_tok = jnp.repeat(jnp.arange(T, dtype=jnp.int32), TOP_K)
    flat_g = gates.reshape(-1)
    order = jnp.argsort(flat_e)
    se, stok, sg = flat_e[order], flat_tok[order], flat_g[order]
    counts = jnp.bincount(flat_e, length=N_EXPERTS)
    starts = jnp.cumsum(counts) - counts
    padded = (counts + EXPERT_BLOCK - 1) // EXPERT_BLOCK * EXPERT_BLOCK
    pad_end = jnp.cumsum(padded)
    pad_start = pad_end - padded
    pos = pad_start[se] + jnp.arange(A) - starts[se]
    n_blocks = -(-A // EXPERT_BLOCK) + N_EXPERTS
    buf_tok = jnp.zeros((n_blocks * EXPERT_BLOCK,), jnp.int32).at[pos].set(stok)
    buf_g = jnp.zeros((n_blocks * EXPERT_BLOCK,), jnp.float32).at[pos].set(sg)
    blk_e = jnp.minimum(jnp.searchsorted(pad_end, jnp.arange(n_blocks) * EXPERT_BLOCK, side='right'),
                        N_EXPERTS - 1)

    def expert_block(args):
        tok, e = args
        xb = xf[tok]
        act = clamped_swiglu(xb @ w1[e] + b1[e])
        return act @ w2[e] + b2[e]

    y = lax.map(expert_block, (buf_tok.reshape(n_blocks, EXPERT_BLOCK), blk_e))
    y = y.reshape(-1, D_).astype(jnp.float32) * buf_g[:, None]
    out = jax.ops.segment_sum(y, buf_tok, num_segments=T)
    return out.astype(h.dtype).reshape(h.shape)


def setup_inputs(seed: int = 0) -> dict:
    key = jax.random.key(seed)
    ks = jax.random.split(key, 20)
    f32 = jnp.float32
    nrm = lambda k, shape, s: jax.random.normal(k, shape, f32) * s
    return {
        "x": nrm(ks[0], (BATCH, SEQ, D_MODEL), 1.0),
        "meta_tokens": nrm(ks[1], (N_META, D_MODEL), 1.0),
        "rel_bias": nrm(ks[2], (N_BUCKETS, H_DIFF), 0.3),
        "attn_norm": 1.0 + nrm(ks[3], (DEPTH, D_MODEL), 0.02),
        "w_in": nrm(ks[4], (DEPTH, D_MODEL, D_IN), D_MODEL ** -0.5),
        "w_out": nrm(ks[5], (DEPTH, D_MIX, D_MODEL), D_MIX ** -0.5),
        "lambda_q1": nrm(ks[6], (DEPTH, HEAD_DIM), 0.1),
        "lambda_k1": nrm(ks[7], (DEPTH, HEAD_DIM), 0.1),
        "lambda_q2": nrm(ks[8], (DEPTH, HEAD_DIM), 0.1),
        "lambda_k2": nrm(ks[9], (DEPTH, HEAD_DIM), 0.1),
        "subln_gain": 1.0 + nrm(ks[10], (DEPTH, 2 * HEAD_DIM), 0.02),
        "ffn_norm": 1.0 + nrm(ks[11], (DEPTH, D_MODEL), 0.02),
        "w_router": nrm(ks[12], (DEPTH, D_MODEL, N_EXPERTS), D_MODEL ** -0.5),
        "b_router": nrm(ks[13], (DEPTH, N_EXPERTS), 0.01),
        "w1": nrm(ks[14], (DEPTH, N_EXPERTS, D_MODEL, 2 * D_FF), D_MODEL ** -0.5),
        "b1": nrm(ks[15], (DEPTH, N_EXPERTS, 2 * D_FF), 0.01),
        "w2": nrm(ks[16], (DEPTH, N_EXPERTS, D_FF, D_MODEL), D_FF ** -0.5),
        "b2": nrm(ks[17], (DEPTH, N_EXPERTS, D_MODEL), 0.01),
        "final_norm": 1.0 + nrm(ks[18], (D_MODEL,), 0.02),
    }


def reference(x, meta_tokens, rel_bias, attn_norm, w_in, w_out, lambda_q1, lambda_k1,
              lambda_q2, lambda_k2, subln_gain, ffn_norm, w_router, b_router, w1, b1, w2, b2,
              final_norm):
    B_, S_ = x.shape[0], x.shape[1]
    meta = jnp.broadcast_to(meta_tokens[None].astype(x.dtype), (B_, N_META, D_MODEL))
    h = jnp.concatenate([meta, x], axis=1)
    L = S_ + N_META
    Lp = -(-L // Q_BLOCK) * Q_BLOCK
    split_at = [int(c) for c in np.cumsum([D_SB, D_SB, D_SB, D_DIFF, D_DIFF])]
    for layer in range(DEPTH):
        lambda_init = 0.8 - 0.6 * math.exp(-0.3 * layer)
        n = rmsnorm(h, attn_norm[layer])
        proj = jnp.pad(n @ w_in[layer], ((0, 0), (0, Lp - L), (0, 0)))
        sb_q, sb_k, sb_v, df_q, df_k, df_v = jnp.split(proj, split_at, axis=-1)
        sb_shape = (B_, Lp, H_SB, HEAD_DIM)
        o_sb = stick_breaking_attention(sb_q.reshape(sb_shape), sb_k.reshape(sb_shape),
                                        sb_v.reshape(sb_shape))
        lam = (jnp.exp(jnp.sum(lambda_q1[layer].astype(jnp.float32) * lambda_k1[layer].astype(jnp.float32)))
               - jnp.exp(jnp.sum(lambda_q2[layer].astype(jnp.float32) * lambda_k2[layer].astype(jnp.float32)))
               + lambda_init)
        o_df = differential_attention(df_q.reshape(B_, Lp, 2 * H_DIFF, HEAD_DIM),
                                      df_k.reshape(B_, Lp, 2 * H_DIFF, HEAD_DIM),
                                      df_v.reshape(B_, Lp, H_DIFF, 2 * HEAD_DIM),
                                      rel_bias, lam, subln_gain[layer], lambda_init)
        mix = jnp.concatenate([o_sb.reshape(B_, Lp, D_SB), o_df.reshape(B_, Lp, D_DIFF)], axis=-1)[:, :L]
        h = h + mix @ w_out[layer]
        h = h + moe(rmsnorm(h, ffn_norm[layer]), w_router[layer], b_router[layer],
                    w1[layer], b1[layer], w2[layer], b2[layer])
    h = rmsnorm(h, final_norm)
    return h[:, N_META:]
```

```cpp
#include <hip/hip_runtime.h>
#include <cstdio>
#include <cstdint>

#ifndef ONE_LAUNCH
#define ONE_LAUNCH 1
#endif
#ifndef REP_PHASE
#define REP_PHASE -1
#endif
#define REP_COUNT 3
#define NREP(k) ((REP_PHASE == (k)) ? REP_COUNT : 1)
#define REP_BEGIN(k) for (int rep_ = 0; rep_ < NREP(k); ++rep_) {
#define REP_END(k) if (rep_ + 1 < NREP(k)) GRID_BAR(); }
#ifndef NAIVE_SB
#define NAIVE_SB 0
#endif
#ifndef NAIVE_DF
#define NAIVE_DF 0
#endif

#define LAS __attribute__((address_space(3)))
#define GAS __attribute__((address_space(1)))
typedef unsigned short bf16_t;
typedef short bf16x8 __attribute__((ext_vector_type(8)));
typedef float f32x4 __attribute__((ext_vector_type(4)));
typedef float f32x2 __attribute__((ext_vector_type(2)));
typedef unsigned u32x4 __attribute__((ext_vector_type(4)));
typedef unsigned u32x2 __attribute__((ext_vector_type(2)));

constexpr int D = 1024, BATCH = 32, SEQ = 2048, T = BATCH * SEQ, NMETA = 16, DIN = 3072, NEXP = 32, TOPK = 4;
constexpr int COL_SBQ = 0, COL_SBK = 512, COL_SBV = 1024, COL_DFQ = 1536, COL_DFK = 2048, COL_DFV = 2560;
constexpr int MAXTILES = 1024 + 32, MAXSLOTS = 33;
constexpr float LOG2E = 1.4426950408889634f;
constexpr float C2 = 0.125f * LOG2E;
constexpr float NORM_EPS = 1e-6f, SUBLN_EPS = 1e-5f, LAMBDA_INIT = 0.2f;
constexpr int NWAVES = 8;

constexpr size_t MiB = 1u << 20;
constexpr size_t WS_CTL = 0, CTL_ZERO_BYTES = 32768;
constexpr size_t WS_WIN = 2 * MiB;
constexpr size_t WS_WOUT = 8 * MiB;
constexpr size_t WS_W1 = 10 * MiB;
constexpr size_t WS_W2 = 74 * MiB;
constexpr size_t WS_SMALL = 106 * MiB;
constexpr size_t WS_METAKV = WS_SMALL;
constexpr size_t WS_TOKE = WS_SMALL + 1 * MiB;
constexpr size_t WS_TOKG = WS_SMALL + 2 * MiB;
constexpr size_t WS_TOKLR = WS_SMALL + 3 * MiB;
constexpr size_t WS_CNT = WS_SMALL + 4 * MiB;
constexpr size_t WS_ROWTOK = WS_SMALL + 5 * MiB;
constexpr size_t WS_ROWSG = WS_SMALL + 7 * MiB;
constexpr size_t WS_TILEE = WS_SMALL + 10 * MiB;
constexpr size_t WS_DUMP = WS_SMALL + 11 * MiB;
constexpr size_t WS_ROWSS = WS_SMALL + 12 * MiB;
constexpr size_t WS_XN8 = 122 * MiB;
constexpr size_t WS_Y = 186 * MiB;
constexpr size_t WS_PROJ = WS_Y;
constexpr size_t WS_MIX = WS_Y + 384 * MiB;
constexpr size_t WS_H1 = 442 * MiB;
constexpr size_t WS_ACT = 698 * MiB;
constexpr size_t WS_XN = WS_ACT;
constexpr size_t WS_TMP = WS_ACT + 128 * MiB;
constexpr size_t WS_END = 962 * MiB;
constexpr int CW_BAR = 4096;

constexpr int RING_BYTES = 131072;
constexpr int GIDX_OFF = RING_BYTES;
constexpr int TE_OFF = GIDX_OFF + 16896;
constexpr int EXTRA_OFF = TE_OFF + 1088;
constexpr int MISC_OFF = EXTRA_OFF + 4096;
constexpr int LDS_BYTES = 155648;
static_assert(MISC_OFF + 128 <= LDS_BYTES, "LDS map");

#define LDS_WAIT() asm volatile("s_waitcnt lgkmcnt(0)" ::: "memory")
#define VM_WAIT() asm volatile("s_waitcnt vmcnt(0)" ::: "memory")
__device__ __forceinline__ unsigned f2bf(float f) { unsigned u = __builtin_bit_cast(unsigned, f); return (u + 0x7fffu + ((u >> 16) & 1u)) >> 16; }
__device__ __forceinline__ unsigned pk2(float lo, float hi) { return f2bf(lo) | (f2bf(hi) << 16); }
__device__ __forceinline__ float bf_lo(unsigned u) { return __builtin_bit_cast(float, u << 16); }
__device__ __forceinline__ float bf_hi(unsigned u) { return __builtin_bit_cast(float, u & 0xffff0000u); }
__device__ __forceinline__ unsigned cvt_pk_bf16(float lo, float hi) { unsigned r; asm volatile("v_cvt_pk_bf16_f32 %0, %1, %2" : "=v"(r) : "v"(lo), "v"(hi)); return r; }
__device__ __forceinline__ unsigned pk4_fp8(float a, float b, float c, float d) { int w = __builtin_amdgcn_cvt_pk_fp8_f32(a, b, 0, false); w = __builtin_amdgcn_cvt_pk_fp8_f32(c, d, w, true); return (unsigned)w; }
__device__ __forceinline__ float wave_sum(float v) {
#pragma unroll
    for (int o = 1; o < 64; o <<= 1) v += __shfl_xor(v, o);
    return v;
}

namespace pg8 {
constexpr int BM = 256, BK = 64, HALF = 128, HTB = HALF * BK * 2, STAGE_BYTES = 8 * HTB, NXCD = 8, WGM = 8, K = 1024, NT_K = K / BK;
__host__ __device__ __forceinline__ int lds_byte(int r, int c, int SH = 5) { const int st = (r >> 4) * 2 + (c >> 5), rr = r & 15, cc = c & 31, ob = rr * 64 + cc * 2; return st * 1024 + (ob ^ (((ob >> 9) & 1) << SH)); }
__host__ __device__ __forceinline__ void stage_rc(int b, int& R, int& C, int SH = 5) { const int st = b / 1024, sb = b % 1024, swz = sb ^ (((sb >> 9) & 1) << SH); R = (st >> 1) * 16 + swz / 64; C = (st & 1) * 32 + (swz % 64) / 2; }
__host__ __device__ __forceinline__ int perm32(int rho) { const int n = rho >> 4, i = rho & 15; return 8 * (i >> 2) + 4 * n + (i & 3); }

struct Unit { int pm, pn, e; };
struct Gemm { const void* A; const void* Bt; size_t estride; const LAS unsigned short* gidx; };

struct StaticOrder {
    int nM, nN, nwg, G, c;
    __device__ void init(int M, int N, int G_, int c_) { nM = M / BM; nN = N / BM; nwg = nM * nN; G = G_; c = c_; }
    __device__ bool next(int i, Unit& u) const {
        const long L = (long)i * G + c; if (L >= nwg) return false;
        int wgid = (int)L; { const int q = nwg / NXCD, r = nwg % NXCD, xcd = wgid % NXCD, off = wgid / NXCD; wgid = (xcd < r ? xcd * (q + 1) : r * (q + 1) + (xcd - r) * q) + off; }
        const int nig = WGM * nN, gid = wgid / nig, fm = gid * WGM, gsz = (nM - fm) < WGM ? (nM - fm) : WGM;
        u.pm = fm + ((wgid % nig) % gsz); u.pn = (wgid % nig) / gsz; u.e = 0; return true;
    }
};
struct GroupedOrder {
    int nM, nN, nwg, G, c, tile0; const LAS unsigned char* te;
    __device__ void init(int ntiles, int nN_, int G_, int c_, int tile0_, const LAS unsigned char* te_) { nM = ntiles; nN = nN_; nwg = nM * nN; G = G_; c = c_; tile0 = tile0_; te = te_; }
    __device__ bool next(int i, Unit& u) const {
        const long L = (long)i * G + c; if (L >= nwg) return false;
        int wgid = (int)L; { const int q = nwg / NXCD, r = nwg % NXCD, xcd = wgid % NXCD, off = wgid / NXCD; wgid = (xcd < r ? xcd * (q + 1) : r * (q + 1) + (xcd - r) * q) + off; }
        const int nig = WGM * nN, gid = wgid / nig, fm = gid * WGM, gsz = (nM - fm) < WGM ? (nM - fm) : WGM;
        u.pm = tile0 + fm + ((wgid % nig) % gsz); u.pn = (wgid % nig) / gsz; u.e = __builtin_amdgcn_readfirstlane((int)te[u.pm]); return true;
    }
};

struct EpiProj {
    static constexpr bool PERM = true;
    bf16_t* O;
    __device__ __forceinline__ void operator()(const f32x4 (&acc)[2][2][4][2], const Unit& u, int wr, int wc, int fr, int fq) const {
        const int row0 = u.pm * BM + wr * 64 + fr; const int col0 = u.pn * BM + wc * 32 + 8 * fq;
        const float sc = (u.pn < 2 || u.pn == 6 || u.pn == 7) ? C2 : 1.0f;
#pragma unroll
        for (int ai = 0; ai < 2; ++ai)
#pragma unroll
            for (int m = 0; m < 4; ++m) { bf16_t* rowp = O + (size_t)(row0 + ai * HALF + m * 16) * DIN + col0;
#pragma unroll
                for (int bj = 0; bj < 2; ++bj) { const f32x4 v0 = acc[ai][bj][m][0] * sc, v1 = acc[ai][bj][m][1] * sc;
                    u32x4 w; w.x = cvt_pk_bf16(v0[0], v0[1]); w.y = cvt_pk_bf16(v0[2], v0[3]); w.z = cvt_pk_bf16(v1[0], v1[1]); w.w = cvt_pk_bf16(v1[2], v1[3]);
                    *(u32x4*)(rowp + bj * HALF) = w; } }
    }
};
struct EpiRes {
    static constexpr bool PERM = false;
    const float* base; bf16_t* out; float* rowss;
    __device__ __forceinline__ void operator()(const f32x4 (&acc)[2][2][4][2], const Unit& u, int wr, int wc, int fr, int fq) const {
        const int col0 = u.pn * BM + wc * 32 + 4 * fq;
#pragma unroll
        for (int ai = 0; ai < 2; ++ai)
#pragma unroll
            for (int m = 0; m < 4; ++m) { const int row = u.pm * BM + ai * HALF + wr * 64 + m * 16 + fr; const size_t off = (size_t)row * D + col0; float ss = 0.f;
#pragma unroll
                for (int bj = 0; bj < 2; ++bj)
#pragma unroll
                    for (int n = 0; n < 2; ++n) { const f32x4 bs = *(const f32x4*)(base + off + bj * HALF + n * 16); const f32x4 v = bs + acc[ai][bj][m][n];
                        u32x2 w; w.x = cvt_pk_bf16(v[0], v[1]); w.y = cvt_pk_bf16(v[2], v[3]); *(u32x2*)(out + off + bj * HALF + n * 16) = w;
                        ss += (v[0] * v[0] + v[1] * v[1]) + (v[2] * v[2] + v[3] * v[3]); }
                ss += __shfl_xor(ss, 16); ss += __shfl_xor(ss, 32);
                if (fq == 0) rowss[(size_t)row * 16 + u.pn * 4 + wc] = ss;
                if (m & 1) asm volatile("" ::: "memory"); }
    }
};
struct EpiSwiglu {
    static constexpr bool PERM = true;
    unsigned char* act; const float* b1;
    __device__ __forceinline__ void operator()(const f32x4 (&acc)[2][2][4][2], const Unit& u, int wr, int wc, int fr, int fq) const {
        const int row0 = u.pm * BM + wr * 64 + fr; const int lc = u.pn * HALF + wc * 32 + 8 * fq;
        const float* bg = b1 + (size_t)u.e * 2048 + lc; const float* bl = bg + 1024;
        f32x4 bgv[2], blv[2];
#pragma unroll
        for (int n = 0; n < 2; ++n) { bgv[n] = *(const f32x4*)(bg + 4 * n); blv[n] = *(const f32x4*)(bl + 4 * n); }
#pragma unroll
        for (int ai = 0; ai < 2; ++ai)
#pragma unroll
            for (int m = 0; m < 4; ++m) { float r[8];
#pragma unroll
                for (int n = 0; n < 2; ++n)
#pragma unroll
                    for (int x = 0; x < 4; ++x) { float g = acc[ai][0][m][n][x] * (1.0f / 32.0f) + bgv[n][x], l = acc[ai][1][m][n][x] * (1.0f / 32.0f) + blv[n][x];
                        g = fminf(g, 7.0f); l = fminf(fmaxf(l, -7.0f), 7.0f);
                        const float sg = __builtin_amdgcn_rcpf(1.0f + __builtin_amdgcn_exp2f(-1.702f * LOG2E * g));
                        r[n * 4 + x] = g * sg * (l + 1.0f); }
                u32x2 w; w.x = pk4_fp8(r[0], r[1], r[2], r[3]); w.y = pk4_fp8(r[4], r[5], r[6], r[7]);
                *(u32x2*)(act + (size_t)(row0 + ai * HALF + m * 16) * D + lc) = w; }
    }
};
struct EpiDown {
    static constexpr bool PERM = true;
    unsigned char* Y; const float* b2; const int* rowsg; unsigned char* dump;
    __device__ __forceinline__ void operator()(const f32x4 (&acc)[2][2][4][2], const Unit& u, int wr, int wc, int fr, int fq) const {
        const int col0 = u.pn * BM + wc * 32 + 8 * fq;
        f32x4 bv[2][2];
#pragma unroll
        for (int bj = 0; bj < 2; ++bj)
#pragma unroll
            for (int n = 0; n < 2; ++n) bv[bj][n] = *(const f32x4*)(b2 + (size_t)u.e * D + col0 + bj * HALF + 4 * n);
#pragma unroll
        for (int ai = 0; ai < 2; ++ai)
#pragma unroll
            for (int m = 0; m < 4; ++m) { const int arow = u.pm * BM + ai * HALF + wr * 64 + m * 16 + fr;
                const int slot = rowsg[2 * arow]; const float gt = __builtin_bit_cast(float, rowsg[2 * arow + 1]);
                { unsigned char* rowp = (slot >= 0 ? Y + (size_t)slot * D : dump) + col0;
#pragma unroll
                    for (int bj = 0; bj < 2; ++bj) { const f32x4 v0 = (acc[ai][bj][m][0] * (1.0f / 32.0f) + bv[bj][0]) * gt, v1 = (acc[ai][bj][m][1] * (1.0f / 32.0f) + bv[bj][1]) * gt;
                        u32x2 w; w.x = pk4_fp8(v0[0], v0[1], v0[2], v0[3]); w.y = pk4_fp8(v1[0], v1[1], v1[2], v1[3]);
                        *(u32x2*)(rowp + bj * HALF) = w; } }
                asm volatile("" ::: "memory"); }
    }
};

typedef int i32x8 __attribute__((ext_vector_type(8)));
typedef int i32x4 __attribute__((ext_vector_type(4)));
template <bool FP8> struct FragT { typedef bf16x8 A[4][2]; typedef bf16x8 B[2][2]; };
template <> struct FragT<true> { typedef i32x8 A[4]; typedef i32x8 B[2]; };
template <class Epi, class Sched, bool GATHER, bool FP8>
__device__ __forceinline__ void gemm_phase(LAS unsigned char* lds, const Gemm g, const Sched& S, const Epi& E, int tileA0) {
    int tid = threadIdx.x; asm volatile("" : "+v"(tid));
    const int wid = __builtin_amdgcn_readfirstlane(tid >> 6), lane = tid & 63, wr = wid >> 2, wc = wid & 3, fr = lane & 15, fq = lane >> 4;
    constexpr int KB = FP8 ? K : 2 * K;
    constexpr int nt = FP8 ? K / 128 : K / 64;
    unsigned cA[2], voffB[2]; int rA[2];
#pragma unroll
    for (int i = 0; i < 2; ++i) { int R, C; stage_rc(tid * 16 + i * 8192, R, C, FP8 ? 4 : 5); const int Rb = Epi::PERM ? ((R & ~31) + perm32(R & 31)) : R;
        cA[i] = (unsigned)(C * 2); rA[i] = R; voffB[i] = (unsigned)(Rb * KB + C * 2); }
    constexpr size_t kstep = 128;
    constexpr size_t hstep = (size_t)HALF * KB;
    constexpr size_t tstep = 2 * hstep;
    const unsigned ldsw = (unsigned)wid * 1024u;
    const int aoff = FP8 ? lds_byte(wr * 64 + fr, fq * 16, 4) : lds_byte(wr * 64 + fr, fq * 8), boff = FP8 ? lds_byte(wc * 32 + fr, fq * 16, 4) : lds_byte(wc * 32 + fr, fq * 8);
    const int aoff1 = FP8 ? lds_byte(wr * 64 + fr, fq * 16 + 8, 4) : 0, boff1 = FP8 ? lds_byte(wc * 32 + fr, fq * 16 + 8, 4) : 0;
#define PG8_SA(b, h) (((b) * 2 + (h)) * HTB)
#define PG8_SB(b, h) ((4 + (b) * 2 + (h)) * HTB)
#define PG8_STAGE(bufoff, gbase, voff) do { _Pragma("unroll") for (int _i = 0; _i < 2; ++_i) \
        __builtin_amdgcn_global_load_lds((const unsigned*)((const char*)(gbase) + (voff)[_i]), (LAS unsigned*)(lds + (bufoff) + ldsw + _i * 8192), 16, 0, 0); } while (0)
#define PG8_LDA(dst, b, h) do { if constexpr (FP8) { _Pragma("unroll") for (int m = 0; m < 4; ++m) { dst[m].lo = *(const LAS i32x4*)(lds + PG8_SA(b, h) + aoff + m * 2048); dst[m].hi = *(const LAS i32x4*)(lds + PG8_SA(b, h) + aoff1 + m * 2048); } } \
        else { _Pragma("unroll") for (int m = 0; m < 4; ++m) _Pragma("unroll") for (int k = 0; k < 2; ++k) dst[m][k] = *(const LAS bf16x8*)(lds + PG8_SA(b, h) + aoff + m * 2048 + k * 1024); } } while (0)
#define PG8_LDB(dst, b, h) do { if constexpr (FP8) { _Pragma("unroll") for (int n = 0; n < 2; ++n) { dst[n].lo = *(const LAS i32x4*)(lds + PG8_SB(b, h) + boff + n * 2048); dst[n].hi = *(const LAS i32x4*)(lds + PG8_SB(b, h) + boff1 + n * 2048); } } \
        else { _Pragma("unroll") for (int n = 0; n < 2; ++n) _Pragma("unroll") for (int k = 0; k < 2; ++k) dst[n][k] = *(const LAS bf16x8*)(lds + PG8_SB(b, h) + boff + n * 2048 + k * 1024); } } while (0)
#define PG8_MMA(ai, bj, At, Bt) do { __builtin_amdgcn_s_setprio(1); if constexpr (FP8) { _Pragma("unroll") for (int m = 0; m < 4; ++m) _Pragma("unroll") for (int n = 0; n < 2; ++n) \
            acc[ai][bj][m][n] = __builtin_amdgcn_mfma_scale_f32_16x16x128_f8f6f4(Bt[n], At[m], acc[ai][bj][m][n], 0, 0, 0, 0x7f7f7f7f, 0, 0x7f7f7f7f); } \
        else { _Pragma("unroll") for (int m = 0; m < 4; ++m) _Pragma("unroll") for (int n = 0; n < 2; ++n) _Pragma("unroll") for (int k = 0; k < 2; ++k) \
            acc[ai][bj][m][n] = __builtin_amdgcn_mfma_f32_16x16x32_bf16(Bt[n][k], At[m][k], acc[ai][bj][m][n], 0, 0, 0); } __builtin_amdgcn_s_setprio(0); } while (0)
#define PG8_WAIT_V(n) asm volatile("s_waitcnt vmcnt(" #n ")" ::: "memory")
#define PG8_WAIT_L(n) asm volatile("s_waitcnt lgkmcnt(" #n ")" ::: "memory")
#define PG8_BAR __builtin_amdgcn_s_barrier()
#define PG8_SCHED __builtin_amdgcn_sched_barrier(0)
#define PG8_GLOAD(dst, slot, u) do { _Pragma("unroll") for (int h = 0; h < 2; ++h) _Pragma("unroll") for (int i = 0; i < 2; ++i) \
        dst[h][i] = (GATHER ? (unsigned)g.gidx[(slot) * 256 + h * HALF + rA[i]] : (unsigned)(((u).pm - tileA0) * BM + h * HALF + rA[i])) * (unsigned)KB + cA[i]; } while (0)
#define PG8_STAGE_A(bufoff, ptr, h, VG) PG8_STAGE(bufoff, ptr, VG[h])
    Unit cur, nxt; int ui = 0;
    if (!S.next(0, cur)) return;
    f32x4 acc[2][2][4][2];
#pragma unroll
    for (int a = 0; a < 2; ++a)
#pragma unroll
        for (int b = 0; b < 2; ++b)
#pragma unroll
            for (int m = 0; m < 4; ++m)
#pragma unroll
                for (int n = 0; n < 2; ++n) acc[a][b][m][n] = (f32x4){0.f, 0.f, 0.f, 0.f};
    typename FragT<FP8>::A At; typename FragT<FP8>::B B0, B1;
    unsigned vC[2][2];
    PG8_GLOAD(vC, 0, cur);
    const char* const Ab = (const char*)g.A;
    const char* cB = (const char*)g.Bt + (size_t)cur.e * g.estride + (size_t)cur.pn * tstep;
    PG8_STAGE(PG8_SB(0, 0), cB, voffB); PG8_STAGE(PG8_SB(0, 1), cB + hstep, voffB); PG8_STAGE_A(PG8_SA(0, 0), Ab, 0, vC); PG8_STAGE_A(PG8_SA(0, 1), Ab, 1, vC);
    if (wr == 1) PG8_BAR;
    PG8_WAIT_V(2); PG8_BAR;
    PG8_STAGE(PG8_SB(1, 0), cB + kstep, voffB); PG8_STAGE_A(PG8_SA(1, 0), Ab + kstep, 0, vC); PG8_STAGE(PG8_SB(1, 1), cB + hstep + kstep, voffB);
    PG8_WAIT_V(6); PG8_BAR;
    for (;;) {
        const bool has_next = S.next(ui + 1, nxt);
        const char* nB = has_next ? (const char*)g.Bt + (size_t)nxt.e * g.estride + (size_t)nxt.pn * tstep : cB;
#pragma unroll 1
        for (int t = 0; t < nt; t += 2) {
            const bool last = (t == nt - 2);
            const char* a1 = Ab + (size_t)(t + 1) * kstep;
            const char* a2 = last ? Ab : Ab + (size_t)(t + 2) * kstep; const char* b2 = last ? nB : cB + (size_t)(t + 2) * kstep;
            const char* a3 = a2 + kstep; const char* b3 = b2 + kstep;
            PG8_LDB(B0, 0, 0); PG8_LDB(B1, 0, 1); PG8_SCHED; PG8_LDA(At, 0, 0); PG8_STAGE_A(PG8_SA(1, 1), a1, 1, vC);
            if (last && has_next) { PG8_GLOAD(vC, ui + 1, nxt); }
            PG8_WAIT_V(8); PG8_WAIT_L(0); PG8_BAR; PG8_MMA(0, 0, At, B0); PG8_MMA(0, 1, At, B1); PG8_BAR; PG8_SCHED;
            PG8_LDA(At, 0, 1); PG8_STAGE(PG8_SB(0, 0), b2, voffB); PG8_STAGE(PG8_SB(0, 1), b2 + hstep, voffB); PG8_STAGE_A(PG8_SA(0, 0), a2, 0, vC);
            PG8_WAIT_V(8); PG8_WAIT_L(0); PG8_BAR; PG8_MMA(1, 0, At, B0); PG8_MMA(1, 1, At, B1); PG8_BAR; PG8_SCHED;
            PG8_LDB(B0, 1, 0); PG8_LDB(B1, 1, 1); PG8_SCHED; PG8_LDA(At, 1, 0); PG8_STAGE_A(PG8_SA(0, 1), a2, 1, vC);
            PG8_WAIT_V(8); PG8_WAIT_L(0); PG8_BAR; PG8_MMA(0, 0, At, B0); PG8_MMA(0, 1, At, B1); PG8_BAR; PG8_SCHED;
            PG8_LDA(At, 1, 1); PG8_STAGE(PG8_SB(1, 0), b3, voffB); PG8_STAGE(PG8_SB(1, 1), b3 + hstep, voffB); PG8_STAGE_A(PG8_SA(1, 0), a3, 0, vC);
            PG8_WAIT_V(8); PG8_WAIT_L(0); PG8_BAR; PG8_MMA(1, 0, At, B0); PG8_MMA(1, 1, At, B1); PG8_BAR; PG8_SCHED;
        }
        if (wr == 0) PG8_BAR;
        { int fr_ = fr, fq_ = fq; asm volatile("" : "+v"(fr_), "+v"(fq_));
          E(acc, cur, wr, wc, fr_, fq_); }
        if (!has_next) break;
#pragma unroll
        for (int a = 0; a < 2; ++a)
#pragma unroll
            for (int b = 0; b < 2; ++b)
#pragma unroll
                for (int m = 0; m < 4; ++m)
#pragma unroll
                    for (int n = 0; n < 2; ++n) acc[a][b][m][n] = (f32x4){0.f, 0.f, 0.f, 0.f};
        cur = nxt; cB = nB; ++ui;
        if (wr == 1) PG8_BAR;
    }
    PG8_WAIT_V(0);
    PG8_BAR;
#undef PG8_SA
#undef PG8_SB
#undef PG8_STAGE
#undef PG8_LDA
#undef PG8_LDB
#undef PG8_MMA
#undef PG8_WAIT_V
#undef PG8_WAIT_L
#undef PG8_BAR
#undef PG8_SCHED
#undef PG8_GLOAD
#undef PG8_STAGE_A
}
}


namespace att {
typedef float f32x16 __attribute__((ext_vector_type(16)));
typedef short s16x4 __attribute__((ext_vector_type(4)));
typedef short v4i16_t __attribute__((ext_vector_type(4)));
typedef const LAS unsigned char* lptr;
__device__ __forceinline__ int crow(int r, int hi) { return (r & 3) + 8 * (r >> 2) + 4 * hi; }
__device__ __forceinline__ s16x4 vtr(lptr p) { return __builtin_bit_cast(s16x4, __builtin_amdgcn_ds_read_tr16_b64_v4i16((LAS v4i16_t*)p)); }
__device__ __forceinline__ void glds16(const void* g, LAS unsigned char* l) { __builtin_amdgcn_global_load_lds((const unsigned*)g, (LAS unsigned*)l, 16, 0, 0); }
__device__ __forceinline__ float partner32(float x, bool hi) { auto rr = __builtin_amdgcn_permlane32_swap(__float_as_uint(x), __float_as_uint(x), false, false); return __uint_as_float(hi ? rr[0] : rr[1]); }
__device__ __forceinline__ void kload(bf16x8 (&kf)[8], lptr kslot, int r32, int hi) {
    lptr kb = kslot + hi * 1024 + r32 * 16;
#pragma unroll
    for (int d0 = 0; d0 < 4; ++d0) { kf[2 * d0] = *(const LAS bf16x8*)(kb + d0 * 2048); kf[2 * d0 + 1] = *(const LAS bf16x8*)(kb + d0 * 2048 + 512); }
}
__device__ __forceinline__ void qkt(f32x16& p0, f32x16& p1, const bf16x8 (&kf)[8], const bf16x8 (&qr)[4], const f32x16& c0) {
    __builtin_amdgcn_s_setprio(1);
    p0 = __builtin_amdgcn_mfma_f32_32x32x16_bf16(kf[0], qr[0], c0, 0, 0, 0); p1 = __builtin_amdgcn_mfma_f32_32x32x16_bf16(kf[1], qr[0], c0, 0, 0, 0);
#pragma unroll
    for (int d0 = 1; d0 < 4; ++d0) { p0 = __builtin_amdgcn_mfma_f32_32x32x16_bf16(kf[2 * d0], qr[d0], p0, 0, 0, 0); p1 = __builtin_amdgcn_mfma_f32_32x32x16_bf16(kf[2 * d0 + 1], qr[d0], p1, 0, 0, 0); }
    __builtin_amdgcn_s_setprio(0);
}
__device__ __forceinline__ void vload(bf16x8 (&vf)[8], lptr vp) {
#pragma unroll
    for (int d0 = 0; d0 < 2; ++d0)
#pragma unroll
        for (int ks = 0; ks < 4; ++ks) { const s16x4 lo = vtr(vp + d0 * 4096 + ks * 1024), hi4 = vtr(vp + d0 * 4096 + ks * 1024 + 512);
            vf[d0 * 4 + ks] = (bf16x8){lo[0], lo[1], lo[2], lo[3], hi4[0], hi4[1], hi4[2], hi4[3]}; }
}
__device__ __forceinline__ void pv64(f32x16& o0, f32x16& o1, const bf16x8 (&vf)[8], const bf16x8 (&pa)[4]) {
    __builtin_amdgcn_s_setprio(1);
#pragma unroll
    for (int ks = 0; ks < 4; ++ks) { o0 = __builtin_amdgcn_mfma_f32_32x32x16_bf16(pa[ks], vf[ks], o0, 0, 0, 0); o1 = __builtin_amdgcn_mfma_f32_32x32x16_bf16(pa[ks], vf[4 + ks], o1, 0, 0, 0); }
    __builtin_amdgcn_s_setprio(0);
}
__device__ __forceinline__ void pack_p(bf16x8 (&pa)[4], const f32x16& p0, const f32x16& p1) {
    u32x4 w0, w1, w2, w3;
    w0.x = cvt_pk_bf16(p0[0], p0[1]); w0.y = cvt_pk_bf16(p0[2], p0[3]); w0.z = cvt_pk_bf16(p0[4], p0[5]); w0.w = cvt_pk_bf16(p0[6], p0[7]);
    w1.x = cvt_pk_bf16(p0[8], p0[9]); w1.y = cvt_pk_bf16(p0[10], p0[11]); w1.z = cvt_pk_bf16(p0[12], p0[13]); w1.w = cvt_pk_bf16(p0[14], p0[15]);
    w2.x = cvt_pk_bf16(p1[0], p1[1]); w2.y = cvt_pk_bf16(p1[2], p1[3]); w2.z = cvt_pk_bf16(p1[4], p1[5]); w2.w = cvt_pk_bf16(p1[6], p1[7]);
    w3.x = cvt_pk_bf16(p1[8], p1[9]); w3.y = cvt_pk_bf16(p1[10], p1[11]); w3.z = cvt_pk_bf16(p1[12], p1[13]); w3.w = cvt_pk_bf16(p1[14], p1[15]);
    pa[0] = __builtin_bit_cast(bf16x8, w0); pa[1] = __builtin_bit_cast(bf16x8, w1); pa[2] = __builtin_bit_cast(bf16x8, w2); pa[3] = __builtin_bit_cast(bf16x8, w3);
}

__device__ __forceinline__ void sb_probs(f32x16& p0, f32x16& p1) {
#pragma unroll
    for (int r = 0; r < 16; ++r) { p0[r] = __builtin_amdgcn_rcpf(1.0f + __builtin_amdgcn_exp2f(p0[r])); p1[r] = __builtin_amdgcn_rcpf(1.0f + __builtin_amdgcn_exp2f(p1[r])); }
}
__device__ __forceinline__ void sb_mask(f32x16& p0, f32x16& p1, int lim, int hi) {
#pragma unroll
    for (int r = 0; r < 16; ++r) { const int kl = crow(r, hi); if (kl >= lim) p0[r] = 1.0f; if (kl + 32 >= lim) p1[r] = 1.0f; }
}
__device__ __forceinline__ void sb_scan(f32x16& p0, f32x16& p1, float& carry, bool hib) {
    float G[8], Gp[8];
#pragma unroll
    for (int gi = 0; gi < 4; ++gi) { G[gi] = (p0[4 * gi] * p0[4 * gi + 1]) * (p0[4 * gi + 2] * p0[4 * gi + 3]); G[4 + gi] = (p1[4 * gi] * p1[4 * gi + 1]) * (p1[4 * gi + 2] * p1[4 * gi + 3]); }
#pragma unroll
    for (int gi = 0; gi < 8; ++gi) Gp[gi] = partner32(G[gi], hib);
    float u = carry;
#pragma unroll
    for (int gi = 7; gi >= 0; --gi) {
        const float ug = u * Gp[gi]; float tt = hib ? u : ug;
#pragma unroll
        for (int i = 3; i >= 0; --i) { if (gi >= 4) { const float tn = tt * p1[4 * (gi - 4) + i]; p1[4 * (gi - 4) + i] = tt - tn; tt = tn; } else { const float tn = tt * p0[4 * gi + i]; p0[4 * gi + i] = tt - tn; tt = tn; } }
        u = ug * G[gi];
    }
    carry = u;
}
__device__ __forceinline__ void sb_head(LAS unsigned char* lds, const bf16_t* PROJ, const bf16_t* METAKV, bf16_t* MIX, int b, int h) {
    int tid = threadIdx.x; asm volatile("" : "+v"(tid));
    const int lane = tid & 63, r32 = lane & 31, hi = lane >> 5; const int wid = __builtin_amdgcn_readfirstlane(tid >> 6);
    const bool hib = hi != 0;
    const bf16_t* Kg = PROJ + (size_t)b * SEQ * DIN + COL_SBK + h * 64; const bf16_t* Vg = PROJ + (size_t)b * SEQ * DIN + COL_SBV + h * 64;
    const bf16_t* Km = METAKV + COL_SBK + h * 64; const bf16_t* Vm = METAKV + COL_SBV + h * 64;
    const int vrow = 16 * (wid & 3) + (lane >> 2), vcol = (wid >> 2) * 32 + (lane & 3) * 8;
    const int voff_lane = ((lane >> 4) & 1) * 32 + (lane & 3) * 8 + (4 * hi + ((lane & 15) >> 2)) * 64;
#define SB_ISSUE(ip_, buf_) do { const int ip__ = (ip_); LAS unsigned char* bb_ = lds + (buf_) * 32768; \
        if (ip__ < NP) { const int keyA_ = 64 * (NT - 1 - 2 * ip__), keyB_ = keyA_ - 64; \
            glds16(Kg + (size_t)(keyA_ + lane) * DIN + wid * 8, bb_ + wid * 1024); glds16(Vg + (size_t)(keyA_ + vrow) * DIN + vcol, bb_ + 8192 + wid * 1024); \
            glds16(Kg + (size_t)(keyB_ + lane) * DIN + wid * 8, bb_ + 16384 + wid * 1024); glds16(Vg + (size_t)(keyB_ + vrow) * DIN + vcol, bb_ + 24576 + wid * 1024); } \
        else { glds16(Km + (size_t)(lane < 16 ? lane : 15) * DIN + wid * 8, bb_ + wid * 1024); glds16(Vm + (size_t)(vrow < 16 ? vrow : 15) * DIN + vcol, bb_ + 8192 + wid * 1024); } } while (0)
    for (int qb = 7; qb >= 0; --qb) {
        const int NT = 4 * qb + 4, NP = NT / 2, q0w = qb * 256 + wid * 32, my_diag = 4 * qb + (wid >> 1);
        bf16x8 qr[4];
        { const bf16_t* qp = PROJ + ((size_t)b * SEQ + q0w + r32) * DIN + COL_SBQ + h * 64 + hi * 8;
#pragma unroll
          for (int d0 = 0; d0 < 4; ++d0) qr[d0] = *(const bf16x8*)(qp + d0 * 16); }
        f32x16 o0 = {}, o1 = {}; float carry = 1.0f;
        SB_ISSUE(0, 0);
        for (int ip = 0; ip <= NP; ++ip) {
            asm volatile("s_waitcnt vmcnt(0)" ::: "memory");
            __syncthreads();
            if (ip < NP) SB_ISSUE(ip + 1, (ip + 1) & 1);
            lptr bb = lds + (ip & 1) * 32768;
            const f32x16 z16 = {};
            if (ip == NP) {
                f32x16 p0, p1; bf16x8 kf[8]; kload(kf, bb, r32, hi); qkt(p0, p1, kf, qr, z16);
                bf16x8 vf[8]; vload(vf, bb + 8192 + voff_lane);
                sb_probs(p0, p1); sb_mask(p0, p1, 16, hi); sb_scan(p0, p1, carry, hib);
                bf16x8 pa[4]; pack_p(pa, p0, p1); pv64(o0, o1, vf, pa);
            } else {
                const int tA = NT - 1 - 2 * ip, tB = tA - 1;
                if (tA <= my_diag) {
                    f32x16 a0, a1, b0, b1; bf16x8 kf[8];
                    kload(kf, bb, r32, hi); qkt(a0, a1, kf, qr, z16);
                    kload(kf, bb + 16384, r32, hi); qkt(b0, b1, kf, qr, z16);
                    sb_probs(a0, a1); sb_probs(b0, b1);
                    if (tA == my_diag) sb_mask(a0, a1, q0w + r32 - 64 * tA, hi);
                    sb_scan(a0, a1, carry, hib);
                    { bf16x8 vf[8]; vload(vf, bb + 8192 + voff_lane); bf16x8 pa[4]; pack_p(pa, a0, a1); pv64(o0, o1, vf, pa); }
                    sb_scan(b0, b1, carry, hib);
                    { bf16x8 vf[8]; vload(vf, bb + 24576 + voff_lane); bf16x8 pa[4]; pack_p(pa, b0, b1); pv64(o0, o1, vf, pa); }
                } else if (tB <= my_diag) {
                    f32x16 p0, p1; bf16x8 kf[8]; kload(kf, bb + 16384, r32, hi); qkt(p0, p1, kf, qr, z16);
                    bf16x8 vf[8]; vload(vf, bb + 24576 + voff_lane);
                    sb_probs(p0, p1); if (tB == my_diag) sb_mask(p0, p1, q0w + r32 - 64 * tB, hi); sb_scan(p0, p1, carry, hib);
                    bf16x8 pa[4]; pack_p(pa, p0, p1); pv64(o0, o1, vf, pa);
                }
            }
        }
        { LAS bf16_t* stg = (LAS bf16_t*)(lds + 65536 + wid * 4096);
#pragma unroll
          for (int r = 0; r < 16; ++r) { const int orow = crow(r, hi); stg[orow * 64 + r32] = (bf16_t)f2bf(o0[r]); stg[orow * 64 + 32 + r32] = (bf16_t)f2bf(o1[r]); }
          bf16_t* Ow = MIX + ((size_t)b * SEQ + q0w) * D + h * 64;
#pragma unroll
          for (int i = 0; i < 4; ++i) { const int row = i * 8 + (lane >> 3), ch = lane & 7; const u32x4 v = *(const LAS u32x4*)(stg + row * 64 + ch * 8); *(u32x4*)(Ow + (size_t)row * D + ch * 8) = v; } }
        __syncthreads();
    }
#undef SB_ISSUE
}

constexpr float DF_THR = 8.0f;
__device__ __forceinline__ void df_head(LAS unsigned char* lds, LAS float* wsf_all, const LAS float* btab, float lam, const float* sgain, const bf16_t* PROJ, const bf16_t* METAKV, bf16_t* MIX, int b, int hd, int which) {
    int tid = threadIdx.x; asm volatile("" : "+v"(tid));
    const int lane = tid & 63, r32 = lane & 31, hi = lane >> 5; const int wid = __builtin_amdgcn_readfirstlane(tid >> 6);
    const bool hib = hi != 0; const int s = wid >> 2, qw = wid & 3;
    const size_t rb = (size_t)b * SEQ * DIN;
    const bf16_t* K0g = PROJ + rb + COL_DFK + (2 * hd) * 64; const bf16_t* K1g = K0g + 64; const bf16_t* Vg = PROJ + rb + COL_DFV + hd * 128;
    const bf16_t* K0m = METAKV + COL_DFK + (2 * hd) * 64; const bf16_t* K1m = K0m + 64; const bf16_t* Vm = METAKV + COL_DFV + hd * 128;
    const int vrow = 16 * (wid & 3) + (lane >> 2), vcol = (wid >> 2) * 32 + (lane & 3) * 8;
    const int voff_lane = ((lane >> 4) & 1) * 32 + (lane & 3) * 8 + (4 * hi + ((lane & 15) >> 2)) * 64;
    LAS float* wsf = wsf_all + wid * 64;
    const LAS float* bt = btab + hd * 192;
    const float bfar = bt[0];
#define DF_ISSUE(it_, buf_) do { const int it__ = (it_); LAS unsigned char* bb_ = lds + (buf_) * 32768; \
        if (it__ < NTL) { const int key0_ = 64 * it__; const size_t ko_ = (size_t)(key0_ + lane) * DIN + wid * 8, vo_ = (size_t)(key0_ + vrow) * DIN + vcol; \
            glds16(K0g + ko_, bb_ + wid * 1024); glds16(K1g + ko_, bb_ + 8192 + wid * 1024); glds16(Vg + vo_, bb_ + 16384 + wid * 1024); glds16(Vg + vo_ + 64, bb_ + 24576 + wid * 1024); } \
        else { const size_t ko_ = (size_t)(lane < 16 ? lane : 15) * DIN + wid * 8, vo_ = (size_t)(vrow < 16 ? vrow : 15) * DIN + vcol; \
            glds16(K0m + ko_, bb_ + wid * 1024); glds16(K1m + ko_, bb_ + 8192 + wid * 1024); glds16(Vm + vo_, bb_ + 16384 + wid * 1024); glds16(Vm + vo_ + 64, bb_ + 24576 + wid * 1024); } } while (0)
    for (int i8 = 0; i8 < 8; ++i8) {
        const int u = 2 * i8 + (which ? 1 - (i8 & 1) : (i8 & 1));
        const int NTL = 2 * u + 2;
        const int q0w = u * 128 + qw * 32, mychunk = 2 * u + (qw >> 1);
        bf16x8 qr[4];
        { const bf16_t* qp = PROJ + ((size_t)b * SEQ + q0w + r32) * DIN + COL_DFQ + (2 * hd + s) * 64 + hi * 8;
#pragma unroll
          for (int d0 = 0; d0 < 4; ++d0) qr[d0] = *(const bf16x8*)(qp + d0 * 16); }
        f32x16 o[4] = {{}, {}, {}, {}}; float mrun = -1e30f, lsum = 0.f;
        DF_ISSUE(0, 0);
        for (int it = 0; it <= NTL; ++it) {
            asm volatile("s_waitcnt vmcnt(0)" ::: "memory");
            __syncthreads();
            if (it < NTL) DF_ISSUE(it + 1, (it + 1) & 1);
            const bool meta = it == NTL;
            if (meta || it <= mychunk) {
                lptr bb = lds + (it & 1) * 32768;
                const int kbase = meta ? -16 : 64 * it;
                const bool near = (q0w - (kbase + 63)) < 128;
                f32x16 p0, p1; const f32x16 c0 = {};
                const float badd = near ? 0.f : bfar;
                bf16x8 kf[8]; kload(kf, bb + s * 8192, r32, hi); __builtin_amdgcn_sched_barrier(0);
                qkt(p0, p1, kf, qr, c0);
                if (near) { const int base = kbase - (q0w + r32) + 128;
#pragma unroll
                    for (int r = 0; r < 16; ++r) { int i0 = base + crow(r, hi); int i1 = i0 + 32; i0 = i0 < 0 ? 0 : i0; i1 = i1 < 0 ? 0 : i1; p0[r] += bt[i0]; p1[r] += bt[i1]; } }
                if (meta) {
#pragma unroll
                    for (int r = 0; r < 16; ++r) { if (crow(r, hi) >= 16) p0[r] = -1e30f; p1[r] = -1e30f; } }
                float tm = fmaxf(p0[0], p1[0]);
#pragma unroll
                for (int r = 1; r < 16; ++r) tm = fmaxf(tm, fmaxf(p0[r], p1[r]));
                tm = fmaxf(tm, partner32(tm, hib)) + badd;
                if (__any(tm > mrun + DF_THR)) {
                    const float mn = fmaxf(mrun, tm); const float f = __builtin_amdgcn_exp2f(mrun - mn); mrun = mn; lsum *= f;
                    if (!hib) wsf[r32] = f;
#pragma unroll
                    for (int r = 0; r < 16; ++r) { const float fr_ = wsf[crow(r, hi)]; o[0][r] *= fr_; o[1][r] *= fr_; o[2][r] *= fr_; o[3][r] *= fr_; }
                }
                float ps = 0.f;
                const float msub = mrun - badd;
#pragma unroll
                for (int r = 0; r < 16; ++r) { p0[r] = __builtin_amdgcn_exp2f(p0[r] - msub); p1[r] = __builtin_amdgcn_exp2f(p1[r] - msub); ps += p0[r] + p1[r]; }
                lsum += ps;
                bf16x8 pa[4]; pack_p(pa, p0, p1);
                bf16x8 vf[8]; vload(vf, bb + 16384 + voff_lane); __builtin_amdgcn_sched_barrier(0);
                pv64(o[0], o[1], vf, pa);
                vload(vf, bb + 24576 + voff_lane); __builtin_amdgcn_sched_barrier(0);
                pv64(o[2], o[3], vf, pa);
            }
        }
        const float ltot = lsum + partner32(lsum, hib);
        if (!hib) wsf[r32] = (s ? lam : 1.0f) / ltot;
        float sc[16];
#pragma unroll
        for (int r = 0; r < 16; ++r) sc[r] = wsf[crow(r, hi)];
        LAS float* X = (LAS float*)(lds + 65536 + qw * 16384);
        if (s == 1) {
#pragma unroll
            for (int db = 0; db < 4; ++db)
#pragma unroll
                for (int r = 0; r < 16; ++r) X[(db * 16 + r) * 64 + lane] = o[db][r] * sc[r];
        }
        __syncthreads();
        if (s == 0) {
            float ssq[16];
#pragma unroll
            for (int r = 0; r < 16; ++r) ssq[r] = 0.f;
#pragma unroll
            for (int db = 0; db < 4; ++db)
#pragma unroll
                for (int r = 0; r < 16; ++r) { const float a = o[db][r] * sc[r] - X[(db * 16 + r) * 64 + lane]; o[db][r] = a; ssq[r] += a * a; }
#pragma unroll
            for (int r = 0; r < 16; ++r) {
#pragma unroll
                for (int of = 1; of < 32; of <<= 1) ssq[r] += __shfl_xor(ssq[r], of);
                ssq[r] = (1.0f - LAMBDA_INIT) / sqrtf(ssq[r] * (1.0f / 128.0f) + SUBLN_EPS); }
            LAS bf16_t* stg = (LAS bf16_t*)X;
#pragma unroll
            for (int db = 0; db < 4; ++db) { const float gnv = sgain[db * 32 + r32];
#pragma unroll
                for (int r = 0; r < 16; ++r) stg[crow(r, hi) * 136 + db * 32 + r32] = (bf16_t)f2bf(o[db][r] * ssq[r] * gnv); }
            bf16_t* Ow = MIX + ((size_t)b * SEQ + q0w) * D + 512 + hd * 128;
            const int row = lane >> 1, hf = lane & 1;
#pragma unroll
            for (int i = 0; i < 8; ++i) { const u32x4 v = *(const LAS u32x4*)(stg + row * 136 + hf * 64 + i * 8); *(u32x4*)(Ow + (size_t)row * D + hf * 64 + i * 8) = v; }
        }
        __syncthreads();
    }
#undef DF_ISSUE
}
}

#define XB_TMO      128
#define XB_XCNT(j)  (256  + 64 * (j))
#define XB_XSUB(j)  (1280 + 64 * (j))
#define XB_XGEN(j)  (2304 + 64 * (j))
#define XB_TOP      3328
#define XB_TOPGEN   3392
#define XCD_BAR_WORDS 3456
#define XB_SPIN_CAP (1u << 18)
__device__ __forceinline__ unsigned xb_ld(unsigned* p)              { return __hip_atomic_load(p, __ATOMIC_RELAXED, __HIP_MEMORY_SCOPE_AGENT); }
__device__ __forceinline__ unsigned xb_add(unsigned* p, unsigned v) { return __hip_atomic_fetch_add(p, v, __ATOMIC_RELAXED, __HIP_MEMORY_SCOPE_AGENT); }
__device__ __forceinline__ unsigned xb_xcc_id() { return (unsigned)__builtin_amdgcn_s_getreg((3 << 11) | 20) & 0xFu; }
#define XB_SPIN(cond, bar) do { unsigned _sp = 0; while (cond) { __builtin_amdgcn_s_sleep(1); \
    if ((++_sp & 255u) == 0u) { if (xb_ld(&(bar)[XB_TMO])) break; if (_sp > XB_SPIN_CAP) { atomicAdd(&(bar)[XB_TMO], 1u); break; } } } } while (0)
struct XcdBarrier { unsigned* bar; unsigned x; volatile LAS unsigned* st; };
__device__ __forceinline__ XcdBarrier xcd_barrier_post(unsigned* bar, volatile LAS unsigned* st) {
    XcdBarrier b; b.bar = bar; b.x = xb_xcc_id(); b.st = st;
    if (threadIdx.x == 0) (void)xb_add(&bar[XB_XCNT(b.x)], 1u);
    return b;
}
__device__ __forceinline__ void xcd_barrier_complete(unsigned* bar, unsigned x, unsigned& nloc, unsigned& nx) {
    const unsigned G = gridDim.x * gridDim.y * gridDim.z;
    unsigned sum, cnt, mine, sp = 0u;
    for (;;) {
        sum = 0u; cnt = 0u; mine = 0u;
#pragma unroll
        for (unsigned j = 0; j < 16; ++j) { const unsigned c = xb_ld(&bar[XB_XCNT(j)]); sum += c; cnt += (c > 0u) ? 1u : 0u; mine = (j == x) ? c : mine; }
        if (sum == G) break;
        __builtin_amdgcn_s_sleep(1);
        if ((++sp & 255u) == 0u) { if (xb_ld(&bar[XB_TMO])) break; if (sp > XB_SPIN_CAP) { atomicAdd(&bar[XB_TMO], 1u); break; } }
    }
    nloc = mine > 0u ? mine : 1u; nx = cnt > 0u ? cnt : 1u;
}
__device__ __forceinline__ void xcd_barrier(const XcdBarrier& b) {
    asm volatile("s_waitcnt vmcnt(0)" ::: "memory");
    __syncthreads();
    if (threadIdx.x == 0) {
        unsigned* bar = b.bar;
        __builtin_amdgcn_s_waitcnt(0);
        unsigned nloc = b.st[0], nx = b.st[1];
        if (nloc == 0u) { xcd_barrier_complete(bar, b.x, nloc, nx); b.st[0] = nloc; b.st[1] = nx; }
        const unsigned old = xb_add(&bar[XB_XSUB(b.x)], 1u);
        const unsigned gen = old / nloc;
        if (old + 1u == (gen + 1u) * nloc) {
            __builtin_amdgcn_fence(__ATOMIC_RELEASE, "agent");
            asm volatile("s_waitcnt vmcnt(0)" ::: "memory");
            const unsigned og = xb_add(&bar[XB_TOP], 1u);
            const unsigned tg = og / nx;
            if (og + 1u == (tg + 1u) * nx) xb_add(&bar[XB_TOPGEN], 1u);
            else XB_SPIN(xb_ld(&bar[XB_TOPGEN]) == tg, bar);
            __builtin_amdgcn_fence(__ATOMIC_ACQUIRE, "agent");
            xb_add(&bar[XB_XGEN(b.x)], 1u);
            asm volatile("s_waitcnt vmcnt(0)" ::: "memory");
        } else {
            XB_SPIN(xb_ld(&bar[XB_XGEN(b.x)]) == gen, bar);
            __builtin_amdgcn_fence(__ATOMIC_ACQUIRE, "agent");
            asm volatile("s_waitcnt vmcnt(0)" ::: "memory");
        }
    }
    __syncthreads();
}

struct Args { const float* in[19]; float* out; unsigned char* ws; int ph_lo, ph_hi; };
enum { I_X = 0, I_META, I_RELB, I_ANORM, I_WIN, I_WOUT, I_LQ1, I_LK1, I_LQ2, I_LK2, I_SUBLN, I_FNORM, I_WR, I_BR, I_W1, I_B1, I_W2, I_B2, I_FINAL };

__device__ __forceinline__ void rms_row_to_bf16(const float* xrow, const f32x4 (&gn)[4], bf16_t* orow, int lane) {
    const f32x4* xr = (const f32x4*)xrow + lane;
    f32x4 v[4]; float s = 0.f;
#pragma unroll
    for (int j = 0; j < 4; ++j) { v[j] = xr[64 * j]; s += (v[j].x * v[j].x + v[j].y * v[j].y) + (v[j].z * v[j].z + v[j].w * v[j].w); }
    const float r = 1.0f / sqrtf(wave_sum(s) * (1.f / D) + NORM_EPS);
    unsigned long long* o8 = (unsigned long long*)orow + lane;
#pragma unroll
    for (int j = 0; j < 4; ++j) { const f32x4 y = v[j] * r * gn[j]; o8[64 * j] = (unsigned long long)pk2(y.x, y.y) | ((unsigned long long)pk2(y.z, y.w) << 32); }
}

__device__ __forceinline__ void p0_transpose_item(const float* W, int K, int N, bf16_t* WT, LAS float* scr, int item, int lane, int mode) {
    const int nblk = N / 32, kb = item / nblk, nb = item % nblk, k0 = 64 * kb, n0 = 32 * nb;
#pragma unroll 8
    for (int i = 0; i < 32; ++i) { const int kk = 2 * i + (lane >> 5); scr[kk * 33 + (lane & 31)] = W[(size_t)(k0 + kk) * N + n0 + (lane & 31)]; }
    LDS_WAIT(); asm volatile("" ::: "memory");
    int d0 = n0;
    if (mode == 1) { const int half = n0 >> 10, jj = n0 & 1023; d0 = (jj >> 7) * 256 + half * 128 + (jj & 127); }
    const int c = lane & 7;
#pragma unroll
    for (int j = 0; j < 4; ++j) { const int n = (lane >> 3) + 8 * j; const LAS float* s = scr + (8 * c) * 33 + n;
        u32x4 o; o.x = pk2(s[0 * 33], s[1 * 33]); o.y = pk2(s[2 * 33], s[3 * 33]); o.z = pk2(s[4 * 33], s[5 * 33]); o.w = pk2(s[6 * 33], s[7 * 33]);
        *(u32x4*)(WT + (size_t)(d0 + n) * K + k0 + 8 * c) = o; }
    LDS_WAIT(); asm volatile("" ::: "memory");
}

__device__ __forceinline__ void p0_transpose_item8(const float* W, int K, int N, unsigned char* WT, LAS float* scr, int item, int lane, int mode) {
    const int nblk = N / 32, kb = item / nblk, nb = item % nblk, k0 = 64 * kb, n0 = 32 * nb;
#pragma unroll 8
    for (int i = 0; i < 32; ++i) { const int kk = 2 * i + (lane >> 5); scr[kk * 33 + (lane & 31)] = W[(size_t)(k0 + kk) * N + n0 + (lane & 31)]; }
    LDS_WAIT(); asm volatile("" ::: "memory");
    int d0 = n0;
    if (mode == 1) { const int half = n0 >> 10, jj = n0 & 1023; d0 = (jj >> 7) * 256 + half * 128 + (jj & 127); }
    const int c = lane & 3;
#pragma unroll
    for (int j = 0; j < 2; ++j) { const int n = (lane >> 2) + 16 * j; const LAS float* sp = scr + (16 * c) * 33 + n;
        u32x4 o;
        o.x = pk4_fp8(sp[0 * 33] * 32.f, sp[1 * 33] * 32.f, sp[2 * 33] * 32.f, sp[3 * 33] * 32.f); o.y = pk4_fp8(sp[4 * 33] * 32.f, sp[5 * 33] * 32.f, sp[6 * 33] * 32.f, sp[7 * 33] * 32.f);
        o.z = pk4_fp8(sp[8 * 33] * 32.f, sp[9 * 33] * 32.f, sp[10 * 33] * 32.f, sp[11 * 33] * 32.f); o.w = pk4_fp8(sp[12 * 33] * 32.f, sp[13 * 33] * 32.f, sp[14 * 33] * 32.f, sp[15 * 33] * 32.f);
        *(u32x4*)(WT + (size_t)(d0 + n) * K + k0 + 16 * c) = o; }
    LDS_WAIT(); asm volatile("" ::: "memory");
}

__device__ __forceinline__ int t5_bucket(int rel) {
    const int n = rel < 0 ? -rel : rel; int b = rel > 0 ? 16 : 0;
    int large = 8 + (n >= 12) + (n >= 16) + (n >= 23) + (n >= 32) + (n >= 46) + (n >= 64) + (n >= 91);
    return b + (n < 8 ? n : large);
}

template <int CLS> __global__ void __launch_bounds__(NWAVES * 64, 2) fwd_kernel(Args args) {
    extern __shared__ __attribute__((aligned(16))) unsigned char lds_raw[];
    LAS unsigned char* lds = (LAS unsigned char*)lds_raw;
    volatile LAS unsigned* MISC = (volatile LAS unsigned*)(lds + MISC_OFF);
    const int tid = threadIdx.x, lane = tid & 63, wave = __builtin_amdgcn_readfirstlane(tid >> 6);
    const int G = gridDim.x, bx = blockIdx.x;
    const int gw = bx * NWAVES + wave, NGW = G * NWAVES;
    unsigned char* ws = args.ws;
    unsigned* ctl = (unsigned*)(ws + WS_CTL);
    const float* x = args.in[I_X];
    bf16_t* WinT = (bf16_t*)(ws + WS_WIN); bf16_t* WoutT = (bf16_t*)(ws + WS_WOUT); unsigned char* W1T = ws + WS_W1; unsigned char* W2T = ws + WS_W2; unsigned char* XN8 = ws + WS_XN8;
    bf16_t* METAKV = (bf16_t*)(ws + WS_METAKV); bf16_t* XN = (bf16_t*)(ws + WS_XN); bf16_t* PROJ = (bf16_t*)(ws + WS_PROJ); bf16_t* MIX = (bf16_t*)(ws + WS_MIX);
    float* TMP = (float*)(ws + WS_TMP); unsigned char* Y = ws + WS_Y; unsigned char* ACT = ws + WS_ACT;
    int* tok_e = (int*)(ws + WS_TOKE); float* tok_g = (float*)(ws + WS_TOKG); int* tok_lr = (int*)(ws + WS_TOKLR); int* cnt = (int*)(ws + WS_CNT);
    unsigned* rowtok = (unsigned*)(ws + WS_ROWTOK); int* rowsg = (int*)(ws + WS_ROWSG); int* tilee_hdr = (int*)(ws + WS_TILEE); unsigned char* tilee = (unsigned char*)(ws + WS_TILEE) + 64;
    bf16_t* H1 = (bf16_t*)(ws + WS_H1);

    if (tid < 32) MISC[tid] = 0u;
    __syncthreads();
#if ONE_LAUNCH
    XcdBarrier bar = xcd_barrier_post(ctl + CW_BAR, MISC + 8);
#define GRID_BAR() xcd_barrier(bar)
#else
#define GRID_BAR() do {} while (0)
#endif
    const int lo = args.ph_lo, hi = args.ph_hi;
#define INC(k, cls) ((CLS == -1 || CLS == (cls)) && lo <= (k) && (k) < hi)
#define IN(k) INC(k, k)
#define BOTH(k) (CLS == -1 && lo <= (k) && (k) + 1 < hi)

    if (IN(0)) {
        REP_BEGIN(0)
        int tid = threadIdx.x; asm volatile("" : "+v"(tid)); const int lane = tid & 63;
        LAS float* scr = (LAS float*)(lds + wave * 16384);
        constexpr int I_IN = 16 * 96, I_OUT = 16 * 32, I_1 = 16 * 64, I_2 = 16 * 32;
        constexpr int NITEMS = I_IN + I_OUT + NEXP * (I_1 + I_2);
        for (int it = gw; it < NITEMS; it += NGW) {
            int r = it;
            if (r < I_IN) { p0_transpose_item(args.in[I_WIN], D, DIN, WinT, scr, r, lane, 0); continue; } r -= I_IN;
            if (r < I_OUT) { p0_transpose_item(args.in[I_WOUT], D, D, WoutT, scr, r, lane, 0); continue; } r -= I_OUT;
            if (r < NEXP * I_1) { const int e = r / I_1; p0_transpose_item8(args.in[I_W1] + (size_t)e * D * 2048, D, 2048, W1T + (size_t)e * 2048 * D, scr, r % I_1, lane, 1); continue; } r -= NEXP * I_1;
            { const int e = r / I_2; p0_transpose_item8(args.in[I_W2] + (size_t)e * D * D, D, D, W2T + (size_t)e * D * D, scr, r % I_2, lane, 0); }
        }
        f32x4 gn[4];
#pragma unroll
        for (int j = 0; j < 4; ++j) gn[j] = ((const f32x4*)args.in[I_ANORM])[lane + 64 * j];
        for (int m = gw; m < T; m += NGW) rms_row_to_bf16(x + (size_t)m * D, gn, XN + (size_t)m * D, lane);
        __syncthreads();
        LAS float* xm = (LAS float*)lds;
        for (int rr = 0; rr < 2; ++rr) { const int m = wave * 2 + rr; const f32x4* xr = (const f32x4*)(args.in[I_META] + (size_t)m * D) + lane;
            f32x4 v[4]; float s = 0.f;
#pragma unroll
            for (int j = 0; j < 4; ++j) { v[j] = xr[64 * j]; s += (v[j].x * v[j].x + v[j].y * v[j].y) + (v[j].z * v[j].z + v[j].w * v[j].w); }
            const float r = 1.0f / sqrtf(wave_sum(s) * (1.f / D) + NORM_EPS);
#pragma unroll
            for (int j = 0; j < 4; ++j) { const f32x4 y = v[j] * r * gn[j]; *(LAS f32x4*)(xm + m * D + 4 * lane + 256 * j) = y; } }
        __syncthreads();
        for (int cb = bx; cb < 256; cb += G) {
            const int q0 = cb * 8; const int n0 = q0 < 1024 ? q0 + 512 : q0 + 1024;
            const int m = tid >> 5, kp = tid & 31; float a8[8];
#pragma unroll
            for (int c = 0; c < 8; ++c) a8[c] = 0.f;
            const float* win = args.in[I_WIN];
            for (int kk = 0; kk < 32; ++kk) { const int k = kk * 32 + kp; const float xv = xm[m * D + k];
                const f32x4 w0 = *(const f32x4*)(win + (size_t)k * DIN + n0), w1 = *(const f32x4*)(win + (size_t)k * DIN + n0 + 4);
                a8[0] += xv * w0.x; a8[1] += xv * w0.y; a8[2] += xv * w0.z; a8[3] += xv * w0.w; a8[4] += xv * w1.x; a8[5] += xv * w1.y; a8[6] += xv * w1.z; a8[7] += xv * w1.w; }
#pragma unroll
            for (int c = 0; c < 8; ++c) {
#pragma unroll
                for (int o = 1; o < 32; o <<= 1) a8[c] += __shfl_xor(a8[c], o); }
            if (kp == 0) { u32x4 w; w.x = pk2(a8[0], a8[1]); w.y = pk2(a8[2], a8[3]); w.z = pk2(a8[4], a8[5]); w.w = pk2(a8[6], a8[7]); *(u32x4*)(METAKV + (size_t)m * DIN + n0) = w; }
        }
        __syncthreads();
        REP_END(0)
        if (BOTH(0)) GRID_BAR();
    }

    if (IN(1)) {
        REP_BEGIN(1)
        pg8::Gemm g{XN, WinT, 0, nullptr}; pg8::StaticOrder S; S.init(T, DIN, G, bx);
        pg8::EpiProj E{PROJ};
        pg8::gemm_phase<pg8::EpiProj, pg8::StaticOrder, false, false>(lds, g, S, E, 0);
        REP_END(1)
        if (BOTH(1)) GRID_BAR();
    }

    if (IN(2)) {
        int tid = threadIdx.x; asm volatile("" : "+v"(tid)); const int lane = tid & 63;
        LAS float* btab = (LAS float*)(lds + EXTRA_OFF);
        LAS float* lamp = btab + 768;
        for (int i = tid; i < 768; i += NWAVES * 64) { const int h = i / 192, idx = i % 192; const int rel = idx - 128; btab[i] = args.in[I_RELB][t5_bucket(rel) * 4 + h] * LOG2E; }
        if (wave == 0) { const float a = wave_sum(args.in[I_LQ1][lane] * args.in[I_LK1][lane]), b = wave_sum(args.in[I_LQ2][lane] * args.in[I_LK2][lane]); if (lane == 0) lamp[0] = expf(a) - expf(b) + LAMBDA_INIT; }
        __syncthreads();
        const float lam = lamp[0];
#if !NAIVE_SB
        REP_BEGIN(20)
        for (int vb = bx; vb < 256; vb += G) att::sb_head(lds, PROJ, METAKV, MIX, vb >> 3, vb & 7);
        REP_END(20)
#else
        for (int it = gw; it < BATCH * 8 * 32; it += NGW) {
            const int qb = it & 31, h = (it >> 5) & 7, b = it >> 8; const int r = qb * 64 + lane;
            const size_t rowq = (size_t)b * SEQ + r;
            unsigned q[32];
            { const u32x4* qp = (const u32x4*)(PROJ + rowq * DIN + COL_SBQ + h * 64);
#pragma unroll
              for (int i = 0; i < 8; ++i) { const u32x4 t4 = qp[i]; q[4 * i] = t4.x; q[4 * i + 1] = t4.y; q[4 * i + 2] = t4.z; q[4 * i + 3] = t4.w; } }
            float o[64];
#pragma unroll
            for (int d = 0; d < 64; ++d) o[d] = 0.f;
            float carry = 1.0f;
            const int jmax = qb * 64 + 62;
            for (int jj = jmax + 16; jj >= 0; --jj) {
                const bool meta = jj < 16; const int j = jj - 16;
                const bf16_t* krow = meta ? METAKV + (size_t)jj * DIN : PROJ + ((size_t)b * SEQ + j) * DIN;
                const u32x4* kp = (const u32x4*)(krow + COL_SBK + h * 64); const u32x4* vp = (const u32x4*)(krow + COL_SBV + h * 64);
                float z = 0.f;
#pragma unroll
                for (int i = 0; i < 8; ++i) { const u32x4 k4 = kp[i];
                    z += bf_lo(q[4 * i]) * bf_lo(k4.x) + bf_hi(q[4 * i]) * bf_hi(k4.x); z += bf_lo(q[4 * i + 1]) * bf_lo(k4.y) + bf_hi(q[4 * i + 1]) * bf_hi(k4.y);
                    z += bf_lo(q[4 * i + 2]) * bf_lo(k4.z) + bf_hi(q[4 * i + 2]) * bf_hi(k4.z); z += bf_lo(q[4 * i + 3]) * bf_lo(k4.w) + bf_hi(q[4 * i + 3]) * bf_hi(k4.w); }
                const float e = __builtin_amdgcn_exp2f(fminf(z, 100.f)); const float p = 1.0f / (1.0f + e);
                const bool vis = meta || (j < r);
                const float w = vis ? (1.0f - p) * carry : 0.f; carry = vis ? carry * p : carry;
#pragma unroll
                for (int i = 0; i < 8; ++i) { const u32x4 v4 = vp[i];
                    o[8 * i] += w * bf_lo(v4.x); o[8 * i + 1] += w * bf_hi(v4.x); o[8 * i + 2] += w * bf_lo(v4.y); o[8 * i + 3] += w * bf_hi(v4.y);
                    o[8 * i + 4] += w * bf_lo(v4.z); o[8 * i + 5] += w * bf_hi(v4.z); o[8 * i + 6] += w * bf_lo(v4.w); o[8 * i + 7] += w * bf_hi(v4.w); }
            }
            u32x4* op = (u32x4*)(MIX + rowq * D + h * 64);
#pragma unroll
            for (int i = 0; i < 8; ++i) { u32x4 w; w.x = pk2(o[8 * i], o[8 * i + 1]); w.y = pk2(o[8 * i + 2], o[8 * i + 3]); w.z = pk2(o[8 * i + 4], o[8 * i + 5]); w.w = pk2(o[8 * i + 6], o[8 * i + 7]); op[i] = w; }
        }
#endif
#if !NAIVE_DF
        __syncthreads();
        REP_BEGIN(21)
        for (int vb = bx; vb < 256; vb += G) { const int pairi = (vb >> 4) * 8 + (vb & 7), which = (vb >> 3) & 1;
            att::df_head(lds, (LAS float*)(lds + GIDX_OFF), btab, lam, args.in[I_SUBLN], PROJ, METAKV, MIX, pairi >> 2, pairi & 3, which); }
        REP_END(21)
#else
        for (int it = gw; it < BATCH * 4 * 32; it += NGW) {
            const int c = it & 31, hd = (it >> 5) & 3, b = it >> 7; const int r = c * 64 + lane;
            const size_t rowq = (size_t)b * SEQ + r;
            float* tmp = TMP + (rowq * 4 + hd) * 128;
            const int nreal = c * 64 + 64;
            for (int s = 0; s < 2; ++s) {
                const int gh = 2 * hd + s;
                unsigned q[32];
                { const u32x4* qp = (const u32x4*)(PROJ + rowq * DIN + COL_DFQ + gh * 64);
#pragma unroll
                  for (int i = 0; i < 8; ++i) { const u32x4 t4 = qp[i]; q[4 * i] = t4.x; q[4 * i + 1] = t4.y; q[4 * i + 2] = t4.z; q[4 * i + 3] = t4.w; } }
                float mx = -1e30f, l = 0.f, ss = 0.f;
                for (int pass = 0; pass < 3; ++pass) {
                    float o[64];
#pragma unroll
                    for (int d = 0; d < 64; ++d) o[d] = 0.f;
                    const float il = pass >= 1 ? 1.0f / l : 0.f; const int dh = pass == 2 ? 64 : 0;
                    for (int jj = 0; jj < nreal + 16; ++jj) {
                        const bool meta = jj < 16; const int j = jj - 16;
                        const bf16_t* krow = meta ? METAKV + (size_t)jj * DIN : PROJ + ((size_t)b * SEQ + j) * DIN;
                        const u32x4* kp = (const u32x4*)(krow + COL_DFK + gh * 64);
                        float z = 0.f;
#pragma unroll
                        for (int i = 0; i < 8; ++i) { const u32x4 k4 = kp[i];
                            z += bf_lo(q[4 * i]) * bf_lo(k4.x) + bf_hi(q[4 * i]) * bf_hi(k4.x); z += bf_lo(q[4 * i + 1]) * bf_lo(k4.y) + bf_hi(q[4 * i + 1]) * bf_hi(k4.y);
                            z += bf_lo(q[4 * i + 2]) * bf_lo(k4.z) + bf_hi(q[4 * i + 2]) * bf_hi(k4.z); z += bf_lo(q[4 * i + 3]) * bf_lo(k4.w) + bf_hi(q[4 * i + 3]) * bf_hi(k4.w); }
                        int rel = meta ? (jj - 16 - r) : (j - r); rel = rel < -128 ? -128 : rel;
                        z += btab[hd * 192 + rel + 128];
                        if (pass == 0) { const float mn = fmaxf(mx, z); l = l * __builtin_amdgcn_exp2f(mx - mn) + __builtin_amdgcn_exp2f(z - mn); mx = mn; }
                        else { const float w = __builtin_amdgcn_exp2f(z - mx) * il; const u32x4* vp = (const u32x4*)(krow + COL_DFV + hd * 128 + dh);
#pragma unroll
                            for (int i = 0; i < 8; ++i) { const u32x4 v4 = vp[i];
                                o[8 * i] += w * bf_lo(v4.x); o[8 * i + 1] += w * bf_hi(v4.x); o[8 * i + 2] += w * bf_lo(v4.y); o[8 * i + 3] += w * bf_hi(v4.y);
                                o[8 * i + 4] += w * bf_lo(v4.z); o[8 * i + 5] += w * bf_hi(v4.z); o[8 * i + 6] += w * bf_lo(v4.w); o[8 * i + 7] += w * bf_hi(v4.w); } }
                    }
                    if (pass >= 1) {
                        if (s == 0) {
#pragma unroll
                            for (int d = 0; d < 64; d += 4) *(f32x4*)(tmp + dh + d) = (f32x4){o[d], o[d + 1], o[d + 2], o[d + 3]};
                        } else {
#pragma unroll
                            for (int d = 0; d < 64; d += 4) { const f32x4 o0 = *(const f32x4*)(tmp + dh + d); f32x4 a; a.x = o0.x - lam * o[d]; a.y = o0.y - lam * o[d + 1]; a.z = o0.z - lam * o[d + 2]; a.w = o0.w - lam * o[d + 3];
                                ss += (a.x * a.x + a.y * a.y) + (a.z * a.z + a.w * a.w); *(f32x4*)(tmp + dh + d) = a; }
                        }
                    }
                }
                if (s == 1) {
                    const float rr = (1.0f - LAMBDA_INIT) / sqrtf(ss * (1.0f / 128.0f) + SUBLN_EPS);
                    const float* sg = args.in[I_SUBLN];
                    u32x4* op = (u32x4*)(MIX + rowq * D + 512 + hd * 128);
#pragma unroll 4
                    for (int i = 0; i < 16; ++i) { const f32x4 a0 = *(const f32x4*)(tmp + 8 * i), a1 = *(const f32x4*)(tmp + 8 * i + 4); const f32x4 g0 = *(const f32x4*)(sg + 8 * i), g1 = *(const f32x4*)(sg + 8 * i + 4);
                        u32x4 w; w.x = pk2(a0.x * rr * g0.x, a0.y * rr * g0.y); w.y = pk2(a0.z * rr * g0.z, a0.w * rr * g0.w); w.z = pk2(a1.x * rr * g1.x, a1.y * rr * g1.y); w.w = pk2(a1.z * rr * g1.z, a1.w * rr * g1.w); op[i] = w; }
                }
            }
        }
#endif
        if (BOTH(2)) GRID_BAR();
    }

    if (IN(3)) {
        REP_BEGIN(3)
        pg8::Gemm g{MIX, WoutT, 0, nullptr}; pg8::StaticOrder S; S.init(T, D, G, bx);
        pg8::EpiRes E{x, H1, (float*)(ws + WS_ROWSS)};
        pg8::gemm_phase<pg8::EpiRes, pg8::StaticOrder, false, false>(lds, g, S, E, 0);
        REP_END(3)
        if (BOTH(3)) GRID_BAR();
    }

    if (IN(4)) {
        REP_BEGIN(4)
        int tid = threadIdx.x; asm volatile("" : "+v"(tid)); const int lane = tid & 63, r32 = lane & 31, hi = lane >> 5; const bool hib = hi != 0;
        LAS bf16_t* wt = (LAS bf16_t*)lds;
        LAS float* gl = (LAS float*)(lds + 66048);
        LAS int* hist = (LAS int*)(lds + EXTRA_OFF);
        const float* wr_g = args.in[I_WR];
        for (int idx = tid; idx < 32 * 1024; idx += NWAVES * 64) wt[(idx & 31) * 1032 + (idx >> 5)] = (bf16_t)f2bf(wr_g[idx]);
        for (int idx = tid; idx < 1024; idx += NWAVES * 64) gl[idx] = args.in[I_FNORM][idx];
        const float* rowss = (const float*)(ws + WS_ROWSS);
        float bias[16];
#pragma unroll
        for (int r = 0; r < 16; ++r) bias[r] = args.in[I_BR][att::crow(r, hi)];
        for (int blk = bx; blk < 256; blk += G) {
            __syncthreads();
            if (tid < 32) hist[tid] = 0;
            __syncthreads();
            const int tok = blk * 256 + wave * 32 + r32;
            float rs;
            { const f32x4* sp = (const f32x4*)(rowss + (size_t)tok * 16); const f32x4 s0 = sp[0], s1 = sp[1], s2 = sp[2], s3 = sp[3];
              const float ssum = (((s0[0] + s0[1]) + (s0[2] + s0[3])) + ((s1[0] + s1[1]) + (s1[2] + s1[3]))) + (((s2[0] + s2[1]) + (s2[2] + s2[3])) + ((s3[0] + s3[1]) + (s3[2] + s3[3])));
              rs = 1.0f / sqrtf(ssum * (1.f / D) + NORM_EPS); }
            const bf16_t* xrow = H1 + (size_t)tok * D + 8 * hi;
            unsigned char* orow = XN8 + (size_t)tok * D + 8 * hi;
            const LAS bf16_t* wrow = wt + r32 * 1032 + 8 * hi;
            att::f32x16 acc = {};
#pragma unroll 1
            for (int sc = 0; sc < 8; ++sc) {
                f32x4 xv[16];
#pragma unroll
                for (int s8 = 0; s8 < 8; ++s8) { const u32x4 hb = *(const u32x4*)(xrow + (sc * 8 + s8) * 16);
                    xv[2 * s8] = (f32x4){bf_lo(hb.x), bf_hi(hb.x), bf_lo(hb.y), bf_hi(hb.y)}; xv[2 * s8 + 1] = (f32x4){bf_lo(hb.z), bf_hi(hb.z), bf_lo(hb.w), bf_hi(hb.w)}; }
#pragma unroll
                for (int s8 = 0; s8 < 8; ++s8) { const int sk = (sc * 8 + s8) * 16;
                    const f32x4 g0 = *(const LAS f32x4*)(gl + sk + 8 * hi), g1 = *(const LAS f32x4*)(gl + sk + 8 * hi + 4);
                    const f32x4 y0 = xv[2 * s8] * g0 * rs, y1 = xv[2 * s8 + 1] * g1 * rs;
                    u32x4 bw; bw.x = cvt_pk_bf16(y0[0], y0[1]); bw.y = cvt_pk_bf16(y0[2], y0[3]); bw.z = cvt_pk_bf16(y1[0], y1[1]); bw.w = cvt_pk_bf16(y1[2], y1[3]);
                    u32x2 o8; o8.x = pk4_fp8(y0[0], y0[1], y0[2], y0[3]); o8.y = pk4_fp8(y1[0], y1[1], y1[2], y1[3]);
                    *(u32x2*)(orow + sk) = o8;
                    const bf16x8 af = *(const LAS bf16x8*)(wrow + sk);
                    acc = __builtin_amdgcn_mfma_f32_32x32x16_bf16(af, __builtin_bit_cast(bf16x8, bw), acc, 0, 0, 0); }
            }
            float v[16];
#pragma unroll
            for (int r = 0; r < 16; ++r) v[r] = acc[r] + bias[r];
            float cv[8]; int ce[8];
#pragma unroll
            for (int k = 0; k < 4; ++k) { float m = v[0]; int mi = 0;
#pragma unroll
                for (int r = 1; r < 16; ++r) { const bool c = v[r] > m; m = c ? v[r] : m; mi = c ? r : mi; }
#pragma unroll
                for (int r = 0; r < 16; ++r) v[r] = (r == mi) ? -3.0e38f : v[r];
                cv[k] = m; ce[k] = (mi & 3) + 8 * (mi >> 2) + 4 * hi; }
#pragma unroll
            for (int k = 0; k < 4; ++k) { cv[4 + k] = att::partner32(cv[k], hib); ce[4 + k] = __builtin_bit_cast(int, att::partner32(__builtin_bit_cast(float, ce[k]), hib)); }
            float tv[4]; int te4[4];
#pragma unroll
            for (int k = 0; k < 4; ++k) { float m = cv[0]; int mi = 0, me = ce[0];
#pragma unroll
                for (int c8 = 1; c8 < 8; ++c8) { const bool c = cv[c8] > m || (cv[c8] == m && ce[c8] < me); m = c ? cv[c8] : m; mi = c ? c8 : mi; me = c ? ce[c8] : me; }
                tv[k] = m; te4[k] = me;
#pragma unroll
                for (int c8 = 0; c8 < 8; ++c8) cv[c8] = (c8 == mi) ? -3.0e38f : cv[c8]; }
            const float e1 = __expf(tv[1] - tv[0]), e2 = __expf(tv[2] - tv[0]), e3 = __expf(tv[3] - tv[0]); const float inv = 1.0f / (((1.0f + e1) + e2) + e3);
            if (!hib) {
                { const int lr = atomicAdd((int*)(hist + te4[0]), 1); tok_e[tok * 4 + 0] = te4[0]; tok_g[tok * 4 + 0] = inv; tok_lr[tok * 4 + 0] = lr; }
                { const int lr = atomicAdd((int*)(hist + te4[1]), 1); tok_e[tok * 4 + 1] = te4[1]; tok_g[tok * 4 + 1] = e1 * inv; tok_lr[tok * 4 + 1] = lr; }
                { const int lr = atomicAdd((int*)(hist + te4[2]), 1); tok_e[tok * 4 + 2] = te4[2]; tok_g[tok * 4 + 2] = e2 * inv; tok_lr[tok * 4 + 2] = lr; }
                { const int lr = atomicAdd((int*)(hist + te4[3]), 1); tok_e[tok * 4 + 3] = te4[3]; tok_g[tok * 4 + 3] = e3 * inv; tok_lr[tok * 4 + 3] = lr; } }
            __syncthreads();
            if (tid < 32) cnt[blk * 32 + tid] = hist[tid];
        }
        __syncthreads();
        REP_END(4)
        if (BOTH(4)) GRID_BAR();
    }

    if (IN(5)) {
        int tid = threadIdx.x; asm volatile("" : "+v"(tid)); const int lane = tid & 63;
        LAS int* tot = (LAS int*)(lds + EXTRA_OFF); LAS int* tstart = tot + 32; LAS int* pref = tstart + 40;
        if (tid < 32) { int s = 0; for (int w = 0; w < 256; ++w) s += cnt[w * 32 + tid]; tot[tid] = s; }
        __syncthreads();
        if (tid == 0) { int a = 0; for (int e = 0; e < 32; ++e) { tstart[e] = a; a += (tot[e] + 255) >> 8; } tstart[32] = a; }
        __syncthreads();
        for (int blk = bx; blk < 256; blk += G) {
            if (tid < 32) { int s = 0; for (int w = 0; w < blk; ++w) s += cnt[w * 32 + tid]; pref[tid] = s; }
            __syncthreads();
            for (int a = tid; a < 1024; a += NWAVES * 64) { const int idx = blk * 1024 + a; const int e = tok_e[idx]; const int pos = tstart[e] * 256 + pref[e] + tok_lr[idx];
                rowtok[pos] = (unsigned)(idx >> 2); rowsg[2 * pos] = idx; rowsg[2 * pos + 1] = __builtin_bit_cast(int, tok_g[idx]); }
            __syncthreads();
        }
        for (int e = bx; e < 32; e += G)
            for (int p = tstart[e] * 256 + tot[e] + tid; p < tstart[e + 1] * 256; p += NWAVES * 64) { rowtok[p] = 0u; rowsg[2 * p] = -1; rowsg[2 * p + 1] = 0; }
        if (bx == 0) { if (tid < 32) for (int tl = tstart[tid]; tl < tstart[tid + 1]; ++tl) tilee[tl] = (unsigned char)tid; if (tid == 0) tilee_hdr[0] = tstart[32]; }
        __syncthreads();
        if (BOTH(5)) GRID_BAR();
    }

    if (IN(6)) {
        REP_BEGIN(6)
        int tid = threadIdx.x; asm volatile("" : "+v"(tid)); const int lane = tid & 63;
        const int NTl = tilee_hdr[0];
        LAS unsigned char* te = lds + TE_OFF; LAS unsigned short* gidx = (LAS unsigned short*)(lds + GIDX_OFF);
        for (int i = tid; i < MAXTILES; i += NWAVES * 64) te[i] = i < NTl ? tilee[i] : (unsigned char)0;
        __syncthreads();
        pg8::GroupedOrder S; S.init(NTl, 8, G, bx, 0, te);
        for (int i = 0; i < MAXSLOTS; ++i) { pg8::Unit u; if (S.next(i, u)) { if (tid < 256) gidx[i * 256 + tid] = (unsigned short)rowtok[u.pm * 256 + tid]; } }
        __syncthreads();
        pg8::Gemm g{XN8, W1T, (size_t)2048 * D, gidx};
        pg8::EpiSwiglu E{ACT, args.in[I_B1]};
        pg8::gemm_phase<pg8::EpiSwiglu, pg8::GroupedOrder, true, true>(lds, g, S, E, 0);
        REP_END(6)
        if (BOTH(6)) GRID_BAR();
    }
    if (IN(7)) {
        REP_BEGIN(7)
        int tid = threadIdx.x; asm volatile("" : "+v"(tid)); const int lane = tid & 63;
        const int NTl = tilee_hdr[0];
        LAS unsigned char* te = lds + TE_OFF;
        __syncthreads();
        for (int i = tid; i < MAXTILES; i += NWAVES * 64) te[i] = i < NTl ? tilee[i] : (unsigned char)0;
        __syncthreads();
        pg8::GroupedOrder S; S.init(NTl, 4, G, bx, 0, te);
        pg8::Gemm g{ACT, W2T, (size_t)D * D, nullptr};
        pg8::EpiDown E{Y, args.in[I_B2], rowsg, ws + WS_DUMP};
        pg8::gemm_phase<pg8::EpiDown, pg8::GroupedOrder, false, true>(lds, g, S, E, 0);
        REP_END(7)
        if (BOTH(7)) GRID_BAR();
    }

    if (IN(8)) {
        int tid = threadIdx.x; asm volatile("" : "+v"(tid)); const int lane = tid & 63;
        f32x4 gn[4];
#pragma unroll
        for (int j = 0; j < 4; ++j) gn[j] = ((const f32x4*)args.in[I_FINAL])[lane + 64 * j];
        for (int tok = gw; tok < T; tok += NGW) {
            f32x4* hp = (f32x4*)(args.out + (size_t)tok * D) + lane; const u32x2* hb = (const u32x2*)(H1 + (size_t)tok * D) + lane; f32x4 v[4]; float s = 0.f;
#pragma unroll
            for (int j = 0; j < 4; ++j) { const u32x2 h2 = hb[64 * j]; v[j] = (f32x4){bf_lo(h2.x), bf_hi(h2.x), bf_lo(h2.y), bf_hi(h2.y)}; }
#pragma unroll
            for (int k = 0; k < 4; ++k) { const unsigned* yp = (const unsigned*)(Y + ((size_t)tok * 4 + k) * D) + lane;
#pragma unroll
                for (int j = 0; j < 4; ++j) { const int y4 = (int)yp[64 * j]; v[j].x += __builtin_amdgcn_cvt_f32_fp8(y4, 0); v[j].y += __builtin_amdgcn_cvt_f32_fp8(y4, 1); v[j].z += __builtin_amdgcn_cvt_f32_fp8(y4, 2); v[j].w += __builtin_amdgcn_cvt_f32_fp8(y4, 3); } }
#pragma unroll
            for (int j = 0; j < 4; ++j) s += (v[j].x * v[j].x + v[j].y * v[j].y) + (v[j].z * v[j].z + v[j].w * v[j].w);
            const float r = 1.0f / sqrtf(wave_sum(s) * (1.f / D) + NORM_EPS);
#pragma unroll
            for (int j = 0; j < 4; ++j) hp[64 * j] = v[j] * r * gn[j];
        }
    }
#undef IN
#undef INC
#undef BOTH
}

#if ONE_LAUNCH
constexpr int NKERN = 1;
static const void* kern_of(int) { return (const void*)fwd_kernel<-1>; }
#else
constexpr int NKERN = 9;
static const void* kern_of(int c) {
    switch (c) { case 0: return (const void*)fwd_kernel<0>; case 1: return (const void*)fwd_kernel<1>; case 2: return (const void*)fwd_kernel<2>; case 3: return (const void*)fwd_kernel<3>; case 4: return (const void*)fwd_kernel<4>;
        case 5: return (const void*)fwd_kernel<5>; case 6: return (const void*)fwd_kernel<6>; case 7: return (const void*)fwd_kernel<7>; default: return (const void*)fwd_kernel<8>; }
}
#endif
extern "C" void kernel_launch(void* const* d_in, const int* in_sizes, int n_in, void* d_out, int out_size, void* d_ws, size_t ws_size, hipStream_t stream) {
    static int grid = 0;
    if (grid == 0) {
        if (n_in != 19 || out_size != T * D || ws_size < WS_END) { fprintf(stderr, "kernel_launch: unexpected shapes (n_in %d, out %d, ws %zu)\n", n_in, out_size, ws_size); grid = -1; return; }
        for (int c = 0; c < NKERN; ++c) if (hipFuncSetAttribute(kern_of(c), hipFuncAttributeMaxDynamicSharedMemorySize, LDS_BYTES) != hipSuccess) { fprintf(stderr, "kernel_launch: hipFuncSetAttribute failed\n"); grid = -1; return; }
        int dev = 0, cus = 0, per_cu = 0;
        (void)hipGetDevice(&dev); (void)hipDeviceGetAttribute(&cus, hipDeviceAttributeMultiprocessorCount, dev);
        (void)hipOccupancyMaxActiveBlocksPerMultiprocessor(&per_cu, kern_of(0), NWAVES * 64, LDS_BYTES);
        (void)hipGetLastError();
        grid = cus > 0 ? cus : 256;
        if (grid > 256) grid = 256;
    }
    if (grid < 0) return;
    (void)hipMemsetAsync((char*)d_ws + WS_CTL, 0, CTL_ZERO_BYTES, stream);
    Args a{};
    for (int i = 0; i < 19; ++i) a.in[i] = (const float*)d_in[i];
    a.out = (float*)d_out; a.ws = (unsigned char*)d_ws;
    constexpr int NPH = 9;
#if ONE_LAUNCH
    a.ph_lo = 0; a.ph_hi = NPH;
    hipLaunchKernelGGL(fwd_kernel<-1>, dim3(grid), dim3(NWAVES * 64), LDS_BYTES, stream, a);
#else
    for (int p = 0; p < NPH; ++p) { a.ph_lo = p; a.ph_hi = p + 1; const int cls = p; void* kargs[] = {&a};
        (void)hipLaunchKernel(kern_of(cls), dim3(grid), dim3(NWAVES * 64), kargs, LDS_BYTES, stream); }
#endif
}
```

```cpp
#include <hip/hip_runtime.h>
#include <cstdio>
#include <cstdint>

#ifndef ONE_LAUNCH
#define ONE_LAUNCH 1
#endif
#ifndef REP_PHASE
#define REP_PHASE -1
#endif
#define REP_COUNT 3
#define NREP(k) ((REP_PHASE == (k)) ? REP_COUNT : 1)
#define REP_BEGIN(k) for (int rep_ = 0; rep_ < NREP(k); ++rep_) {
#define REP_END(k) if (rep_ + 1 < NREP(k)) GRID_BAR(); }
#ifndef NAIVE_SB
#define NAIVE_SB 0
#endif
#ifndef NAIVE_DF
#define NAIVE_DF 0
#endif

#define LAS __attribute__((address_space(3)))
#define GAS __attribute__((address_space(1)))
typedef unsigned short bf16_t;
typedef short bf16x8 __attribute__((ext_vector_type(8)));
typedef float f32x4 __attribute__((ext_vector_type(4)));
typedef float f32x2 __attribute__((ext_vector_type(2)));
typedef unsigned u32x4 __attribute__((ext_vector_type(4)));
typedef unsigned u32x2 __attribute__((ext_vector_type(2)));

constexpr int D = 1024, BATCH = 32, SEQ = 2048, T = BATCH * SEQ, NMETA = 16, DIN = 3072, NEXP = 32, TOPK = 4;
constexpr int COL_SBQ = 0, COL_SBK = 512, COL_SBV = 1024, COL_DFQ = 1536, COL_DFK = 2048, COL_DFV = 2560;
constexpr int MAXTILES = 1024 + 32, MAXSLOTS = 33;
constexpr float LOG2E = 1.4426950408889634f;
constexpr float C2 = 0.125f * LOG2E;
constexpr float NORM_EPS = 1e-6f, SUBLN_EPS = 1e-5f, LAMBDA_INIT = 0.2f;
constexpr int NWAVES = 8;

constexpr size_t MiB = 1u << 20;
constexpr size_t WS_CTL = 0, CTL_ZERO_BYTES = 32768;
constexpr size_t WS_WIN = 2 * MiB;
constexpr size_t WS_WOUT = 8 * MiB;
constexpr size_t WS_W1 = 10 * MiB;
constexpr size_t WS_W2 = 74 * MiB;
constexpr size_t WS_SMALL = 106 * MiB;
constexpr size_t WS_METAKV = WS_SMALL;
constexpr size_t WS_TOKE = WS_SMALL + 1 * MiB;
constexpr size_t WS_TOKG = WS_SMALL + 2 * MiB;
constexpr size_t WS_TOKLR = WS_SMALL + 3 * MiB;
constexpr size_t WS_CNT = WS_SMALL + 4 * MiB;
constexpr size_t WS_ROWTOK = WS_SMALL + 5 * MiB;
constexpr size_t WS_ROWSG = WS_SMALL + 7 * MiB;
constexpr size_t WS_TILEE = WS_SMALL + 10 * MiB;
constexpr size_t WS_DUMP = WS_SMALL + 11 * MiB;
constexpr size_t WS_ROWSS = WS_SMALL + 12 * MiB;
constexpr size_t WS_XN8 = 122 * MiB;
constexpr size_t WS_Y = 186 * MiB;
constexpr size_t WS_PROJ = WS_Y;
constexpr size_t WS_MIX = WS_Y + 384 * MiB;
constexpr size_t WS_H1 = 442 * MiB;
constexpr size_t WS_ACT = 698 * MiB;
constexpr size_t WS_XN = WS_ACT;
constexpr size_t WS_TMP = WS_ACT + 128 * MiB;
constexpr size_t WS_END = 962 * MiB;
constexpr int CW_BAR = 4096;

constexpr int RING_BYTES = 131072;
constexpr int GIDX_OFF = RING_BYTES;
constexpr int TE_OFF = GIDX_OFF + 16896;
constexpr int EXTRA_OFF = TE_OFF + 1088;
constexpr int MISC_OFF = EXTRA_OFF + 4096;
constexpr int LDS_BYTES = 155648;
static_assert(MISC_OFF + 128 <= LDS_BYTES, "LDS map");

#define LDS_WAIT() asm volatile("s_waitcnt lgkmcnt(0)" ::: "memory")
#define VM_WAIT() asm volatile("s_waitcnt vmcnt(0)" ::: "memory")
__device__ __forceinline__ unsigned f2bf(float f) { unsigned u = __builtin_bit_cast(unsigned, f); return (u + 0x7fffu + ((u >> 16) & 1u)) >> 16; }
__device__ __forceinline__ unsigned pk2(float lo, float hi) { return f2bf(lo) | (f2bf(hi) << 16); }
__device__ __forceinline__ float bf_lo(unsigned u) { return __builtin_bit_cast(float, u << 16); }
__device__ __forceinline__ float bf_hi(unsigned u) { return __builtin_bit_cast(float, u & 0xffff0000u); }
__device__ __forceinline__ unsigned cvt_pk_bf16(float lo, float hi) { unsigned r; asm volatile("v_cvt_pk_bf16_f32 %0, %1, %2" : "=v"(r) : "v"(lo), "v"(hi)); return r; }
__device__ __forceinline__ unsigned pk4_fp8(float a, float b, float c, float d) { int w = __builtin_amdgcn_cvt_pk_fp8_f32(a, b, 0, false); w = __builtin_amdgcn_cvt_pk_fp8_f32(c, d, w, true); return (unsigned)w; }
__device__ __forceinline__ float wave_sum(float v) {
#pragma unroll
    for (int o = 1; o < 64; o <<= 1) v += __shfl_xor(v, o);
    return v;
}

namespace pg8 {
constexpr int BM = 256, BK = 64, HALF = 128, HTB = HALF * BK * 2, STAGE_BYTES = 8 * HTB, NXCD = 8, WGM = 8, K = 1024, NT_K = K / BK;
__host__ __device__ __forceinline__ int lds_byte(int r, int c, int SH = 5) { const int st = (r >> 4) * 2 + (c >> 5), rr = r & 15, cc = c & 31, ob = rr * 64 + cc * 2; return st * 1024 + (ob ^ (((ob >> 9) & 1) << SH)); }
__host__ __device__ __forceinline__ void stage_rc(int b, int& R, int& C, int SH = 5) { const int st = b / 1024, sb = b % 1024, swz = sb ^ (((sb >> 9) & 1) << SH); R = (st >> 1) * 16 + swz / 64; C = (st & 1) * 32 + (swz % 64) / 2; }
__host__ __device__ __forceinline__ int perm32(int rho) { const int n = rho >> 4, i = rho & 15; return 8 * (i >> 2) + 4 * n + (i & 3); }

struct Unit { int pm, pn, e; };
struct Gemm { const void* A; const void* Bt; size_t estride; const LAS unsigned short* gidx; };

struct StaticOrder {
    int nM, nN, nwg, G, c;
    __device__ void init(int M, int N, int G_, int c_) { nM = M / BM; nN = N / BM; nwg = nM * nN; G = G_; c = c_; }
    __device__ bool next(int i, Unit& u) const {
        const long L = (long)i * G + c; if (L >= nwg) return false;
        int wgid = (int)L; { const int q = nwg / NXCD, r = nwg % NXCD, xcd = wgid % NXCD, off = wgid / NXCD; wgid = (xcd < r ? xcd * (q + 1) : r * (q + 1) + (xcd - r) * q) + off; }
        const int nig = WGM * nN, gid = wgid / nig, fm = gid * WGM, gsz = (nM - fm) < WGM ? (nM - fm) : WGM;
        u.pm = fm + ((wgid % nig) % gsz); u.pn = (wgid % nig) / gsz; u.e = 0; return true;
    }
};
struct GroupedOrder {
    int nM, nN, nwg, G, c, tile0; const LAS unsigned char* te;
    __device__ void init(int ntiles, int nN_, int G_, int c_, int tile0_, const LAS unsigned char* te_) { nM = ntiles; nN = nN_; nwg = nM * nN; G = G_; c = c_; tile0 = tile0_; te = te_; }
    __device__ bool next(int i, Unit& u) const {
        const long L = (long)i * G + c; if (L >= nwg) return false;
        int wgid = (int)L; { const int q = nwg / NXCD, r = nwg % NXCD, xcd = wgid % NXCD, off = wgid / NXCD; wgid = (xcd < r ? xcd * (q + 1) : r * (q + 1) + (xcd - r) * q) + off; }
        const int nig = WGM * nN, gid = wgid / nig, fm = gid * WGM, gsz = (nM - fm) < WGM ? (nM - fm) : WGM;
        u.pm = tile0 + fm + ((wgid % nig) % gsz); u.pn = (wgid % nig) / gsz; u.e = __builtin_amdgcn_readfirstlane((int)te[u.pm]); return true;
    }
};

struct EpiProj {
    static constexpr bool PERM = true;
    bf16_t* O;
    __device__ __forceinline__ void operator()(const f32x4 (&acc)[2][2][4][2], const Unit& u, int wr, int wc, int fr, int fq) const {
        const int row0 = u.pm * BM + wr * 64 + fr; const int col0 = u.pn * BM + wc * 32 + 8 * fq;
        const float sc = (u.pn < 2 || u.pn == 6 || u.pn == 7) ? C2 : 1.0f;
#pragma unroll
        for (int ai = 0; ai < 2; ++ai)
#pragma unroll
            for (int m = 0; m < 4; ++m) { bf16_t* rowp = O + (size_t)(row0 + ai * HALF + m * 16) * DIN + col0;
#pragma unroll
                for (int bj = 0; bj < 2; ++bj) { const f32x4 v0 = acc[ai][bj][m][0] * sc, v1 = acc[ai][bj][m][1] * sc;
                    u32x4 w; w.x = cvt_pk_bf16(v0[0], v0[1]); w.y = cvt_pk_bf16(v0[2], v0[3]); w.z = cvt_pk_bf16(v1[0], v1[1]); w.w = cvt_pk_bf16(v1[2], v1[3]);
                    *(u32x4*)(rowp + bj * HALF) = w; } }
    }
};
struct EpiRes {
    static constexpr bool PERM = true;
    const float* base; bf16_t* out; float* rowss;
    __device__ __forceinline__ void operator()(const f32x4 (&acc)[2][2][4][2], const Unit& u, int wr, int wc, int fr, int fq) const {
        const int col0 = u.pn * BM + wc * 32 + 8 * fq;
#pragma unroll
        for (int ai = 0; ai < 2; ++ai) {
            f32x4 rs[4][2][2];
#pragma unroll
            for (int m = 0; m < 4; ++m) { const float* rp = base + (size_t)(u.pm * BM + ai * HALF + wr * 64 + m * 16 + fr) * D + col0;
#pragma unroll
                for (int bj = 0; bj < 2; ++bj) { rs[m][bj][0] = *(const f32x4*)(rp + bj * HALF); rs[m][bj][1] = *(const f32x4*)(rp + bj * HALF + 4); } }
#pragma unroll
            for (int m = 0; m < 4; ++m) { const int row = u.pm * BM + ai * HALF + wr * 64 + m * 16 + fr; bf16_t* op = out + (size_t)row * D + col0; float ss = 0.f;
#pragma unroll
                for (int bj = 0; bj < 2; ++bj) { const f32x4 v0 = rs[m][bj][0] + acc[ai][bj][m][0], v1 = rs[m][bj][1] + acc[ai][bj][m][1];
                    u32x4 w; w.x = cvt_pk_bf16(v0[0], v0[1]); w.y = cvt_pk_bf16(v0[2], v0[3]); w.z = cvt_pk_bf16(v1[0], v1[1]); w.w = cvt_pk_bf16(v1[2], v1[3]);
                    *(u32x4*)(op + bj * HALF) = w;
                    ss += ((v0[0] * v0[0] + v0[1] * v0[1]) + (v0[2] * v0[2] + v0[3] * v0[3])) + ((v1[0] * v1[0] + v1[1] * v1[1]) + (v1[2] * v1[2] + v1[3] * v1[3])); }
                ss += __shfl_xor(ss, 16); ss += __shfl_xor(ss, 32);
                if (fq == 0) rowss[(size_t)row * 16 + u.pn * 4 + wc] = ss; }
            asm volatile("" ::: "memory");
        }
    }
};
struct EpiSwiglu {
    static constexpr bool PERM = true;
    unsigned char* act; const float* b1;
    __device__ __forceinline__ void operator()(const f32x4 (&acc)[2][2][4][2], const Unit& u, int wr, int wc, int fr, int fq) const {
        const int row0 = u.pm * BM + wr * 64 + fr; const int lc = u.pn * HALF + wc * 32 + 8 * fq;
        const float* bg = b1 + (size_t)u.e * 2048 + lc; const float* bl = bg + 1024;
        f32x4 bgv[2], blv[2];
#pragma unroll
        for (int n = 0; n < 2; ++n) { bgv[n] = *(const f32x4*)(bg + 4 * n); blv[n] = *(const f32x4*)(bl + 4 * n); }
#pragma unroll
        for (int ai = 0; ai < 2; ++ai)
#pragma unroll
            for (int m = 0; m < 4; ++m) { float r[8];
#pragma unroll
                for (int n = 0; n < 2; ++n)
#pragma unroll
                    for (int x = 0; x < 4; ++x) { float g = acc[ai][0][m][n][x] * (1.0f / 32.0f) + bgv[n][x], l = acc[ai][1][m][n][x] * (1.0f / 32.0f) + blv[n][x];
                        g = fminf(g, 7.0f); l = fminf(fmaxf(l, -7.0f), 7.0f);
                        const float sg = __builtin_amdgcn_rcpf(1.0f + __builtin_amdgcn_exp2f(-1.702f * LOG2E * g));
                        r[n * 4 + x] = g * sg * (l + 1.0f); }
                u32x2 w; w.x = pk4_fp8(r[0], r[1], r[2], r[3]); w.y = pk4_fp8(r[4], r[5], r[6], r[7]);
                *(u32x2*)(act + (size_t)(row0 + ai * HALF + m * 16) * D + lc) = w; }
    }
};
struct EpiDown {
    static constexpr bool PERM = true;
    unsigned char* Y; const float* b2; const int* rowsg; unsigned char* dump;
    __device__ __forceinline__ void operator()(const f32x4 (&acc)[2][2][4][2], const Unit& u, int wr, int wc, int fr, int fq) const {
        const int col0 = u.pn * BM + wc * 32 + 8 * fq;
        f32x4 bv[2][2];
#pragma unroll
        for (int bj = 0; bj < 2; ++bj)
#pragma unroll
            for (int n = 0; n < 2; ++n) bv[bj][n] = *(const f32x4*)(b2 + (size_t)u.e * D + col0 + bj * HALF + 4 * n);
        int slotv[8]; float gtv[8];
#pragma unroll
        for (int ai = 0; ai < 2; ++ai)
#pragma unroll
            for (int m = 0; m < 4; ++m) { const int arow = u.pm * BM + ai * HALF + wr * 64 + m * 16 + fr; slotv[ai * 4 + m] = rowsg[2 * arow]; gtv[ai * 4 + m] = __builtin_bit_cast(float, rowsg[2 * arow + 1]); }
#pragma unroll
        for (int i = 0; i < 8; ++i) asm volatile("" : "+v"(slotv[i]), "+v"(gtv[i]));
#pragma unroll
        for (int ai = 0; ai < 2; ++ai)
#pragma unroll
            for (int m = 0; m < 4; ++m) {
                const int slot = slotv[ai * 4 + m]; const float gt = gtv[ai * 4 + m];
                { unsigned char* rowp = (slot >= 0 ? Y + (size_t)slot * D : dump) + col0;
#pragma unroll
                    for (int bj = 0; bj < 2; ++bj) { const f32x4 v0 = (acc[ai][bj][m][0] * (1.0f / 32.0f) + bv[bj][0]) * gt, v1 = (acc[ai][bj][m][1] * (1.0f / 32.0f) + bv[bj][1]) * gt;
                        u32x2 w; w.x = pk4_fp8(v0[0], v0[1], v0[2], v0[3]); w.y = pk4_fp8(v1[0], v1[1], v1[2], v1[3]);
                        *(u32x2*)(rowp + bj * HALF) = w; } }
                asm volatile("" ::: "memory"); }
    }
};

typedef int i32x8 __attribute__((ext_vector_type(8)));
typedef int i32x4 __attribute__((ext_vector_type(4)));
template <bool FP8> struct FragT { typedef bf16x8 A[4][2]; typedef bf16x8 B[2][2]; };
template <> struct FragT<true> { typedef i32x8 A[4]; typedef i32x8 B[2]; };
template <class Epi, class Sched, bool GATHER, bool FP8>
__device__ __forceinline__ void gemm_phase(LAS unsigned char* lds, const Gemm g, const Sched& S, const Epi& E, int tileA0) {
    int tid = threadIdx.x; asm volatile("" : "+v"(tid));
    const int wid = __builtin_amdgcn_readfirstlane(tid >> 6), lane = tid & 63, wr = wid >> 2, wc = wid & 3, fr = lane & 15, fq = lane >> 4;
    constexpr int KB = FP8 ? K : 2 * K;
    constexpr int nt = FP8 ? K / 128 : K / 64;
    unsigned cA[2], voffB[2]; int rA[2];
#pragma unroll
    for (int i = 0; i < 2; ++i) { int R, C; stage_rc(tid * 16 + i * 8192, R, C, FP8 ? 4 : 5); const int Rb = Epi::PERM ? ((R & ~31) + perm32(R & 31)) : R;
        cA[i] = (unsigned)(C * 2); rA[i] = R; voffB[i] = (unsigned)(Rb * KB + C * 2); }
    constexpr size_t kstep = 128;
    constexpr size_t hstep = (size_t)HALF * KB;
    constexpr size_t tstep = 2 * hstep;
    const unsigned ldsw = (unsigned)wid * 1024u;
    const int aoff = FP8 ? lds_byte(wr * 64 + fr, fq * 16, 4) : lds_byte(wr * 64 + fr, fq * 8), boff = FP8 ? lds_byte(wc * 32 + fr, fq * 16, 4) : lds_byte(wc * 32 + fr, fq * 8);
    const int aoff1 = FP8 ? lds_byte(wr * 64 + fr, fq * 16 + 8, 4) : 0, boff1 = FP8 ? lds_byte(wc * 32 + fr, fq * 16 + 8, 4) : 0;
#define PG8_SA(b, h) (((b) * 2 + (h)) * HTB)
#define PG8_SB(b, h) ((4 + (b) * 2 + (h)) * HTB)
#define PG8_STAGE(bufoff, gbase, voff) do { _Pragma("unroll") for (int _i = 0; _i < 2; ++_i) \
        __builtin_amdgcn_global_load_lds((const unsigned*)((const char*)(gbase) + (voff)[_i]), (LAS unsigned*)(lds + (bufoff) + ldsw + _i * 8192), 16, 0, 0); } while (0)
#define PG8_LDA(dst, b, h) do { if constexpr (FP8) { _Pragma("unroll") for (int m = 0; m < 4; ++m) { dst[m].lo = *(const LAS i32x4*)(lds + PG8_SA(b, h) + aoff + m * 2048); dst[m].hi = *(const LAS i32x4*)(lds + PG8_SA(b, h) + aoff1 + m * 2048); } } \
        else { _Pragma("unroll") for (int m = 0; m < 4; ++m) _Pragma("unroll") for (int k = 0; k < 2; ++k) dst[m][k] = *(const LAS bf16x8*)(lds + PG8_SA(b, h) + aoff + m * 2048 + k * 1024); } } while (0)
#define PG8_LDB(dst, b, h) do { if constexpr (FP8) { _Pragma("unroll") for (int n = 0; n < 2; ++n) { dst[n].lo = *(const LAS i32x4*)(lds + PG8_SB(b, h) + boff + n * 2048); dst[n].hi = *(const LAS i32x4*)(lds + PG8_SB(b, h) + boff1 + n * 2048); } } \
        else { _Pragma("unroll") for (int n = 0; n < 2; ++n) _Pragma("unroll") for (int k = 0; k < 2; ++k) dst[n][k] = *(const LAS bf16x8*)(lds + PG8_SB(b, h) + boff + n * 2048 + k * 1024); } } while (0)
#define PG8_MMA(ai, bj, At, Bt) do { __builtin_amdgcn_s_setprio(1); if constexpr (FP8) { _Pragma("unroll") for (int m = 0; m < 4; ++m) _Pragma("unroll") for (int n = 0; n < 2; ++n) \
            acc[ai][bj][m][n] = __builtin_amdgcn_mfma_scale_f32_16x16x128_f8f6f4(Bt[n], At[m], acc[ai][bj][m][n], 0, 0, 0, 0x7f7f7f7f, 0, 0x7f7f7f7f); } \
        else { _Pragma("unroll") for (int m = 0; m < 4; ++m) _Pragma("unroll") for (int n = 0; n < 2; ++n) _Pragma("unroll") for (int k = 0; k < 2; ++k) \
            acc[ai][bj][m][n] = __builtin_amdgcn_mfma_f32_16x16x32_bf16(Bt[n][k], At[m][k], acc[ai][bj][m][n], 0, 0, 0); } __builtin_amdgcn_s_setprio(0); } while (0)
#define PG8_WAIT_V(n) asm volatile("s_waitcnt vmcnt(" #n ")" ::: "memory")
#define PG8_WAIT_L(n) asm volatile("s_waitcnt lgkmcnt(" #n ")" ::: "memory")
#define PG8_BAR __builtin_amdgcn_s_barrier()
#define PG8_SCHED __builtin_amdgcn_sched_barrier(0)
#define PG8_GLOAD(dst, slot, u) do { _Pragma("unroll") for (int h = 0; h < 2; ++h) _Pragma("unroll") for (int i = 0; i < 2; ++i) \
        dst[h][i] = (GATHER ? (unsigned)g.gidx[(slot) * 256 + h * HALF + rA[i]] : (unsigned)(((u).pm - tileA0) * BM + h * HALF + rA[i])) * (unsigned)KB + cA[i]; } while (0)
#define PG8_STAGE_A(bufoff, ptr, h, VG) PG8_STAGE(bufoff, ptr, VG[h])
    Unit cur, nxt; int ui = 0;
    if (!S.next(0, cur)) return;
    f32x4 acc[2][2][4][2];
#pragma unroll
    for (int a = 0; a < 2; ++a)
#pragma unroll
        for (int b = 0; b < 2; ++b)
#pragma unroll
            for (int m = 0; m < 4; ++m)
#pragma unroll
                for (int n = 0; n < 2; ++n) acc[a][b][m][n] = (f32x4){0.f, 0.f, 0.f, 0.f};
    typename FragT<FP8>::A At; typename FragT<FP8>::B B0, B1;
    unsigned vC[2][2];
    PG8_GLOAD(vC, 0, cur);
    const char* const Ab = (const char*)g.A;
    const char* cB = (const char*)g.Bt + (size_t)cur.e * g.estride + (size_t)cur.pn * tstep;
    PG8_STAGE(PG8_SB(0, 0), cB, voffB); PG8_STAGE(PG8_SB(0, 1), cB + hstep, voffB); PG8_STAGE_A(PG8_SA(0, 0), Ab, 0, vC); PG8_STAGE_A(PG8_SA(0, 1), Ab, 1, vC);
    if (wr == 1) PG8_BAR;
    PG8_WAIT_V(2); PG8_BAR;
    PG8_STAGE(PG8_SB(1, 0), cB + kstep, voffB); PG8_STAGE_A(PG8_SA(1, 0), Ab + kstep, 0, vC); PG8_STAGE(PG8_SB(1, 1), cB + hstep + kstep, voffB);
    PG8_WAIT_V(6); PG8_BAR;
    for (;;) {
        const bool has_next = S.next(ui + 1, nxt);
        const char* nB = has_next ? (const char*)g.Bt + (size_t)nxt.e * g.estride + (size_t)nxt.pn * tstep : cB;
#pragma unroll 1
        for (int t = 0; t < nt; t += 2) {
            const bool last = (t == nt - 2);
            const char* a1 = Ab + (size_t)(t + 1) * kstep;
            const char* a2 = last ? Ab : Ab + (size_t)(t + 2) * kstep; const char* b2 = last ? nB : cB + (size_t)(t + 2) * kstep;
            const char* a3 = a2 + kstep; const char* b3 = b2 + kstep;
            PG8_LDB(B0, 0, 0); PG8_LDB(B1, 0, 1); PG8_SCHED; PG8_LDA(At, 0, 0); PG8_STAGE_A(PG8_SA(1, 1), a1, 1, vC);
            if (last && has_next) { PG8_GLOAD(vC, ui + 1, nxt); }
            PG8_WAIT_V(8); PG8_WAIT_L(0); PG8_BAR; PG8_MMA(0, 0, At, B0); PG8_MMA(0, 1, At, B1); PG8_BAR; PG8_SCHED;
            PG8_LDA(At, 0, 1); PG8_STAGE(PG8_SB(0, 0), b2, voffB); PG8_STAGE(PG8_SB(0, 1), b2 + hstep, voffB); PG8_STAGE_A(PG8_SA(0, 0), a2, 0, vC);
            PG8_WAIT_V(8); PG8_WAIT_L(0); PG8_BAR; PG8_MMA(1, 0, At, B0); PG8_MMA(1, 1, At, B1); PG8_BAR; PG8_SCHED;
            PG8_LDB(B0, 1, 0); PG8_LDB(B1, 1, 1); PG8_SCHED; PG8_LDA(At, 1, 0); PG8_STAGE_A(PG8_SA(0, 1), a2, 1, vC);
            PG8_WAIT_V(8); PG8_WAIT_L(0); PG8_BAR; PG8_MMA(0, 0, At, B0); PG8_MMA(0, 1, At, B1); PG8_BAR; PG8_SCHED;
            PG8_LDA(At, 1, 1); PG8_STAGE(PG8_SB(1, 0), b3, voffB); PG8_STAGE(PG8_SB(1, 1), b3 + hstep, voffB); PG8_STAGE_A(PG8_SA(1, 0), a3, 0, vC);
            PG8_WAIT_V(8); PG8_WAIT_L(0); PG8_BAR; PG8_MMA(1, 0, At, B0); PG8_MMA(1, 1, At, B1); PG8_BAR; PG8_SCHED;
        }
        if (wr == 0) PG8_BAR;
        { int fr_ = fr, fq_ = fq; asm volatile("" : "+v"(fr_), "+v"(fq_));
          E(acc, cur, wr, wc, fr_, fq_); }
        if (!has_next) break;
#pragma unroll
        for (int a = 0; a < 2; ++a)
#pragma unroll
            for (int b = 0; b < 2; ++b)
#pragma unroll
                for (int m = 0; m < 4; ++m)
#pragma unroll
                    for (int n = 0; n < 2; ++n) acc[a][b][m][n] = (f32x4){0.f, 0.f, 0.f, 0.f};
        cur = nxt; cB = nB; ++ui;
        if (wr == 1) PG8_BAR;
    }
    PG8_WAIT_V(0);
    PG8_BAR;
#undef PG8_SA
#undef PG8_SB
#undef PG8_STAGE
#undef PG8_LDA
#undef PG8_LDB
#undef PG8_MMA
#undef PG8_WAIT_V
#undef PG8_WAIT_L
#undef PG8_BAR
#undef PG8_SCHED
#undef PG8_GLOAD
#undef PG8_STAGE_A
}
}


namespace att {
typedef float f32x16 __attribute__((ext_vector_type(16)));
typedef short s16x4 __attribute__((ext_vector_type(4)));
typedef short v4i16_t __attribute__((ext_vector_type(4)));
typedef const LAS unsigned char* lptr;
__device__ __forceinline__ int crow(int r, int hi) { return (r & 3) + 8 * (r >> 2) + 4 * hi; }
__device__ __forceinline__ s16x4 vtr(lptr p) { return __builtin_bit_cast(s16x4, __builtin_amdgcn_ds_read_tr16_b64_v4i16((LAS v4i16_t*)p)); }
__device__ __forceinline__ void glds16(const void* g, LAS unsigned char* l) {
    const unsigned dst = (unsigned)__builtin_amdgcn_readfirstlane((int)(unsigned)(size_t)l); unsigned keep;
    asm volatile("s_mov_b32 %0, m0\n\ts_mov_b32 m0, %2\n\ts_nop 0\n\tglobal_load_lds_dwordx4 %1, off\n\ts_mov_b32 m0, %0" : "=&s"(keep) : "v"(g), "s"(dst) : "memory");
}
__device__ __forceinline__ float partner32(float x, bool hi) { auto rr = __builtin_amdgcn_permlane32_swap(__float_as_uint(x), __float_as_uint(x), false, false); return __uint_as_float(hi ? rr[0] : rr[1]); }
__device__ __forceinline__ void kload(bf16x8 (&kf)[8], lptr kslot, int r32, int hi) {
    lptr kb = kslot + hi * 1024 + r32 * 16;
#pragma unroll
    for (int d0 = 0; d0 < 4; ++d0) { kf[2 * d0] = *(const LAS bf16x8*)(kb + d0 * 2048); kf[2 * d0 + 1] = *(const LAS bf16x8*)(kb + d0 * 2048 + 512); }
}
__device__ __forceinline__ void qkt(f32x16& p0, f32x16& p1, const bf16x8 (&kf)[8], const bf16x8 (&qr)[4], const f32x16& c0) {
    __builtin_amdgcn_s_setprio(1);
    p0 = __builtin_amdgcn_mfma_f32_32x32x16_bf16(kf[0], qr[0], c0, 0, 0, 0); p1 = __builtin_amdgcn_mfma_f32_32x32x16_bf16(kf[1], qr[0], c0, 0, 0, 0);
#pragma unroll
    for (int d0 = 1; d0 < 4; ++d0) { p0 = __builtin_amdgcn_mfma_f32_32x32x16_bf16(kf[2 * d0], qr[d0], p0, 0, 0, 0); p1 = __builtin_amdgcn_mfma_f32_32x32x16_bf16(kf[2 * d0 + 1], qr[d0], p1, 0, 0, 0); }
    __builtin_amdgcn_s_setprio(0);
}
__device__ __forceinline__ void vload(bf16x8 (&vf)[8], lptr vp) {
#pragma unroll
    for (int d0 = 0; d0 < 2; ++d0)
#pragma unroll
        for (int ks = 0; ks < 4; ++ks) { const s16x4 lo = vtr(vp + d0 * 4096 + ks * 1024), hi4 = vtr(vp + d0 * 4096 + ks * 1024 + 512);
            vf[d0 * 4 + ks] = (bf16x8){lo[0], lo[1], lo[2], lo[3], hi4[0], hi4[1], hi4[2], hi4[3]}; }
}
__device__ __forceinline__ void pv64(f32x16& o0, f32x16& o1, const bf16x8 (&vf)[8], const bf16x8 (&pa)[4]) {
    __builtin_amdgcn_s_setprio(1);
#pragma unroll
    for (int ks = 0; ks < 4; ++ks) { o0 = __builtin_amdgcn_mfma_f32_32x32x16_bf16(pa[ks], vf[ks], o0, 0, 0, 0); o1 = __builtin_amdgcn_mfma_f32_32x32x16_bf16(pa[ks], vf[4 + ks], o1, 0, 0, 0); }
    __builtin_amdgcn_s_setprio(0);
}
__device__ __forceinline__ void pack_p(bf16x8 (&pa)[4], const f32x16& p0, const f32x16& p1) {
    u32x4 w0, w1, w2, w3;
    w0.x = cvt_pk_bf16(p0[0], p0[1]); w0.y = cvt_pk_bf16(p0[2], p0[3]); w0.z = cvt_pk_bf16(p0[4], p0[5]); w0.w = cvt_pk_bf16(p0[6], p0[7]);
    w1.x = cvt_pk_bf16(p0[8], p0[9]); w1.y = cvt_pk_bf16(p0[10], p0[11]); w1.z = cvt_pk_bf16(p0[12], p0[13]); w1.w = cvt_pk_bf16(p0[14], p0[15]);
    w2.x = cvt_pk_bf16(p1[0], p1[1]); w2.y = cvt_pk_bf16(p1[2], p1[3]); w2.z = cvt_pk_bf16(p1[4], p1[5]); w2.w = cvt_pk_bf16(p1[6], p1[7]);
    w3.x = cvt_pk_bf16(p1[8], p1[9]); w3.y = cvt_pk_bf16(p1[10], p1[11]); w3.z = cvt_pk_bf16(p1[12], p1[13]); w3.w = cvt_pk_bf16(p1[14], p1[15]);
    pa[0] = __builtin_bit_cast(bf16x8, w0); pa[1] = __builtin_bit_cast(bf16x8, w1); pa[2] = __builtin_bit_cast(bf16x8, w2); pa[3] = __builtin_bit_cast(bf16x8, w3);
}

#define ATT_WAIT_BAR(N) asm volatile("s_waitcnt vmcnt(" #N ") lgkmcnt(0)\n\ts_barrier" ::: "memory")
#define ATT_BAR() asm volatile("s_waitcnt lgkmcnt(0)\n\ts_barrier" ::: "memory")
__device__ __forceinline__ void sb_probs(f32x16& p0, f32x16& p1) {
#pragma unroll
    for (int r = 0; r < 16; ++r) { p0[r] = __builtin_amdgcn_rcpf(1.0f + __builtin_amdgcn_exp2f(p0[r])); p1[r] = __builtin_amdgcn_rcpf(1.0f + __builtin_amdgcn_exp2f(p1[r])); }
}
__device__ __forceinline__ void sb_mask(f32x16& p0, f32x16& p1, int lim, int hi) {
#pragma unroll
    for (int r = 0; r < 16; ++r) { const int kl = crow(r, hi); if (kl >= lim) p0[r] = 1.0f; if (kl + 32 >= lim) p1[r] = 1.0f; }
}
__device__ __forceinline__ void sb_scan(f32x16& p0, f32x16& p1, float& carry, bool hib) {
    float G[8], Gp[8];
#pragma unroll
    for (int gi = 0; gi < 4; ++gi) { G[gi] = (p0[4 * gi] * p0[4 * gi + 1]) * (p0[4 * gi + 2] * p0[4 * gi + 3]); G[4 + gi] = (p1[4 * gi] * p1[4 * gi + 1]) * (p1[4 * gi + 2] * p1[4 * gi + 3]); }
#pragma unroll
    for (int gi = 0; gi < 8; ++gi) Gp[gi] = partner32(G[gi], hib);
    float u = carry;
#pragma unroll
    for (int gi = 7; gi >= 0; --gi) {
        const float ug = u * Gp[gi]; float tt = hib ? u : ug;
#pragma unroll
        for (int i = 3; i >= 0; --i) { if (gi >= 4) { const float tn = tt * p1[4 * (gi - 4) + i]; p1[4 * (gi - 4) + i] = tt - tn; tt = tn; } else { const float tn = tt * p0[4 * gi + i]; p0[4 * gi + i] = tt - tn; tt = tn; } }
        u = ug * G[gi];
    }
    carry = u;
}
__device__ __forceinline__ void sb_head(LAS unsigned char* lds, const bf16_t* PROJ, const bf16_t* METAKV, bf16_t* MIX, int b, int h) {
    int tid = threadIdx.x; asm volatile("" : "+v"(tid));
    const int lane = tid & 63, r32 = lane & 31, hi = lane >> 5; const int wid = __builtin_amdgcn_readfirstlane(tid >> 6);
    const bool hib = hi != 0;
    const bf16_t* Kg = PROJ + (size_t)b * SEQ * DIN + COL_SBK + h * 64; const bf16_t* Vg = PROJ + (size_t)b * SEQ * DIN + COL_SBV + h * 64;
    const bf16_t* Km = METAKV + COL_SBK + h * 64; const bf16_t* Vm = METAKV + COL_SBV + h * 64;
    const int vrow = 16 * (wid & 3) + (lane >> 2), vcol = (wid >> 2) * 32 + (lane & 3) * 8;
    const int voff_lane = ((lane >> 4) & 1) * 32 + (lane & 3) * 8 + (4 * hi + ((lane & 15) >> 2)) * 64;
    int c_qb = 7, c_ip = 0, n_iss = 0, s_iss = 0;
#define SB_ISSUE_NEXT() do { if (c_qb >= 0) { LAS unsigned char* bb_ = lds + s_iss * 32768; const int NT_ = 4 * c_qb + 4, NP_ = NT_ >> 1; \
        if (c_ip < NP_) { const int keyA_ = 64 * (NT_ - 1 - 2 * c_ip), keyB_ = keyA_ - 64; \
            glds16(Kg + (size_t)(keyA_ + lane) * DIN + wid * 8, bb_ + wid * 1024); glds16(Vg + (size_t)(keyA_ + vrow) * DIN + vcol, bb_ + 8192 + wid * 1024); \
            glds16(Kg + (size_t)(keyB_ + lane) * DIN + wid * 8, bb_ + 16384 + wid * 1024); glds16(Vg + (size_t)(keyB_ + vrow) * DIN + vcol, bb_ + 24576 + wid * 1024); } \
        else { glds16(Km + (size_t)(lane < 16 ? lane : 15) * DIN + wid * 8, bb_ + wid * 1024); glds16(Vm + (size_t)(vrow < 16 ? vrow : 15) * DIN + vcol, bb_ + 8192 + wid * 1024); \
            glds16(Km + (size_t)(lane < 16 ? lane : 15) * DIN + wid * 8, bb_ + 16384 + wid * 1024); glds16(Vm + (size_t)(vrow < 16 ? vrow : 15) * DIN + vcol, bb_ + 24576 + wid * 1024); } \
        ++n_iss; s_iss = s_iss == 2 ? 0 : s_iss + 1; if (++c_ip > NP_) { c_ip = 0; --c_qb; } } } while (0)
    SB_ISSUE_NEXT(); SB_ISSUE_NEXT();
    bf16x8 qr[4];
    { const bf16_t* qp = PROJ + ((size_t)b * SEQ + 7 * 256 + wid * 32 + r32) * DIN + COL_SBQ + h * 64 + hi * 8;
#pragma unroll
      for (int d0 = 0; d0 < 4; ++d0) qr[d0] = *(const bf16x8*)(qp + d0 * 16); }
    asm volatile("" : "+v"(qr[0]), "+v"(qr[1]), "+v"(qr[2]), "+v"(qr[3]));
    int js = 0, s_cmp = 0;
    for (int qb = 7; qb >= 0; --qb) {
        const int NT = 4 * qb + 4, NP = NT / 2, q0w = qb * 256 + wid * 32, my_diag = 4 * qb + (wid >> 1);
        f32x16 o0 = {}, o1 = {}; float carry = 1.0f;
        bf16x8 qn[4] = {qr[0], qr[1], qr[2], qr[3]};
        for (int ip = 0; ip <= NP; ++ip) {
            if (ip == 0) ATT_BAR(); else if (js + 1 < n_iss) ATT_WAIT_BAR(4); else ATT_WAIT_BAR(0);
            SB_ISSUE_NEXT();
            if (ip == NP && qb > 0) { const bf16_t* qp = PROJ + ((size_t)b * SEQ + (qb - 1) * 256 + wid * 32 + r32) * DIN + COL_SBQ + h * 64 + hi * 8;
#pragma unroll
                for (int d0 = 0; d0 < 4; ++d0) qn[d0] = *(const bf16x8*)(qp + d0 * 16); }
            lptr bb = lds + s_cmp * 32768;
            const f32x16 z16 = {};
            if (ip == NP) {
                f32x16 p0, p1; bf16x8 kf[8]; kload(kf, bb, r32, hi); qkt(p0, p1, kf, qr, z16);
                bf16x8 vf[8]; vload(vf, bb + 8192 + voff_lane);
                sb_probs(p0, p1); sb_mask(p0, p1, 16, hi); sb_scan(p0, p1, carry, hib);
                bf16x8 pa[4]; pack_p(pa, p0, p1); pv64(o0, o1, vf, pa);
            } else {
                const int tA = NT - 1 - 2 * ip, tB = tA - 1;
                if (tA <= my_diag) {
                    f32x16 a0, a1, b0, b1; bf16x8 kf[8];
                    kload(kf, bb, r32, hi); qkt(a0, a1, kf, qr, z16);
                    kload(kf, bb + 16384, r32, hi); qkt(b0, b1, kf, qr, z16);
                    sb_probs(a0, a1); sb_probs(b0, b1);
                    if (tA == my_diag) sb_mask(a0, a1, q0w + r32 - 64 * tA, hi);
                    sb_scan(a0, a1, carry, hib);
                    { bf16x8 vf[8]; vload(vf, bb + 8192 + voff_lane); bf16x8 pa[4]; pack_p(pa, a0, a1); pv64(o0, o1, vf, pa); }
                    sb_scan(b0, b1, carry, hib);
                    { bf16x8 vf[8]; vload(vf, bb + 24576 + voff_lane); bf16x8 pa[4]; pack_p(pa, b0, b1); pv64(o0, o1, vf, pa); }
                } else if (tB <= my_diag) {
                    f32x16 p0, p1; bf16x8 kf[8]; kload(kf, bb + 16384, r32, hi); qkt(p0, p1, kf, qr, z16);
                    bf16x8 vf[8]; vload(vf, bb + 24576 + voff_lane);
                    sb_probs(p0, p1); if (tB == my_diag) sb_mask(p0, p1, q0w + r32 - 64 * tB, hi); sb_scan(p0, p1, carry, hib);
                    bf16x8 pa[4]; pack_p(pa, p0, p1); pv64(o0, o1, vf, pa);
                }
            }
            ++js; s_cmp = s_cmp == 2 ? 0 : s_cmp + 1;
        }
        if (qb > 0) asm volatile("" : "+v"(qn[0]), "+v"(qn[1]), "+v"(qn[2]), "+v"(qn[3]));
        { LAS bf16_t* stg = (LAS bf16_t*)(lds + 98304 + wid * 4096);
#pragma unroll
          for (int r = 0; r < 16; ++r) { const int orow = crow(r, hi); stg[orow * 64 + r32] = (bf16_t)f2bf(o0[r]); stg[orow * 64 + 32 + r32] = (bf16_t)f2bf(o1[r]); }
          bf16_t* Ow = MIX + ((size_t)b * SEQ + q0w) * D + h * 64;
#pragma unroll
          for (int i = 0; i < 4; ++i) { const int row = i * 8 + (lane >> 3), ch = lane & 7; const u32x4 v = *(const LAS u32x4*)(stg + row * 64 + ch * 8); *(u32x4*)(Ow + (size_t)row * D + ch * 8) = v; } }
#pragma unroll
        for (int d0 = 0; d0 < 4; ++d0) qr[d0] = qn[d0];
    }
    asm volatile("s_waitcnt vmcnt(0) lgkmcnt(0)\n\ts_barrier" ::: "memory");
#undef SB_ISSUE_NEXT
}

constexpr float DF_THR = 8.0f;
__device__ __forceinline__ void df_head(LAS unsigned char* lds, LAS float* wsf_all, const LAS float* btab, float lam, const float* sgain, const bf16_t* PROJ, const bf16_t* METAKV, bf16_t* MIX, int b, int hd, int which) {
    int tid = threadIdx.x; asm volatile("" : "+v"(tid));
    const int lane = tid & 63, r32 = lane & 31, hi = lane >> 5; const int wid = __builtin_amdgcn_readfirstlane(tid >> 6);
    const bool hib = hi != 0; const int s = wid >> 2, qw = wid & 3;
    const size_t rb = (size_t)b * SEQ * DIN;
    const bf16_t* K0g = PROJ + rb + COL_DFK + (2 * hd) * 64; const bf16_t* K1g = K0g + 64; const bf16_t* Vg = PROJ + rb + COL_DFV + hd * 128;
    const bf16_t* K0m = METAKV + COL_DFK + (2 * hd) * 64; const bf16_t* K1m = K0m + 64; const bf16_t* Vm = METAKV + COL_DFV + hd * 128;
    const int vrow = 16 * (wid & 3) + (lane >> 2), vcol = (wid >> 2) * 32 + (lane & 3) * 8;
    const int voff_lane = ((lane >> 4) & 1) * 32 + (lane & 3) * 8 + (4 * hi + ((lane & 15) >> 2)) * 64;
    LAS float* wsf = wsf_all + wid * 64;
    const LAS float* bt = btab + hd * 192;
    const float bfar = bt[0];
#define DF_UNIT(i8_) (2 * (i8_) + (which ? 1 - ((i8_) & 1) : ((i8_) & 1)))
    int c_i8 = 0, c_it = 0, n_iss = 0, s_iss = 0;
#define DF_ISSUE_NEXT() do { if (c_i8 < 8) { LAS unsigned char* bb_ = lds + s_iss * 32768; const int NTL_ = 2 * DF_UNIT(c_i8) + 2; \
        if (c_it < NTL_) { const int key0_ = 64 * c_it; const size_t ko_ = (size_t)(key0_ + lane) * DIN + wid * 8, vo_ = (size_t)(key0_ + vrow) * DIN + vcol; \
            glds16(K0g + ko_, bb_ + wid * 1024); glds16(K1g + ko_, bb_ + 8192 + wid * 1024); glds16(Vg + vo_, bb_ + 16384 + wid * 1024); glds16(Vg + vo_ + 64, bb_ + 24576 + wid * 1024); } \
        else { const size_t ko_ = (size_t)(lane < 16 ? lane : 15) * DIN + wid * 8, vo_ = (size_t)(vrow < 16 ? vrow : 15) * DIN + vcol; \
            glds16(K0m + ko_, bb_ + wid * 1024); glds16(K1m + ko_, bb_ + 8192 + wid * 1024); glds16(Vm + vo_, bb_ + 16384 + wid * 1024); glds16(Vm + vo_ + 64, bb_ + 24576 + wid * 1024); } \
        ++n_iss; s_iss = s_iss == 2 ? 0 : s_iss + 1; if (++c_it > NTL_) { c_it = 0; ++c_i8; } } } while (0)
    DF_ISSUE_NEXT(); DF_ISSUE_NEXT();
    bf16x8 qr[4];
    { const bf16_t* qp = PROJ + ((size_t)b * SEQ + DF_UNIT(0) * 128 + qw * 32 + r32) * DIN + COL_DFQ + (2 * hd + s) * 64 + hi * 8;
#pragma unroll
      for (int d0 = 0; d0 < 4; ++d0) qr[d0] = *(const bf16x8*)(qp + d0 * 16); }
    float gnv[4];
#pragma unroll
    for (int db = 0; db < 4; ++db) gnv[db] = sgain[db * 32 + r32];
    asm volatile("" : "+v"(qr[0]), "+v"(qr[1]), "+v"(qr[2]), "+v"(qr[3]), "+v"(gnv[0]), "+v"(gnv[1]), "+v"(gnv[2]), "+v"(gnv[3]));
    int js = 0, s_cmp = 0;
    for (int i8 = 0; i8 < 8; ++i8) {
        const int u = DF_UNIT(i8);
        const int NTL = 2 * u + 2;
        const int q0w = u * 128 + qw * 32, mychunk = 2 * u + (qw >> 1);
        f32x16 o[4] = {{}, {}, {}, {}}; float mrun = -1e30f, lsum = 0.f;
        bf16x8 qn[4] = {qr[0], qr[1], qr[2], qr[3]};
        for (int it = 0; it <= NTL; ++it) {
            if (it == 0) ATT_BAR(); else if (js + 1 < n_iss) ATT_WAIT_BAR(4); else ATT_WAIT_BAR(0);
            DF_ISSUE_NEXT();
            const bool meta = it == NTL;
            if (meta && i8 < 7) { const bf16_t* qp = PROJ + ((size_t)b * SEQ + DF_UNIT(i8 + 1) * 128 + qw * 32 + r32) * DIN + COL_DFQ + (2 * hd + s) * 64 + hi * 8;
#pragma unroll
                for (int d0 = 0; d0 < 4; ++d0) qn[d0] = *(const bf16x8*)(qp + d0 * 16); }
            if (meta || it <= mychunk) {
                lptr bb = lds + s_cmp * 32768;
                const int kbase = meta ? -16 : 64 * it;
                const bool near = (q0w - (kbase + 63)) < 128;
                f32x16 p0, p1; const f32x16 c0 = {};
                const float badd = near ? 0.f : bfar;
                bf16x8 kf[8]; kload(kf, bb + s * 8192, r32, hi); __builtin_amdgcn_sched_barrier(0);
                qkt(p0, p1, kf, qr, c0);
                if (near) { const int base = kbase - (q0w + r32) + 128;
#pragma unroll
                    for (int r = 0; r < 16; ++r) { int i0 = base + crow(r, hi); int i1 = i0 + 32; i0 = i0 < 0 ? 0 : i0; i1 = i1 < 0 ? 0 : i1; p0[r] += bt[i0]; p1[r] += bt[i1]; } }
                if (meta) {
#pragma unroll
                    for (int r = 0; r < 16; ++r) { if (crow(r, hi) >= 16) p0[r] = -1e30f; p1[r] = -1e30f; } }
                float tm = fmaxf(p0[0], p1[0]);
#pragma unroll
                for (int r = 1; r < 16; ++r) tm = fmaxf(tm, fmaxf(p0[r], p1[r]));
                tm = fmaxf(tm, partner32(tm, hib)) + badd;
                if (__any(tm > mrun + DF_THR)) {
                    const float mn = fmaxf(mrun, tm); const float f = __builtin_amdgcn_exp2f(mrun - mn); mrun = mn; lsum *= f;
                    if (!hib) wsf[r32] = f;
#pragma unroll
                    for (int r = 0; r < 16; ++r) { const float fr_ = wsf[crow(r, hi)]; o[0][r] *= fr_; o[1][r] *= fr_; o[2][r] *= fr_; o[3][r] *= fr_; }
                }
                float ps = 0.f;
                const float msub = mrun - badd;
#pragma unroll
                for (int r = 0; r < 16; ++r) { p0[r] = __builtin_amdgcn_exp2f(p0[r] - msub); p1[r] = __builtin_amdgcn_exp2f(p1[r] - msub); ps += p0[r] + p1[r]; }
                lsum += ps;
                bf16x8 pa[4]; pack_p(pa, p0, p1);
                bf16x8 vf[8]; vload(vf, bb + 16384 + voff_lane); __builtin_amdgcn_sched_barrier(0);
                pv64(o[0], o[1], vf, pa);
                vload(vf, bb + 24576 + voff_lane); __builtin_amdgcn_sched_barrier(0);
                pv64(o[2], o[3], vf, pa);
            }
            ++js; s_cmp = s_cmp == 2 ? 0 : s_cmp + 1;
        }
        if (i8 < 7) asm volatile("" : "+v"(qn[0]), "+v"(qn[1]), "+v"(qn[2]), "+v"(qn[3]));
        const float ltot = lsum + partner32(lsum, hib);
        if (!hib) wsf[r32] = (s ? lam : 1.0f) / ltot;
        float sc[16];
#pragma unroll
        for (int r = 0; r < 16; ++r) sc[r] = wsf[crow(r, hi)];
        LAS unsigned* X = (LAS unsigned*)(lds + 98304 + qw * 8192);
        if (s == 1) {
#pragma unroll
            for (int db = 0; db < 4; ++db)
#pragma unroll
                for (int rp = 0; rp < 8; ++rp) X[(db * 8 + rp) * 64 + lane] = cvt_pk_bf16(o[db][2 * rp] * sc[2 * rp], o[db][2 * rp + 1] * sc[2 * rp + 1]);
        }
        ATT_BAR();
        if (s == 0) {
            float ssq[16];
#pragma unroll
            for (int r = 0; r < 16; ++r) ssq[r] = 0.f;
#pragma unroll
            for (int db = 0; db < 4; ++db)
#pragma unroll
                for (int rp = 0; rp < 8; ++rp) { const unsigned xx = X[(db * 8 + rp) * 64 + lane];
                    const float a0 = o[db][2 * rp] * sc[2 * rp] - bf_lo(xx), a1 = o[db][2 * rp + 1] * sc[2 * rp + 1] - bf_hi(xx);
                    o[db][2 * rp] = a0; o[db][2 * rp + 1] = a1; ssq[2 * rp] += a0 * a0; ssq[2 * rp + 1] += a1 * a1; }
#pragma unroll
            for (int r = 0; r < 16; ++r) {
#pragma unroll
                for (int of = 1; of < 32; of <<= 1) ssq[r] += __shfl_xor(ssq[r], of);
                ssq[r] = (1.0f - LAMBDA_INIT) / sqrtf(ssq[r] * (1.0f / 128.0f) + SUBLN_EPS); }
            LAS bf16_t* stg = (LAS bf16_t*)X;
#pragma unroll
            for (int db = 0; db < 4; ++db)
#pragma unroll
                for (int r = 0; r < 16; ++r) stg[crow(r, hi) * 128 + db * 32 + r32] = (bf16_t)f2bf(o[db][r] * ssq[r] * gnv[db]);
            bf16_t* Ow = MIX + ((size_t)b * SEQ + q0w) * D + 512 + hd * 128;
            const int row0 = lane >> 4, ch = lane & 15;
#pragma unroll
            for (int i = 0; i < 8; ++i) { const int row = row0 + 4 * i; const u32x4 v = *(const LAS u32x4*)(stg + row * 128 + ch * 8); *(u32x4*)(Ow + (size_t)row * D + ch * 8) = v; }
        }
#pragma unroll
        for (int d0 = 0; d0 < 4; ++d0) qr[d0] = qn[d0];
    }
    asm volatile("s_waitcnt vmcnt(0) lgkmcnt(0)\n\ts_barrier" ::: "memory");
#undef DF_ISSUE_NEXT
#undef DF_UNIT
}
}

#define XB_TMO      128
#define XB_XCNT(j)  (256  + 64 * (j))
#define XB_XSUB(j)  (1280 + 64 * (j))
#define XB_XGEN(j)  (2304 + 64 * (j))
#define XB_TOP      3328
#define XB_TOPGEN   3392
#define XCD_BAR_WORDS 3456
#define XB_SPIN_CAP (1u << 18)
__device__ __forceinline__ unsigned xb_ld(unsigned* p)              { return __hip_atomic_load(p, __ATOMIC_RELAXED, __HIP_MEMORY_SCOPE_AGENT); }
__device__ __forceinline__ unsigned xb_add(unsigned* p, unsigned v) { return __hip_atomic_fetch_add(p, v, __ATOMIC_RELAXED, __HIP_MEMORY_SCOPE_AGENT); }
__device__ __forceinline__ unsigned xb_xcc_id() { return (unsigned)__builtin_amdgcn_s_getreg((3 << 11) | 20) & 0xFu; }
#define XB_SPIN(cond, bar) do { unsigned _sp = 0; while (cond) { __builtin_amdgcn_s_sleep(1); \
    if ((++_sp & 255u) == 0u) { if (xb_ld(&(bar)[XB_TMO])) break; if (_sp > XB_SPIN_CAP) { atomicAdd(&(bar)[XB_TMO], 1u); break; } } } } while (0)
struct XcdBarrier { unsigned* bar; unsigned x; volatile LAS unsigned* st; };
__device__ __forceinline__ XcdBarrier xcd_barrier_post(unsigned* bar, volatile LAS unsigned* st) {
    XcdBarrier b; b.bar = bar; b.x = xb_xcc_id(); b.st = st;
    if (threadIdx.x == 0) (void)xb_add(&bar[XB_XCNT(b.x)], 1u);
    return b;
}
__device__ __forceinline__ void xcd_barrier_complete(unsigned* bar, unsigned x, unsigned& nloc, unsigned& nx) {
    const unsigned G = gridDim.x * gridDim.y * gridDim.z;
    unsigned sum, cnt, mine, sp = 0u;
    for (;;) {
        sum = 0u; cnt = 0u; mine = 0u;
#pragma unroll
        for (unsigned j = 0; j < 16; ++j) { const unsigned c = xb_ld(&bar[XB_XCNT(j)]); sum += c; cnt += (c > 0u) ? 1u : 0u; mine = (j == x) ? c : mine; }
        if (sum == G) break;
        __builtin_amdgcn_s_sleep(1);
        if ((++sp & 255u) == 0u) { if (xb_ld(&bar[XB_TMO])) break; if (sp > XB_SPIN_CAP) { atomicAdd(&bar[XB_TMO], 1u); break; } }
    }
    nloc = mine > 0u ? mine : 1u; nx = cnt > 0u ? cnt : 1u;
}
__device__ __forceinline__ void xcd_barrier(const XcdBarrier& b) {
    asm volatile("s_waitcnt vmcnt(0)" ::: "memory");
    __syncthreads();
    if (threadIdx.x == 0) {
        unsigned* bar = b.bar;
        __builtin_amdgcn_s_waitcnt(0);
        unsigned nloc = b.st[0], nx = b.st[1];
        if (nloc == 0u) { xcd_barrier_complete(bar, b.x, nloc, nx); b.st[0] = nloc; b.st[1] = nx; }
        const unsigned old = xb_add(&bar[XB_XSUB(b.x)], 1u);
        const unsigned gen = old / nloc;
        if (old + 1u == (gen + 1u) * nloc) {
            __builtin_amdgcn_fence(__ATOMIC_RELEASE, "agent");
            asm volatile("s_waitcnt vmcnt(0)" ::: "memory");
            const unsigned og = xb_add(&bar[XB_TOP], 1u);
            const unsigned tg = og / nx;
            if (og + 1u == (tg + 1u) * nx) xb_add(&bar[XB_TOPGEN], 1u);
            else XB_SPIN(xb_ld(&bar[XB_TOPGEN]) == tg, bar);
            __builtin_amdgcn_fence(__ATOMIC_ACQUIRE, "agent");
            xb_add(&bar[XB_XGEN(b.x)], 1u);
            asm volatile("s_waitcnt vmcnt(0)" ::: "memory");
        } else {
            XB_SPIN(xb_ld(&bar[XB_XGEN(b.x)]) == gen, bar);
            __builtin_amdgcn_fence(__ATOMIC_ACQUIRE, "agent");
            asm volatile("s_waitcnt vmcnt(0)" ::: "memory");
        }
    }
    __syncthreads();
}

struct Args { const float* in[19]; float* out; unsigned char* ws; int ph_lo, ph_hi; };
enum { I_X = 0, I_META, I_RELB, I_ANORM, I_WIN, I_WOUT, I_LQ1, I_LK1, I_LQ2, I_LK2, I_SUBLN, I_FNORM, I_WR, I_BR, I_W1, I_B1, I_W2, I_B2, I_FINAL };

__device__ __forceinline__ void rms_row_to_bf16(const float* xrow, const f32x4 (&gn)[4], bf16_t* orow, int lane) {
    const f32x4* xr = (const f32x4*)xrow + lane;
    f32x4 v[4]; float s = 0.f;
#pragma unroll
    for (int j = 0; j < 4; ++j) { v[j] = xr[64 * j]; s += (v[j].x * v[j].x + v[j].y * v[j].y) + (v[j].z * v[j].z + v[j].w * v[j].w); }
    const float r = 1.0f / sqrtf(wave_sum(s) * (1.f / D) + NORM_EPS);
    unsigned long long* o8 = (unsigned long long*)orow + lane;
#pragma unroll
    for (int j = 0; j < 4; ++j) { const f32x4 y = v[j] * r * gn[j]; o8[64 * j] = (unsigned long long)pk2(y.x, y.y) | ((unsigned long long)pk2(y.z, y.w) << 32); }
}

__device__ __forceinline__ void p0_transpose_item(const float* W, int K, int N, bf16_t* WT, LAS float* scr, int item, int lane, int mode) {
    const int nblk = N / 32, kb = item / nblk, nb = item % nblk, k0 = 64 * kb, n0 = 32 * nb;
#pragma unroll 8
    for (int i = 0; i < 32; ++i) { const int kk = 2 * i + (lane >> 5); scr[kk * 33 + (lane & 31)] = W[(size_t)(k0 + kk) * N + n0 + (lane & 31)]; }
    LDS_WAIT(); asm volatile("" ::: "memory");
    int d0 = n0;
    if (mode == 1) { const int half = n0 >> 10, jj = n0 & 1023; d0 = (jj >> 7) * 256 + half * 128 + (jj & 127); }
    const int c = lane & 7;
#pragma unroll
    for (int j = 0; j < 4; ++j) { const int n = (lane >> 3) + 8 * j; const LAS float* s = scr + (8 * c) * 33 + n;
        u32x4 o; o.x = pk2(s[0 * 33], s[1 * 33]); o.y = pk2(s[2 * 33], s[3 * 33]); o.z = pk2(s[4 * 33], s[5 * 33]); o.w = pk2(s[6 * 33], s[7 * 33]);
        *(u32x4*)(WT + (size_t)(d0 + n) * K + k0 + 8 * c) = o; }
    LDS_WAIT(); asm volatile("" ::: "memory");
}

__device__ __forceinline__ void p0_transpose_item8(const float* W, int K, int N, unsigned char* WT, LAS float* scr, int item, int lane, int mode) {
    const int nblk = N / 32, kb = item / nblk, nb = item % nblk, k0 = 64 * kb, n0 = 32 * nb;
#pragma unroll 8
    for (int i = 0; i < 32; ++i) { const int kk = 2 * i + (lane >> 5); scr[kk * 33 + (lane & 31)] = W[(size_t)(k0 + kk) * N + n0 + (lane & 31)]; }
    LDS_WAIT(); asm volatile("" ::: "memory");
    int d0 = n0;
    if (mode == 1) { const int half = n0 >> 10, jj = n0 & 1023; d0 = (jj >> 7) * 256 + half * 128 + (jj & 127); }
    const int c = lane & 3;
#pragma unroll
    for (int j = 0; j < 2; ++j) { const int n = (lane >> 2) + 16 * j; const LAS float* sp = scr + (16 * c) * 33 + n;
        u32x4 o;
        o.x = pk4_fp8(sp[0 * 33] * 32.f, sp[1 * 33] * 32.f, sp[2 * 33] * 32.f, sp[3 * 33] * 32.f); o.y = pk4_fp8(sp[4 * 33] * 32.f, sp[5 * 33] * 32.f, sp[6 * 33] * 32.f, sp[7 * 33] * 32.f);
        o.z = pk4_fp8(sp[8 * 33] * 32.f, sp[9 * 33] * 32.f, sp[10 * 33] * 32.f, sp[11 * 33] * 32.f); o.w = pk4_fp8(sp[12 * 33] * 32.f, sp[13 * 33] * 32.f, sp[14 * 33] * 32.f, sp[15 * 33] * 32.f);
        *(u32x4*)(WT + (size_t)(d0 + n) * K + k0 + 16 * c) = o; }
    LDS_WAIT(); asm volatile("" ::: "memory");
}

__device__ __forceinline__ int t5_bucket(int rel) {
    const int n = rel < 0 ? -rel : rel; int b = rel > 0 ? 16 : 0;
    int large = 8 + (n >= 12) + (n >= 16) + (n >= 23) + (n >= 32) + (n >= 46) + (n >= 64) + (n >= 91);
    return b + (n < 8 ? n : large);
}

template <int CLS> __global__ void __launch_bounds__(NWAVES * 64, 2) fwd_kernel(Args args) {
    extern __shared__ __attribute__((aligned(16))) unsigned char lds_raw[];
    LAS unsigned char* lds = (LAS unsigned char*)lds_raw;
    volatile LAS unsigned* MISC = (volatile LAS unsigned*)(lds + MISC_OFF);
    const int tid = threadIdx.x, lane = tid & 63, wave = __builtin_amdgcn_readfirstlane(tid >> 6);
    const int G = gridDim.x, bx = blockIdx.x;
    const int gw = bx * NWAVES + wave, NGW = G * NWAVES;
    unsigned char* ws = args.ws;
    unsigned* ctl = (unsigned*)(ws + WS_CTL);
    const float* x = args.in[I_X];
    bf16_t* WinT = (bf16_t*)(ws + WS_WIN); bf16_t* WoutT = (bf16_t*)(ws + WS_WOUT); unsigned char* W1T = ws + WS_W1; unsigned char* W2T = ws + WS_W2; unsigned char* XN8 = ws + WS_XN8;
    bf16_t* METAKV = (bf16_t*)(ws + WS_METAKV); bf16_t* XN = (bf16_t*)(ws + WS_XN); bf16_t* PROJ = (bf16_t*)(ws + WS_PROJ); bf16_t* MIX = (bf16_t*)(ws + WS_MIX);
    float* TMP = (float*)(ws + WS_TMP); unsigned char* Y = ws + WS_Y; unsigned char* ACT = ws + WS_ACT;
    int* tok_e = (int*)(ws + WS_TOKE); float* tok_g = (float*)(ws + WS_TOKG); int* tok_lr = (int*)(ws + WS_TOKLR); int* cnt = (int*)(ws + WS_CNT);
    unsigned* rowtok = (unsigned*)(ws + WS_ROWTOK); int* rowsg = (int*)(ws + WS_ROWSG); int* tilee_hdr = (int*)(ws + WS_TILEE); unsigned char* tilee = (unsigned char*)(ws + WS_TILEE) + 64;
    bf16_t* H1 = (bf16_t*)(ws + WS_H1);

    if (tid < 32) MISC[tid] = 0u;
    __syncthreads();
#if ONE_LAUNCH
    XcdBarrier bar = xcd_barrier_post(ctl + CW_BAR, MISC + 8);
#define GRID_BAR() xcd_barrier(bar)
#else
#define GRID_BAR() do {} while (0)
#endif
    const int lo = args.ph_lo, hi = args.ph_hi;
#define INC(k, cls) ((CLS == -1 || CLS == (cls)) && lo <= (k) && (k) < hi)
#define IN(k) INC(k, k)
#define BOTH(k) (CLS == -1 && lo <= (k) && (k) + 1 < hi)

    if (IN(0)) {
        REP_BEGIN(0)
        int tid = threadIdx.x; asm volatile("" : "+v"(tid)); const int lane = tid & 63;
        LAS float* scr = (LAS float*)(lds + wave * 16384);
        constexpr int I_IN = 16 * 96, I_OUT = 16 * 32, I_1 = 16 * 64, I_2 = 16 * 32;
        constexpr int NITEMS = I_IN + I_OUT + NEXP * (I_1 + I_2);
        for (int it = gw; it < NITEMS; it += NGW) {
            int r = it;
            if (r < I_IN) { p0_transpose_item(args.in[I_WIN], D, DIN, WinT, scr, r, lane, 0); continue; } r -= I_IN;
            if (r < I_OUT) { p0_transpose_item(args.in[I_WOUT], D, D, WoutT, scr, r, lane, 0); continue; } r -= I_OUT;
            if (r < NEXP * I_1) { const int e = r / I_1; p0_transpose_item8(args.in[I_W1] + (size_t)e * D * 2048, D, 2048, W1T + (size_t)e * 2048 * D, scr, r % I_1, lane, 1); continue; } r -= NEXP * I_1;
            { const int e = r / I_2; p0_transpose_item8(args.in[I_W2] + (size_t)e * D * D, D, D, W2T + (size_t)e * D * D, scr, r % I_2, lane, 0); }
        }
        f32x4 gn[4];
#pragma unroll
        for (int j = 0; j < 4; ++j) gn[j] = ((const f32x4*)args.in[I_ANORM])[lane + 64 * j];
        for (int m = gw; m < T; m += NGW) rms_row_to_bf16(x + (size_t)m * D, gn, XN + (size_t)m * D, lane);
        __syncthreads();
        LAS float* xm = (LAS float*)lds;
        for (int rr = 0; rr < 2; ++rr) { const int m = wave * 2 + rr; const f32x4* xr = (const f32x4*)(args.in[I_META] + (size_t)m * D) + lane;
            f32x4 v[4]; float s = 0.f;
#pragma unroll
            for (int j = 0; j < 4; ++j) { v[j] = xr[64 * j]; s += (v[j].x * v[j].x + v[j].y * v[j].y) + (v[j].z * v[j].z + v[j].w * v[j].w); }
            const float r = 1.0f / sqrtf(wave_sum(s) * (1.f / D) + NORM_EPS);
#pragma unroll
            for (int j = 0; j < 4; ++j) { const f32x4 y = v[j] * r * gn[j]; *(LAS f32x4*)(xm + m * D + 4 * lane + 256 * j) = y; } }
        __syncthreads();
        for (int cb = bx; cb < 256; cb += G) {
            const int q0 = cb * 8; const int n0 = q0 < 1024 ? q0 + 512 : q0 + 1024;
            const int m = tid >> 5, kp = tid & 31; float a8[8];
#pragma unroll
            for (int c = 0; c < 8; ++c) a8[c] = 0.f;
            const float* win = args.in[I_WIN];
            for (int kk = 0; kk < 32; ++kk) { const int k = kk * 32 + kp; const float xv = xm[m * D + k];
                const f32x4 w0 = *(const f32x4*)(win + (size_t)k * DIN + n0), w1 = *(const f32x4*)(win + (size_t)k * DIN + n0 + 4);
                a8[0] += xv * w0.x; a8[1] += xv * w0.y; a8[2] += xv * w0.z; a8[3] += xv * w0.w; a8[4] += xv * w1.x; a8[5] += xv * w1.y; a8[6] += xv * w1.z; a8[7] += xv * w1.w; }
#pragma unroll
            for (int c = 0; c < 8; ++c) {
#pragma unroll
                for (int o = 1; o < 32; o <<= 1) a8[c] += __shfl_xor(a8[c], o); }
            if (kp == 0) { u32x4 w; w.x = pk2(a8[0], a8[1]); w.y = pk2(a8[2], a8[3]); w.z = pk2(a8[4], a8[5]); w.w = pk2(a8[6], a8[7]); *(u32x4*)(METAKV + (size_t)m * DIN + n0) = w; }
        }
        __syncthreads();
        REP_END(0)
        if (BOTH(0)) GRID_BAR();
    }

    if (IN(1)) {
        REP_BEGIN(1)
        pg8::Gemm g{XN, WinT, 0, nullptr}; pg8::StaticOrder S; S.init(T, DIN, G, bx);
        pg8::EpiProj E{PROJ};
        pg8::gemm_phase<pg8::EpiProj, pg8::StaticOrder, false, false>(lds, g, S, E, 0);
        REP_END(1)
        if (BOTH(1)) GRID_BAR();
    }

    if (IN(2)) {
        int tid = threadIdx.x; asm volatile("" : "+v"(tid)); const int lane = tid & 63;
        LAS float* btab = (LAS float*)(lds + EXTRA_OFF);
        LAS float* lamp = btab + 768;
        for (int i = tid; i < 768; i += NWAVES * 64) { const int h = i / 192, idx = i % 192; const int rel = idx - 128; btab[i] = args.in[I_RELB][t5_bucket(rel) * 4 + h] * LOG2E; }
        if (wave == 0) { const float a = wave_sum(args.in[I_LQ1][lane] * args.in[I_LK1][lane]), b = wave_sum(args.in[I_LQ2][lane] * args.in[I_LK2][lane]); if (lane == 0) lamp[0] = expf(a) - expf(b) + LAMBDA_INIT; }
        __syncthreads();
        const float lam = lamp[0];
#if !NAIVE_SB
        REP_BEGIN(20)
        for (int vb = bx; vb < 256; vb += G) att::sb_head(lds, PROJ, METAKV, MIX, vb >> 3, vb & 7);
        REP_END(20)
#else
        for (int it = gw; it < BATCH * 8 * 32; it += NGW) {
            const int qb = it & 31, h = (it >> 5) & 7, b = it >> 8; const int r = qb * 64 + lane;
            const size_t rowq = (size_t)b * SEQ + r;
            unsigned q[32];
            { const u32x4* qp = (const u32x4*)(PROJ + rowq * DIN + COL_SBQ + h * 64);
#pragma unroll
              for (int i = 0; i < 8; ++i) { const u32x4 t4 = qp[i]; q[4 * i] = t4.x; q[4 * i + 1] = t4.y; q[4 * i + 2] = t4.z; q[4 * i + 3] = t4.w; } }
            float o[64];
#pragma unroll
            for (int d = 0; d < 64; ++d) o[d] = 0.f;
            float carry = 1.0f;
            const int jmax = qb * 64 + 62;
            for (int jj = jmax + 16; jj >= 0; --jj) {
                const bool meta = jj < 16; const int j = jj - 16;
                const bf16_t* krow = meta ? METAKV + (size_t)jj * DIN : PROJ + ((size_t)b * SEQ + j) * DIN;
                const u32x4* kp = (const u32x4*)(krow + COL_SBK + h * 64); const u32x4* vp = (const u32x4*)(krow + COL_SBV + h * 64);
                float z = 0.f;
#pragma unroll
                for (int i = 0; i < 8; ++i) { const u32x4 k4 = kp[i];
                    z += bf_lo(q[4 * i]) * bf_lo(k4.x) + bf_hi(q[4 * i]) * bf_hi(k4.x); z += bf_lo(q[4 * i + 1]) * bf_lo(k4.y) + bf_hi(q[4 * i + 1]) * bf_hi(k4.y);
                    z += bf_lo(q[4 * i + 2]) * bf_lo(k4.z) + bf_hi(q[4 * i + 2]) * bf_hi(k4.z); z += bf_lo(q[4 * i + 3]) * bf_lo(k4.w) + bf_hi(q[4 * i + 3]) * bf_hi(k4.w); }
                const float e = __builtin_amdgcn_exp2f(fminf(z, 100.f)); const float p = 1.0f / (1.0f + e);
                const bool vis = meta || (j < r);
                const float w = vis ? (1.0f - p) * carry : 0.f; carry = vis ? carry * p : carry;
#pragma unroll
                for (int i = 0; i < 8; ++i) { const u32x4 v4 = vp[i];
                    o[8 * i] += w * bf_lo(v4.x); o[8 * i + 1] += w * bf_hi(v4.x); o[8 * i + 2] += w * bf_lo(v4.y); o[8 * i + 3] += w * bf_hi(v4.y);
                    o[8 * i + 4] += w * bf_lo(v4.z); o[8 * i + 5] += w * bf_hi(v4.z); o[8 * i + 6] += w * bf_lo(v4.w); o[8 * i + 7] += w * bf_hi(v4.w); }
            }
            u32x4* op = (u32x4*)(MIX + rowq * D + h * 64);
#pragma unroll
            for (int i = 0; i < 8; ++i) { u32x4 w; w.x = pk2(o[8 * i], o[8 * i + 1]); w.y = pk2(o[8 * i + 2], o[8 * i + 3]); w.z = pk2(o[8 * i + 4], o[8 * i + 5]); w.w = pk2(o[8 * i + 6], o[8 * i + 7]); op[i] = w; }
        }
#endif
#if !NAIVE_DF
        __syncthreads();
        REP_BEGIN(21)
        for (int vb = bx; vb < 256; vb += G) { const int pairi = (vb >> 4) * 8 + (vb & 7), which = (vb >> 3) & 1;
            att::df_head(lds, (LAS float*)(lds + GIDX_OFF), btab, lam, args.in[I_SUBLN], PROJ, METAKV, MIX, pairi >> 2, pairi & 3, which); }
        REP_END(21)
#else
        for (int it = gw; it < BATCH * 4 * 32; it += NGW) {
            const int c = it & 31, hd = (it >> 5) & 3, b = it >> 7; const int r = c * 64 + lane;
            const size_t rowq = (size_t)b * SEQ + r;
            float* tmp = TMP + (rowq * 4 + hd) * 128;
            const int nreal = c * 64 + 64;
            for (int s = 0; s < 2; ++s) {
                const int gh = 2 * hd + s;
                unsigned q[32];
                { const u32x4* qp = (const u32x4*)(PROJ + rowq * DIN + COL_DFQ + gh * 64);
#pragma unroll
                  for (int i = 0; i < 8; ++i) { const u32x4 t4 = qp[i]; q[4 * i] = t4.x; q[4 * i + 1] = t4.y; q[4 * i + 2] = t4.z; q[4 * i + 3] = t4.w; } }
                float mx = -1e30f, l = 0.f, ss = 0.f;
                for (int pass = 0; pass < 3; ++pass) {
                    float o[64];
#pragma unroll
                    for (int d = 0; d < 64; ++d) o[d] = 0.f;
                    const float il = pass >= 1 ? 1.0f / l : 0.f; const int dh = pass == 2 ? 64 : 0;
                    for (int jj = 0; jj < nreal + 16; ++jj) {
                        const bool meta = jj < 16; const int j = jj - 16;
                        const bf16_t* krow = meta ? METAKV + (size_t)jj * DIN : PROJ + ((size_t)b * SEQ + j) * DIN;
                        const u32x4* kp = (const u32x4*)(krow + COL_DFK + gh * 64);
                        float z = 0.f;
#pragma unroll
                        for (int i = 0; i < 8; ++i) { const u32x4 k4 = kp[i];
                            z += bf_lo(q[4 * i]) * bf_lo(k4.x) + bf_hi(q[4 * i]) * bf_hi(k4.x); z += bf_lo(q[4 * i + 1]) * bf_lo(k4.y) + bf_hi(q[4 * i + 1]) * bf_hi(k4.y);
                            z += bf_lo(q[4 * i + 2]) * bf_lo(k4.z) + bf_hi(q[4 * i + 2]) * bf_hi(k4.z); z += bf_lo(q[4 * i + 3]) * bf_lo(k4.w) + bf_hi(q[4 * i + 3]) * bf_hi(k4.w); }
                        int rel = meta ? (jj - 16 - r) : (j - r); rel = rel < -128 ? -128 : rel;
                        z += btab[hd * 192 + rel + 128];
                        if (pass == 0) { const float mn = fmaxf(mx, z); l = l * __builtin_amdgcn_exp2f(mx - mn) + __builtin_amdgcn_exp2f(z - mn); mx = mn; }
                        else { const float w = __builtin_amdgcn_exp2f(z - mx) * il; const u32x4* vp = (const u32x4*)(krow + COL_DFV + hd * 128 + dh);
#pragma unroll
                            for (int i = 0; i < 8; ++i) { const u32x4 v4 = vp[i];
                                o[8 * i] += w * bf_lo(v4.x); o[8 * i + 1] += w * bf_hi(v4.x); o[8 * i + 2] += w * bf_lo(v4.y); o[8 * i + 3] += w * bf_hi(v4.y);
                                o[8 * i + 4] += w * bf_lo(v4.z); o[8 * i + 5] += w * bf_hi(v4.z); o[8 * i + 6] += w * bf_lo(v4.w); o[8 * i + 7] += w * bf_hi(v4.w); } }
                    }
                    if (pass >= 1) {
                        if (s == 0) {
#pragma unroll
                            for (int d = 0; d < 64; d += 4) *(f32x4*)(tmp + dh + d) = (f32x4){o[d], o[d + 1], o[d + 2], o[d + 3]};
                        } else {
#pragma unroll
                            for (int d = 0; d < 64; d += 4) { const f32x4 o0 = *(const f32x4*)(tmp + dh + d); f32x4 a; a.x = o0.x - lam * o[d]; a.y = o0.y - lam * o[d + 1]; a.z = o0.z - lam * o[d + 2]; a.w = o0.w - lam * o[d + 3];
                                ss += (a.x * a.x + a.y * a.y) + (a.z * a.z + a.w * a.w); *(f32x4*)(tmp + dh + d) = a; }
                        }
                    }
                }
                if (s == 1) {
                    const float rr = (1.0f - LAMBDA_INIT) / sqrtf(ss * (1.0f / 128.0f) + SUBLN_EPS);
                    const float* sg = args.in[I_SUBLN];
                    u32x4* op = (u32x4*)(MIX + rowq * D + 512 + hd * 128);
#pragma unroll 4
                    for (int i = 0; i < 16; ++i) { const f32x4 a0 = *(const f32x4*)(tmp + 8 * i), a1 = *(const f32x4*)(tmp + 8 * i + 4); const f32x4 g0 = *(const f32x4*)(sg + 8 * i), g1 = *(const f32x4*)(sg + 8 * i + 4);
                        u32x4 w; w.x = pk2(a0.x * rr * g0.x, a0.y * rr * g0.y); w.y = pk2(a0.z * rr * g0.z, a0.w * rr * g0.w); w.z = pk2(a1.x * rr * g1.x, a1.y * rr * g1.y); w.w = pk2(a1.z * rr * g1.z, a1.w * rr * g1.w); op[i] = w; }
                }
            }
        }
#endif
        if (BOTH(2)) GRID_BAR();
    }

    if (IN(3)) {
        REP_BEGIN(3)
        pg8::Gemm g{MIX, WoutT, 0, nullptr}; pg8::StaticOrder S; S.init(T, D, G, bx);
        pg8::EpiRes E{x, H1, (float*)(ws + WS_ROWSS)};
        pg8::gemm_phase<pg8::EpiRes, pg8::StaticOrder, false, false>(lds, g, S, E, 0);
        REP_END(3)
        if (BOTH(3)) GRID_BAR();
    }

    if (IN(4)) {
        REP_BEGIN(4)
        int tid = threadIdx.x; asm volatile("" : "+v"(tid)); const int lane = tid & 63, r32 = lane & 31, hi = lane >> 5; const bool hib = hi != 0;
        LAS bf16_t* wt = (LAS bf16_t*)lds;
        LAS float* gl = (LAS float*)(lds + 66048);
        LAS int* hist = (LAS int*)(lds + EXTRA_OFF);
        const float* wr_g = args.in[I_WR];
        for (int idx = tid; idx < 32 * 1024; idx += NWAVES * 64) wt[(idx & 31) * 1032 + (idx >> 5)] = (bf16_t)f2bf(wr_g[idx]);
        for (int idx = tid; idx < 1024; idx += NWAVES * 64) gl[idx] = args.in[I_FNORM][idx];
        const float* rowss = (const float*)(ws + WS_ROWSS);
        float bias[16];
#pragma unroll
        for (int r = 0; r < 16; ++r) bias[r] = args.in[I_BR][att::crow(r, hi)];
        for (int blk = bx; blk < 256; blk += G) {
            __syncthreads();
            if (tid < 32) hist[tid] = 0;
            __syncthreads();
            const int tok = blk * 256 + wave * 32 + r32;
            float rs;
            { const f32x4* sp = (const f32x4*)(rowss + (size_t)tok * 16); const f32x4 s0 = sp[0], s1 = sp[1], s2 = sp[2], s3 = sp[3];
              const float ssum = (((s0[0] + s0[1]) + (s0[2] + s0[3])) + ((s1[0] + s1[1]) + (s1[2] + s1[3]))) + (((s2[0] + s2[1]) + (s2[2] + s2[3])) + ((s3[0] + s3[1]) + (s3[2] + s3[3])));
              rs = 1.0f / sqrtf(ssum * (1.f / D) + NORM_EPS); }
            const bf16_t* xrow = H1 + (size_t)tok * D + 8 * hi;
            unsigned char* orow = XN8 + (size_t)tok * D + 8 * hi;
            const LAS bf16_t* wrow = wt + r32 * 1032 + 8 * hi;
            att::f32x16 acc = {};
#pragma unroll 1
            for (int sc = 0; sc < 8; ++sc) {
                f32x4 xv[16];
#pragma unroll
                for (int s8 = 0; s8 < 8; ++s8) { const u32x4 hb = *(const u32x4*)(xrow + (sc * 8 + s8) * 16);
                    xv[2 * s8] = (f32x4){bf_lo(hb.x), bf_hi(hb.x), bf_lo(hb.y), bf_hi(hb.y)}; xv[2 * s8 + 1] = (f32x4){bf_lo(hb.z), bf_hi(hb.z), bf_lo(hb.w), bf_hi(hb.w)}; }
#pragma unroll
                for (int s8 = 0; s8 < 8; ++s8) { const int sk = (sc * 8 + s8) * 16;
                    const f32x4 g0 = *(const LAS f32x4*)(gl + sk + 8 * hi), g1 = *(const LAS f32x4*)(gl + sk + 8 * hi + 4);
                    const f32x4 y0 = xv[2 * s8] * g0 * rs, y1 = xv[2 * s8 + 1] * g1 * rs;
                    u32x4 bw; bw.x = cvt_pk_bf16(y0[0], y0[1]); bw.y = cvt_pk_bf16(y0[2], y0[3]); bw.z = cvt_pk_bf16(y1[0], y1[1]); bw.w = cvt_pk_bf16(y1[2], y1[3]);
                    u32x2 o8; o8.x = pk4_fp8(y0[0], y0[1], y0[2], y0[3]); o8.y = pk4_fp8(y1[0], y1[1], y1[2], y1[3]);
                    *(u32x2*)(orow + sk) = o8;
                    const bf16x8 af = *(const LAS bf16x8*)(wrow + sk);
                    acc = __builtin_amdgcn_mfma_f32_32x32x16_bf16(af, __builtin_bit_cast(bf16x8, bw), acc, 0, 0, 0); }
            }
            float v[16];
#pragma unroll
            for (int r = 0; r < 16; ++r) v[r] = acc[r] + bias[r];
            float cv[8]; int ce[8];
#pragma unroll
            for (int k = 0; k < 4; ++k) { float m = v[0]; int mi = 0;
#pragma unroll
                for (int r = 1; r < 16; ++r) { const bool c = v[r] > m; m = c ? v[r] : m; mi = c ? r : mi; }
#pragma unroll
                for (int r = 0; r < 16; ++r) v[r] = (r == mi) ? -3.0e38f : v[r];
                cv[k] = m; ce[k] = (mi & 3) + 8 * (mi >> 2) + 4 * hi; }
#pragma unroll
            for (int k = 0; k < 4; ++k) { cv[4 + k] = att::partner32(cv[k], hib); ce[4 + k] = __builtin_bit_cast(int, att::partner32(__builtin_bit_cast(float, ce[k]), hib)); }
            float tv[4]; int te4[4];
#pragma unroll
            for (int k = 0; k < 4; ++k) { float m = cv[0]; int mi = 0, me = ce[0];
#pragma unroll
                for (int c8 = 1; c8 < 8; ++c8) { const bool c = cv[c8] > m || (cv[c8] == m && ce[c8] < me); m = c ? cv[c8] : m; mi = c ? c8 : mi; me = c ? ce[c8] : me; }
                tv[k] = m; te4[k] = me;
#pragma unroll
                for (int c8 = 0; c8 < 8; ++c8) cv[c8] = (c8 == mi) ? -3.0e38f : cv[c8]; }
            const float e1 = __expf(tv[1] - tv[0]), e2 = __expf(tv[2] - tv[0]), e3 = __expf(tv[3] - tv[0]); const float inv = 1.0f / (((1.0f + e1) + e2) + e3);
            if (!hib) {
                { const int lr = atomicAdd((int*)(hist + te4[0]), 1); tok_e[tok * 4 + 0] = te4[0]; tok_g[tok * 4 + 0] = inv; tok_lr[tok * 4 + 0] = lr; }
                { const int lr = atomicAdd((int*)(hist + te4[1]), 1); tok_e[tok * 4 + 1] = te4[1]; tok_g[tok * 4 + 1] = e1 * inv; tok_lr[tok * 4 + 1] = lr; }
                { const int lr = atomicAdd((int*)(hist + te4[2]), 1); tok_e[tok * 4 + 2] = te4[2]; tok_g[tok * 4 + 2] = e2 * inv; tok_lr[tok * 4 + 2] = lr; }
                { const int lr = atomicAdd((int*)(hist + te4[3]), 1); tok_e[tok * 4 + 3] = te4[3]; tok_g[tok * 4 + 3] = e3 * inv; tok_lr[tok * 4 + 3] = lr; } }
            __syncthreads();
            if (tid < 32) cnt[blk * 32 + tid] = hist[tid];
        }
        __syncthreads();
        REP_END(4)
        if (BOTH(4)) GRID_BAR();
    }

    if (IN(5)) {
        int tid = threadIdx.x; asm volatile("" : "+v"(tid)); const int lane = tid & 63;
        LAS int* tot = (LAS int*)(lds + EXTRA_OFF); LAS int* tstart = tot + 32; LAS int* pref = tstart + 40;
        if (tid < 32) { int s = 0; for (int w = 0; w < 256; ++w) s += cnt[w * 32 + tid]; tot[tid] = s; }
        __syncthreads();
        if (tid == 0) { int a = 0; for (int e = 0; e < 32; ++e) { tstart[e] = a; a += (tot[e] + 255) >> 8; } tstart[32] = a; }
        __syncthreads();
        for (int blk = bx; blk < 256; blk += G) {
            if (tid < 32) { int s = 0; for (int w = 0; w < blk; ++w) s += cnt[w * 32 + tid]; pref[tid] = s; }
            __syncthreads();
            for (int a = tid; a < 1024; a += NWAVES * 64) { const int idx = blk * 1024 + a; const int e = tok_e[idx]; const int pos = tstart[e] * 256 + pref[e] + tok_lr[idx];
                rowtok[pos] = (unsigned)(idx >> 2); rowsg[2 * pos] = idx; rowsg[2 * pos + 1] = __builtin_bit_cast(int, tok_g[idx]); }
            __syncthreads();
        }
        for (int e = bx; e < 32; e += G)
            for (int p = tstart[e] * 256 + tot[e] + tid; p < tstart[e + 1] * 256; p += NWAVES * 64) { rowtok[p] = 0u; rowsg[2 * p] = -1; rowsg[2 * p + 1] = 0; }
        if (bx == 0) { if (tid < 32) for (int tl = tstart[tid]; tl < tstart[tid + 1]; ++tl) tilee[tl] = (unsigned char)tid; if (tid == 0) tilee_hdr[0] = tstart[32]; }
        __syncthreads();
        if (BOTH(5)) GRID_BAR();
    }

    if (IN(6)) {
        REP_BEGIN(6)
        int tid = threadIdx.x; asm volatile("" : "+v"(tid)); const int lane = tid & 63;
        const int NTl = tilee_hdr[0];
        LAS unsigned char* te = lds + TE_OFF; LAS unsigned short* gidx = (LAS unsigned short*)(lds + GIDX_OFF);
        for (int i = tid; i < MAXTILES; i += NWAVES * 64) te[i] = i < NTl ? tilee[i] : (unsigned char)0;
        __syncthreads();
        pg8::GroupedOrder S; S.init(NTl, 8, G, bx, 0, te);
        for (int i = 0; i < MAXSLOTS; ++i) { pg8::Unit u; if (S.next(i, u)) { if (tid < 256) gidx[i * 256 + tid] = (unsigned short)rowtok[u.pm * 256 + tid]; } }
        __syncthreads();
        pg8::Gemm g{XN8, W1T, (size_t)2048 * D, gidx};
        pg8::EpiSwiglu E{ACT, args.in[I_B1]};
        pg8::gemm_phase<pg8::EpiSwiglu, pg8::GroupedOrder, true, true>(lds, g, S, E, 0);
        REP_END(6)
        if (BOTH(6)) GRID_BAR();
    }
    if (IN(7)) {
        REP_BEGIN(7)
        int tid = threadIdx.x; asm volatile("" : "+v"(tid)); const int lane = tid & 63;
        const int NTl = tilee_hdr[0];
        LAS unsigned char* te = lds + TE_OFF;
        __syncthreads();
        for (int i = tid; i < MAXTILES; i += NWAVES * 64) te[i] = i < NTl ? tilee[i] : (unsigned char)0;
        __syncthreads();
        pg8::GroupedOrder S; S.init(NTl, 4, G, bx, 0, te);
        pg8::Gemm g{ACT, W2T, (size_t)D * D, nullptr};
        pg8::EpiDown E{Y, args.in[I_B2], rowsg, ws + WS_DUMP};
        pg8::gemm_phase<pg8::EpiDown, pg8::GroupedOrder, false, true>(lds, g, S, E, 0);
        REP_END(7)
        if (BOTH(7)) GRID_BAR();
    }

    if (IN(8)) {
        int tid = threadIdx.x; asm volatile("" : "+v"(tid)); const int lane = tid & 63;
        f32x4 gn[4];
#pragma unroll
        for (int j = 0; j < 4; ++j) gn[j] = ((const f32x4*)args.in[I_FINAL])[lane + 64 * j];
        for (int tok = gw; tok < T; tok += NGW) {
            f32x4* hp = (f32x4*)(args.out + (size_t)tok * D) + lane; const u32x2* hb = (const u32x2*)(H1 + (size_t)tok * D) + lane; f32x4 v[4]; float s = 0.f;
#pragma unroll
            for (int j = 0; j < 4; ++j) { const u32x2 h2 = hb[64 * j]; v[j] = (f32x4){bf_lo(h2.x), bf_hi(h2.x), bf_lo(h2.y), bf_hi(h2.y)}; }
#pragma unroll
            for (int k = 0; k < 4; ++k) { const unsigned* yp = (const unsigned*)(Y + ((size_t)tok * 4 + k) * D) + lane;
#pragma unroll
                for (int j = 0; j < 4; ++j) { const int y4 = (int)yp[64 * j]; v[j].x += __builtin_amdgcn_cvt_f32_fp8(y4, 0); v[j].y += __builtin_amdgcn_cvt_f32_fp8(y4, 1); v[j].z += __builtin_amdgcn_cvt_f32_fp8(y4, 2); v[j].w += __builtin_amdgcn_cvt_f32_fp8(y4, 3); } }
#pragma unroll
            for (int j = 0; j < 4; ++j) s += (v[j].x * v[j].x + v[j].y * v[j].y) + (v[j].z * v[j].z + v[j].w * v[j].w);
            const float r = 1.0f / sqrtf(wave_sum(s) * (1.f / D) + NORM_EPS);
#pragma unroll
            for (int j = 0; j < 4; ++j) hp[64 * j] = v[j] * r * gn[j];
        }
    }
#undef IN
#undef INC
#undef BOTH
}

#if ONE_LAUNCH
constexpr int NKERN = 1;
static const void* kern_of(int) { return (const void*)fwd_kernel<-1>; }
#else
constexpr int NKERN = 9;
static const void* kern_of(int c) {
    switch (c) { case 0: return (const void*)fwd_kernel<0>; case 1: return (const void*)fwd_kernel<1>; case 2: return (const void*)fwd_kernel<2>; case 3: return (const void*)fwd_kernel<3>; case 4: return (const void*)fwd_kernel<4>;
        case 5: return (const void*)fwd_kernel<5>; case 6: return (const void*)fwd_kernel<6>; case 7: return (const void*)fwd_kernel<7>; default: return (const void*)fwd_kernel<8>; }
}
#endif
extern "C" void kernel_launch(void* const* d_in, const int* in_sizes, int n_in, void* d_out, int out_size, void* d_ws, size_t ws_size, hipStream_t stream) {
    static int grid = 0;
    if (grid == 0) {
        if (n_in != 19 || out_size != T * D || ws_size < WS_END) { fprintf(stderr, "kernel_launch: unexpected shapes (n_in %d, out %d, ws %zu)\n", n_in, out_size, ws_size); grid = -1; return; }
        for (int c = 0; c < NKERN; ++c) if (hipFuncSetAttribute(kern_of(c), hipFuncAttributeMaxDynamicSharedMemorySize, LDS_BYTES) != hipSuccess) { fprintf(stderr, "kernel_launch: hipFuncSetAttribute failed\n"); grid = -1; return; }
        int dev = 0, cus = 0, per_cu = 0;
        (void)hipGetDevice(&dev); (void)hipDeviceGetAttribute(&cus, hipDeviceAttributeMultiprocessorCount, dev);
        (void)hipOccupancyMaxActiveBlocksPerMultiprocessor(&per_cu, kern_of(0), NWAVES * 64, LDS_BYTES);
        (void)hipGetLastError();
        grid = cus > 0 ? cus : 256;
        if (grid > 256) grid = 256;
    }
    if (grid < 0) return;
    (void)hipMemsetAsync((char*)d_ws + WS_CTL, 0, CTL_ZERO_BYTES, stream);
    Args a{};
    for (int i = 0; i < 19; ++i) a.in[i] = (const float*)d_in[i];
    a.out = (float*)d_out; a.ws = (unsigned char*)d_ws;
    constexpr int NPH = 9;
#if ONE_LAUNCH
    a.ph_lo = 0; a.ph_hi = NPH;
    hipLaunchKernelGGL(fwd_kernel<-1>, dim3(grid), dim3(NWAVES * 64), LDS_BYTES, stream, a);
#else
    for (int p = 0; p < NPH; ++p) { a.ph_lo = p; a.ph_hi = p + 1; const int cls = p; void* kargs[] = {&a};
        (void)hipLaunchKernel(kern_of(cls), dim3(grid), dim3(NWAVES * 64), kargs, LDS_BYTES, stream); }
#endif
}
```

```cpp
#include <hip/hip_runtime.h>
#include <cstdio>
#include <cstdint>

#ifndef ONE_LAUNCH
#define ONE_LAUNCH 1
#endif
#ifndef REP_PHASE
#define REP_PHASE -1
#endif
#define REP_COUNT 3
#define NREP(k) ((REP_PHASE == (k)) ? REP_COUNT : 1)
#define REP_BEGIN(k) for (int rep_ = 0; rep_ < NREP(k); ++rep_) {
#define REP_END(k) if (rep_ + 1 < NREP(k)) GRID_BAR(); }
#ifndef NAIVE_SB
#define NAIVE_SB 0
#endif
#ifndef NAIVE_DF
#define NAIVE_DF 0
#endif

#define LAS __attribute__((address_space(3)))
#define GAS __attribute__((address_space(1)))
typedef unsigned short bf16_t;
typedef short bf16x8 __attribute__((ext_vector_type(8)));
typedef float f32x4 __attribute__((ext_vector_type(4)));
typedef float f32x2 __attribute__((ext_vector_type(2)));
typedef unsigned u32x4 __attribute__((ext_vector_type(4)));
typedef unsigned u32x2 __attribute__((ext_vector_type(2)));

constexpr int D = 1024, BATCH = 32, SEQ = 2048, T = BATCH * SEQ, NMETA = 16, DIN = 3072, NEXP = 32, TOPK = 4;
constexpr int COL_SBQ = 0, COL_SBK = 512, COL_SBV = 1024, COL_DFQ = 1536, COL_DFK = 2048, COL_DFV = 2560;
constexpr int MAXTILES = 1024 + 32, MAXSLOTS = 33;
constexpr float LOG2E = 1.4426950408889634f;
constexpr float C2 = 0.125f * LOG2E;
constexpr float NORM_EPS = 1e-6f, SUBLN_EPS = 1e-5f, LAMBDA_INIT = 0.2f;
constexpr int NWAVES = 8;

constexpr size_t MiB = 1u << 20;
constexpr size_t WS_CTL = 0, CTL_ZERO_BYTES = 32768;
constexpr size_t WS_WIN = 2 * MiB;
constexpr size_t WS_WOUT = 8 * MiB;
constexpr size_t WS_W1 = 10 * MiB;
constexpr size_t WS_W2 = 74 * MiB;
constexpr size_t WS_SMALL = 106 * MiB;
constexpr size_t WS_METAKV = WS_SMALL;
constexpr size_t WS_TOKE = WS_SMALL + 1 * MiB;
constexpr size_t WS_TOKG = WS_SMALL + 2 * MiB;
constexpr size_t WS_TOKLR = WS_SMALL + 3 * MiB;
constexpr size_t WS_CNT = WS_SMALL + 4 * MiB;
constexpr size_t WS_ROWTOK = WS_SMALL + 5 * MiB;
constexpr size_t WS_ROWSG = WS_SMALL + 7 * MiB;
constexpr size_t WS_TILEE = WS_SMALL + 10 * MiB;
constexpr size_t WS_DUMP = WS_SMALL + 11 * MiB;
constexpr size_t WS_ROWSS = WS_SMALL + 12 * MiB;
constexpr size_t WS_XN8 = 122 * MiB;
constexpr size_t WS_Y = 186 * MiB;
constexpr size_t WS_PROJ = WS_Y;
constexpr size_t WS_MIX = WS_Y + 384 * MiB;
constexpr size_t WS_H1 = 442 * MiB;
constexpr size_t WS_ACT = 698 * MiB;
constexpr size_t WS_XN = WS_ACT;
constexpr size_t WS_TMP = WS_ACT + 128 * MiB;
constexpr size_t WS_END = 962 * MiB;
constexpr int CW_BAR = 4096;

constexpr int RING_BYTES = 131072;
constexpr int GIDX_OFF = RING_BYTES;
constexpr int TE_OFF = GIDX_OFF + 16896;
constexpr int EXTRA_OFF = TE_OFF + 1088;
constexpr int MISC_OFF = EXTRA_OFF + 4096;
constexpr int LDS_BYTES = 155648;
static_assert(MISC_OFF + 128 <= LDS_BYTES, "LDS map");

#define LDS_WAIT() asm volatile("s_waitcnt lgkmcnt(0)" ::: "memory")
#define VM_WAIT() asm volatile("s_waitcnt vmcnt(0)" ::: "memory")
__device__ __forceinline__ unsigned f2bf(float f) { unsigned u = __builtin_bit_cast(unsigned, f); return (u + 0x7fffu + ((u >> 16) & 1u)) >> 16; }
__device__ __forceinline__ unsigned pk2(float lo, float hi) { return f2bf(lo) | (f2bf(hi) << 16); }
__device__ __forceinline__ float bf_lo(unsigned u) { return __builtin_bit_cast(float, u << 16); }
__device__ __forceinline__ float bf_hi(unsigned u) { return __builtin_bit_cast(float, u & 0xffff0000u); }
__device__ __forceinline__ unsigned cvt_pk_bf16(float lo, float hi) { unsigned r; asm volatile("v_cvt_pk_bf16_f32 %0, %1, %2" : "=v"(r) : "v"(lo), "v"(hi)); return r; }
__device__ __forceinline__ unsigned pk4_fp8(float a, float b, float c, float d) { int w = __builtin_amdgcn_cvt_pk_fp8_f32(a, b, 0, false); w = __builtin_amdgcn_cvt_pk_fp8_f32(c, d, w, true); return (unsigned)w; }
__device__ __forceinline__ float wave_sum(float v) {
#pragma unroll
    for (int o = 1; o < 64; o <<= 1) v += __shfl_xor(v, o);
    return v;
}

namespace pg8 {
constexpr int BM = 256, BK = 64, HALF = 128, HTB = HALF * BK * 2, STAGE_BYTES = 8 * HTB, NXCD = 8, WGM = 8, K = 1024, NT_K = K / BK;
__host__ __device__ __forceinline__ int lds_byte(int r, int c, int SH = 5) { const int st = (r >> 4) * 2 + (c >> 5), rr = r & 15, cc = c & 31, ob = rr * 64 + cc * 2; return st * 1024 + (ob ^ (((ob >> 9) & 1) << SH)); }
__host__ __device__ __forceinline__ void stage_rc(int b, int& R, int& C, int SH = 5) { const int st = b / 1024, sb = b % 1024, swz = sb ^ (((sb >> 9) & 1) << SH); R = (st >> 1) * 16 + swz / 64; C = (st & 1) * 32 + (swz % 64) / 2; }
__host__ __device__ __forceinline__ int perm32(int rho) { const int n = rho >> 4, i = rho & 15; return 8 * (i >> 2) + 4 * n + (i & 3); }

struct Unit { int pm, pn, e; };
struct Gemm { const void* A; const void* Bt; size_t estride; const LAS unsigned short* gidx; };

struct StaticOrder {
    int nM, nN, nwg, G, c;
    __device__ void init(int M, int N, int G_, int c_) { nM = M / BM; nN = N / BM; nwg = nM * nN; G = G_; c = c_; }
    __device__ bool next(int i, Unit& u) const {
        const long L = (long)i * G + c; if (L >= nwg) return false;
        int wgid = (int)L; { const int q = nwg / NXCD, r = nwg % NXCD, xcd = wgid % NXCD, off = wgid / NXCD; wgid = (xcd < r ? xcd * (q + 1) : r * (q + 1) + (xcd - r) * q) + off; }
        const int nig = WGM * nN, gid = wgid / nig, fm = gid * WGM, gsz = (nM - fm) < WGM ? (nM - fm) : WGM;
        u.pm = fm + ((wgid % nig) % gsz); u.pn = (wgid % nig) / gsz; u.e = 0; return true;
    }
};
struct GroupedOrder {
    int nM, nN, nwg, G, c, tile0; const LAS unsigned char* te;
    __device__ void init(int ntiles, int nN_, int G_, int c_, int tile0_, const LAS unsigned char* te_) { nM = ntiles; nN = nN_; nwg = nM * nN; G = G_; c = c_; tile0 = tile0_; te = te_; }
    __device__ bool next(int i, Unit& u) const {
        const long L = (long)i * G + c; if (L >= nwg) return false;
        int wgid = (int)L; { const int q = nwg / NXCD, r = nwg % NXCD, xcd = wgid % NXCD, off = wgid / NXCD; wgid = (xcd < r ? xcd * (q + 1) : r * (q + 1) + (xcd - r) * q) + off; }
        const int nig = WGM * nN, gid = wgid / nig, fm = gid * WGM, gsz = (nM - fm) < WGM ? (nM - fm) : WGM;
        u.pm = tile0 + fm + ((wgid % nig) % gsz); u.pn = (wgid % nig) / gsz; u.e = __builtin_amdgcn_readfirstlane((int)te[u.pm]); return true;
    }
};

struct EpiProj {
    static constexpr bool PERM = true;
    bf16_t* O;
    __device__ __forceinline__ void operator()(const f32x4 (&acc)[2][2][4][2], const Unit& u, int wr, int wc, int fr, int fq) const {
        const int row0 = u.pm * BM + wr * 64 + fr; const int col0 = u.pn * BM + wc * 32 + 8 * fq;
        const float sc = (u.pn < 2 || u.pn == 6 || u.pn == 7) ? C2 : 1.0f;
#pragma unroll
        for (int ai = 0; ai < 2; ++ai)
#pragma unroll
            for (int m = 0; m < 4; ++m) { bf16_t* rowp = O + (size_t)(row0 + ai * HALF + m * 16) * DIN + col0;
#pragma unroll
                for (int bj = 0; bj < 2; ++bj) { const f32x4 v0 = acc[ai][bj][m][0] * sc, v1 = acc[ai][bj][m][1] * sc;
                    u32x4 w; w.x = cvt_pk_bf16(v0[0], v0[1]); w.y = cvt_pk_bf16(v0[2], v0[3]); w.z = cvt_pk_bf16(v1[0], v1[1]); w.w = cvt_pk_bf16(v1[2], v1[3]);
                    *(u32x4*)(rowp + bj * HALF) = w; } }
    }
};
struct EpiRes {
    static constexpr bool PERM = true;
    const float* base; bf16_t* out; float* rowss;
    __device__ __forceinline__ void operator()(const f32x4 (&acc)[2][2][4][2], const Unit& u, int wr, int wc, int fr, int fq) const {
        const int col0 = u.pn * BM + wc * 32 + 8 * fq;
#pragma unroll
        for (int ai = 0; ai < 2; ++ai) {
            f32x4 rs[4][2][2];
#pragma unroll
            for (int m = 0; m < 4; ++m) { const float* rp = base + (size_t)(u.pm * BM + ai * HALF + wr * 64 + m * 16 + fr) * D + col0;
#pragma unroll
                for (int bj = 0; bj < 2; ++bj) { rs[m][bj][0] = *(const f32x4*)(rp + bj * HALF); rs[m][bj][1] = *(const f32x4*)(rp + bj * HALF + 4); } }
#pragma unroll
            for (int m = 0; m < 4; ++m) { const int row = u.pm * BM + ai * HALF + wr * 64 + m * 16 + fr; bf16_t* op = out + (size_t)row * D + col0; float ss = 0.f;
#pragma unroll
                for (int bj = 0; bj < 2; ++bj) { const f32x4 v0 = rs[m][bj][0] + acc[ai][bj][m][0], v1 = rs[m][bj][1] + acc[ai][bj][m][1];
                    u32x4 w; w.x = cvt_pk_bf16(v0[0], v0[1]); w.y = cvt_pk_bf16(v0[2], v0[3]); w.z = cvt_pk_bf16(v1[0], v1[1]); w.w = cvt_pk_bf16(v1[2], v1[3]);
                    *(u32x4*)(op + bj * HALF) = w;
                    ss += ((v0[0] * v0[0] + v0[1] * v0[1]) + (v0[2] * v0[2] + v0[3] * v0[3])) + ((v1[0] * v1[0] + v1[1] * v1[1]) + (v1[2] * v1[2] + v1[3] * v1[3])); }
                ss += __shfl_xor(ss, 16); ss += __shfl_xor(ss, 32);
                if (fq == 0) rowss[(size_t)row * 16 + u.pn * 4 + wc] = ss; }
            asm volatile("" ::: "memory");
        }
    }
};
struct EpiSwiglu {
    static constexpr bool PERM = true;
    unsigned char* act; const float* b1;
    __device__ __forceinline__ void operator()(const f32x4 (&acc)[2][2][4][2], const Unit& u, int wr, int wc, int fr, int fq) const {
        const int row0 = u.pm * BM + wr * 64 + fr; const int lc = u.pn * HALF + wc * 32 + 8 * fq;
        const float* bg = b1 + (size_t)u.e * 2048 + lc; const float* bl = bg + 1024;
        f32x4 bgv[2], blv[2];
#pragma unroll
        for (int n = 0; n < 2; ++n) { bgv[n] = *(const f32x4*)(bg + 4 * n); blv[n] = *(const f32x4*)(bl + 4 * n); }
#pragma unroll
        for (int ai = 0; ai < 2; ++ai)
#pragma unroll
            for (int m = 0; m < 4; ++m) { float r[8];
#pragma unroll
                for (int n = 0; n < 2; ++n)
#pragma unroll
                    for (int x = 0; x < 4; ++x) { float g = acc[ai][0][m][n][x] * (1.0f / 32.0f) + bgv[n][x], l = acc[ai][1][m][n][x] * (1.0f / 32.0f) + blv[n][x];
                        g = fminf(g, 7.0f); l = fminf(fmaxf(l, -7.0f), 7.0f);
                        const float sg = __builtin_amdgcn_rcpf(1.0f + __builtin_amdgcn_exp2f(-1.702f * LOG2E * g));
                        r[n * 4 + x] = g * sg * (l + 1.0f); }
                u32x2 w; w.x = pk4_fp8(r[0], r[1], r[2], r[3]); w.y = pk4_fp8(r[4], r[5], r[6], r[7]);
                *(u32x2*)(act + (size_t)(row0 + ai * HALF + m * 16) * D + lc) = w; }
    }
};
struct EpiDown {
    static constexpr bool PERM = true;
    unsigned char* Y; const float* b2; const int* rowsg; unsigned char* dump;
    __device__ __forceinline__ void operator()(const f32x4 (&acc)[2][2][4][2], const Unit& u, int wr, int wc, int fr, int fq) const {
        const int col0 = u.pn * BM + wc * 32 + 8 * fq;
        f32x4 bv[2][2];
#pragma unroll
        for (int bj = 0; bj < 2; ++bj)
#pragma unroll
            for (int n = 0; n < 2; ++n) bv[bj][n] = *(const f32x4*)(b2 + (size_t)u.e * D + col0 + bj * HALF + 4 * n);
        int slotv[8]; float gtv[8];
#pragma unroll
        for (int ai = 0; ai < 2; ++ai)
#pragma unroll
            for (int m = 0; m < 4; ++m) { const int arow = u.pm * BM + ai * HALF + wr * 64 + m * 16 + fr; slotv[ai * 4 + m] = rowsg[2 * arow]; gtv[ai * 4 + m] = __builtin_bit_cast(float, rowsg[2 * arow + 1]); }
#pragma unroll
        for (int i = 0; i < 8; ++i) asm volatile("" : "+v"(slotv[i]), "+v"(gtv[i]));
#pragma unroll
        for (int ai = 0; ai < 2; ++ai)
#pragma unroll
            for (int m = 0; m < 4; ++m) {
                const int slot = slotv[ai * 4 + m]; const float gt = gtv[ai * 4 + m];
                { unsigned char* rowp = (slot >= 0 ? Y + (size_t)slot * D : dump) + col0;
#pragma unroll
                    for (int bj = 0; bj < 2; ++bj) { const f32x4 v0 = (acc[ai][bj][m][0] * (1.0f / 32.0f) + bv[bj][0]) * gt, v1 = (acc[ai][bj][m][1] * (1.0f / 32.0f) + bv[bj][1]) * gt;
                        u32x2 w; w.x = pk4_fp8(v0[0], v0[1], v0[2], v0[3]); w.y = pk4_fp8(v1[0], v1[1], v1[2], v1[3]);
                        *(u32x2*)(rowp + bj * HALF) = w; } }
                asm volatile("" ::: "memory"); }
    }
};

typedef int i32x8 __attribute__((ext_vector_type(8)));
typedef int i32x4 __attribute__((ext_vector_type(4)));
template <bool FP8> struct FragT { typedef bf16x8 A[4][2]; typedef bf16x8 B[2][2]; };
template <> struct FragT<true> { typedef i32x8 A[4]; typedef i32x8 B[2]; };
template <class Epi, class Sched, bool GATHER, bool FP8>
__device__ __forceinline__ void gemm_phase(LAS unsigned char* lds, const Gemm g, const Sched& S, const Epi& E, int tileA0) {
    int tid = threadIdx.x; asm volatile("" : "+v"(tid));
    const int wid = __builtin_amdgcn_readfirstlane(tid >> 6), lane = tid & 63, wr = wid >> 2, wc = wid & 3, fr = lane & 15, fq = lane >> 4;
    constexpr int KB = FP8 ? K : 2 * K;
    constexpr int nt = FP8 ? K / 128 : K / 64;
    unsigned cA[2], voffB[2]; int rA[2];
#pragma unroll
    for (int i = 0; i < 2; ++i) { int R, C; stage_rc(tid * 16 + i * 8192, R, C, FP8 ? 4 : 5); const int Rb = Epi::PERM ? ((R & ~31) + perm32(R & 31)) : R;
        cA[i] = (unsigned)(C * 2); rA[i] = R; voffB[i] = (unsigned)(Rb * KB + C * 2); }
    constexpr size_t kstep = 128;
    constexpr size_t hstep = (size_t)HALF * KB;
    constexpr size_t tstep = 2 * hstep;
    const unsigned ldsw = (unsigned)wid * 1024u;
    const int aoff = FP8 ? lds_byte(wr * 64 + fr, fq * 16, 4) : lds_byte(wr * 64 + fr, fq * 8), boff = FP8 ? lds_byte(wc * 32 + fr, fq * 16, 4) : lds_byte(wc * 32 + fr, fq * 8);
    const int aoff1 = FP8 ? lds_byte(wr * 64 + fr, fq * 16 + 8, 4) : 0, boff1 = FP8 ? lds_byte(wc * 32 + fr, fq * 16 + 8, 4) : 0;
#define PG8_SA(b, h) (((b) * 2 + (h)) * HTB)
#define PG8_SB(b, h) ((4 + (b) * 2 + (h)) * HTB)
#define PG8_STAGE(bufoff, gbase, voff) do { _Pragma("unroll") for (int _i = 0; _i < 2; ++_i) \
        __builtin_amdgcn_global_load_lds((const unsigned*)((const char*)(gbase) + (voff)[_i]), (LAS unsigned*)(lds + (bufoff) + ldsw + _i * 8192), 16, 0, 0); } while (0)
#define PG8_LDA(dst, b, h) do { if constexpr (FP8) { _Pragma("unroll") for (int m = 0; m < 4; ++m) { dst[m].lo = *(const LAS i32x4*)(lds + PG8_SA(b, h) + aoff + m * 2048); dst[m].hi = *(const LAS i32x4*)(lds + PG8_SA(b, h) + aoff1 + m * 2048); } } \
        else { _Pragma("unroll") for (int m = 0; m < 4; ++m) _Pragma("unroll") for (int k = 0; k < 2; ++k) dst[m][k] = *(const LAS bf16x8*)(lds + PG8_SA(b, h) + aoff + m * 2048 + k * 1024); } } while (0)
#define PG8_LDB(dst, b, h) do { if constexpr (FP8) { _Pragma("unroll") for (int n = 0; n < 2; ++n) { dst[n].lo = *(const LAS i32x4*)(lds + PG8_SB(b, h) + boff + n * 2048); dst[n].hi = *(const LAS i32x4*)(lds + PG8_SB(b, h) + boff1 + n * 2048); } } \
        else { _Pragma("unroll") for (int n = 0; n < 2; ++n) _Pragma("unroll") for (int k = 0; k < 2; ++k) dst[n][k] = *(const LAS bf16x8*)(lds + PG8_SB(b, h) + boff + n * 2048 + k * 1024); } } while (0)
#define PG8_MMA(ai, bj, At, Bt) do { __builtin_amdgcn_s_setprio(1); if constexpr (FP8) { _Pragma("unroll") for (int m = 0; m < 4; ++m) _Pragma("unroll") for (int n = 0; n < 2; ++n) \
            acc[ai][bj][m][n] = __builtin_amdgcn_mfma_scale_f32_16x16x128_f8f6f4(Bt[n], At[m], acc[ai][bj][m][n], 0, 0, 0, 0x7f7f7f7f, 0, 0x7f7f7f7f); } \
        else { _Pragma("unroll") for (int m = 0; m < 4; ++m) _Pragma("unroll") for (int n = 0; n < 2; ++n) _Pragma("unroll") for (int k = 0; k < 2; ++k) \
            acc[ai][bj][m][n] = __builtin_amdgcn_mfma_f32_16x16x32_bf16(Bt[n][k], At[m][k], acc[ai][bj][m][n], 0, 0, 0); } __builtin_amdgcn_s_setprio(0); } while (0)
#define PG8_WAIT_V(n) asm volatile("s_waitcnt vmcnt(" #n ")" ::: "memory")
#define PG8_WAIT_L(n) asm volatile("s_waitcnt lgkmcnt(" #n ")" ::: "memory")
#define PG8_BAR __builtin_amdgcn_s_barrier()
#define PG8_SCHED __builtin_amdgcn_sched_barrier(0)
#define PG8_GLOAD(dst, slot, u) do { _Pragma("unroll") for (int h = 0; h < 2; ++h) _Pragma("unroll") for (int i = 0; i < 2; ++i) \
        dst[h][i] = (GATHER ? (unsigned)g.gidx[(slot) * 256 + h * HALF + rA[i]] : (unsigned)(((u).pm - tileA0) * BM + h * HALF + rA[i])) * (unsigned)KB + cA[i]; } while (0)
#define PG8_STAGE_A(bufoff, ptr, h, VG) PG8_STAGE(bufoff, ptr, VG[h])
    Unit cur, nxt; int ui = 0;
    if (!S.next(0, cur)) return;
    f32x4 acc[2][2][4][2];
#pragma unroll
    for (int a = 0; a < 2; ++a)
#pragma unroll
        for (int b = 0; b < 2; ++b)
#pragma unroll
            for (int m = 0; m < 4; ++m)
#pragma unroll
                for (int n = 0; n < 2; ++n) acc[a][b][m][n] = (f32x4){0.f, 0.f, 0.f, 0.f};
    typename FragT<FP8>::A At; typename FragT<FP8>::B B0, B1;
    unsigned vC[2][2];
    PG8_GLOAD(vC, 0, cur);
    const char* const Ab = (const char*)g.A;
    const char* cB = (const char*)g.Bt + (size_t)cur.e * g.estride + (size_t)cur.pn * tstep;
    PG8_STAGE(PG8_SB(0, 0), cB, voffB); PG8_STAGE(PG8_SB(0, 1), cB + hstep, voffB); PG8_STAGE_A(PG8_SA(0, 0), Ab, 0, vC); PG8_STAGE_A(PG8_SA(0, 1), Ab, 1, vC);
    if (wr == 1) PG8_BAR;
    PG8_WAIT_V(2); PG8_BAR;
    PG8_STAGE(PG8_SB(1, 0), cB + kstep, voffB); PG8_STAGE_A(PG8_SA(1, 0), Ab + kstep, 0, vC); PG8_STAGE(PG8_SB(1, 1), cB + hstep + kstep, voffB);
    PG8_WAIT_V(6); PG8_BAR;
    for (;;) {
        const bool has_next = S.next(ui + 1, nxt);
        const char* nB = has_next ? (const char*)g.Bt + (size_t)nxt.e * g.estride + (size_t)nxt.pn * tstep : cB;
#pragma unroll 1
        for (int t = 0; t < nt; t += 2) {
            const bool last = (t == nt - 2);
            const char* a1 = Ab + (size_t)(t + 1) * kstep;
            const char* a2 = last ? Ab : Ab + (size_t)(t + 2) * kstep; const char* b2 = last ? nB : cB + (size_t)(t + 2) * kstep;
            const char* a3 = a2 + kstep; const char* b3 = b2 + kstep;
            PG8_LDB(B0, 0, 0); PG8_LDB(B1, 0, 1); PG8_SCHED; PG8_LDA(At, 0, 0); PG8_STAGE_A(PG8_SA(1, 1), a1, 1, vC);
            if (last && has_next) { PG8_GLOAD(vC, ui + 1, nxt); }
            PG8_WAIT_V(8); PG8_WAIT_L(0); PG8_BAR; PG8_MMA(0, 0, At, B0); PG8_MMA(0, 1, At, B1); PG8_BAR; PG8_SCHED;
            PG8_LDA(At, 0, 1); PG8_STAGE(PG8_SB(0, 0), b2, voffB); PG8_STAGE(PG8_SB(0, 1), b2 + hstep, voffB); PG8_STAGE_A(PG8_SA(0, 0), a2, 0, vC);
            PG8_WAIT_V(8); PG8_WAIT_L(0); PG8_BAR; PG8_MMA(1, 0, At, B0); PG8_MMA(1, 1, At, B1); PG8_BAR; PG8_SCHED;
            PG8_LDB(B0, 1, 0); PG8_LDB(B1, 1, 1); PG8_SCHED; PG8_LDA(At, 1, 0); PG8_STAGE_A(PG8_SA(0, 1), a2, 1, vC);
            PG8_WAIT_V(8); PG8_WAIT_L(0); PG8_BAR; PG8_MMA(0, 0, At, B0); PG8_MMA(0, 1, At, B1); PG8_BAR; PG8_SCHED;
            PG8_LDA(At, 1, 1); PG8_STAGE(PG8_SB(1, 0), b3, voffB); PG8_STAGE(PG8_SB(1, 1), b3 + hstep, voffB); PG8_STAGE_A(PG8_SA(1, 0), a3, 0, vC);
            PG8_WAIT_V(8); PG8_WAIT_L(0); PG8_BAR; PG8_MMA(1, 0, At, B0); PG8_MMA(1, 1, At, B1); PG8_BAR; PG8_SCHED;
        }
        if (wr == 0) PG8_BAR;
        { int fr_ = fr, fq_ = fq; asm volatile("" : "+v"(fr_), "+v"(fq_));
          E(acc, cur, wr, wc, fr_, fq_); }
        if (!has_next) break;
#pragma unroll
        for (int a = 0; a < 2; ++a)
#pragma unroll
            for (int b = 0; b < 2; ++b)
#pragma unroll
                for (int m = 0; m < 4; ++m)
#pragma unroll
                    for (int n = 0; n < 2; ++n) acc[a][b][m][n] = (f32x4){0.f, 0.f, 0.f, 0.f};
        cur = nxt; cB = nB; ++ui;
        if (wr == 1) PG8_BAR;
    }
    PG8_WAIT_V(0);
    PG8_BAR;
#undef PG8_SA
#undef PG8_SB
#undef PG8_STAGE
#undef PG8_LDA
#undef PG8_LDB
#undef PG8_MMA
#undef PG8_WAIT_V
#undef PG8_WAIT_L
#undef PG8_BAR
#undef PG8_SCHED
#undef PG8_GLOAD
#undef PG8_STAGE_A
}
}


namespace att {
typedef float f32x16 __attribute__((ext_vector_type(16)));
typedef short s16x4 __attribute__((ext_vector_type(4)));
typedef short v4i16_t __attribute__((ext_vector_type(4)));
typedef const LAS unsigned char* lptr;
__device__ __forceinline__ int crow(int r, int hi) { return (r & 3) + 8 * (r >> 2) + 4 * hi; }
__device__ __forceinline__ s16x4 vtr(lptr p) { return __builtin_bit_cast(s16x4, __builtin_amdgcn_ds_read_tr16_b64_v4i16((LAS v4i16_t*)p)); }
__device__ __forceinline__ void glds16(const void* g, LAS unsigned char* l) {
    const unsigned dst = (unsigned)__builtin_amdgcn_readfirstlane((int)(unsigned)(size_t)l); unsigned keep;
    asm volatile("s_mov_b32 %0, m0\n\ts_mov_b32 m0, %2\n\ts_nop 0\n\tglobal_load_lds_dwordx4 %1, off\n\ts_mov_b32 m0, %0" : "=&s"(keep) : "v"(g), "s"(dst) : "memory");
}
__device__ __forceinline__ float partner32(float x, bool hi) { auto rr = __builtin_amdgcn_permlane32_swap(__float_as_uint(x), __float_as_uint(x), false, false); return __uint_as_float(hi ? rr[0] : rr[1]); }
__device__ __forceinline__ void kload(bf16x8 (&kf)[8], lptr kslot, int r32, int hi) {
    lptr kb = kslot + hi * 1024 + r32 * 16;
#pragma unroll
    for (int d0 = 0; d0 < 4; ++d0) { kf[2 * d0] = *(const LAS bf16x8*)(kb + d0 * 2048); kf[2 * d0 + 1] = *(const LAS bf16x8*)(kb + d0 * 2048 + 512); }
}
__device__ __forceinline__ void qkt(f32x16& p0, f32x16& p1, const bf16x8 (&kf)[8], const bf16x8 (&qr)[4], const f32x16& c0) {
    __builtin_amdgcn_s_setprio(1);
    p0 = __builtin_amdgcn_mfma_f32_32x32x16_bf16(kf[0], qr[0], c0, 0, 0, 0); p1 = __builtin_amdgcn_mfma_f32_32x32x16_bf16(kf[1], qr[0], c0, 0, 0, 0);
#pragma unroll
    for (int d0 = 1; d0 < 4; ++d0) { p0 = __builtin_amdgcn_mfma_f32_32x32x16_bf16(kf[2 * d0], qr[d0], p0, 0, 0, 0); p1 = __builtin_amdgcn_mfma_f32_32x32x16_bf16(kf[2 * d0 + 1], qr[d0], p1, 0, 0, 0); }
    __builtin_amdgcn_s_setprio(0);
}
__device__ __forceinline__ void vload(bf16x8 (&vf)[8], lptr vp) {
#pragma unroll
    for (int d0 = 0; d0 < 2; ++d0)
#pragma unroll
        for (int ks = 0; ks < 4; ++ks) { const s16x4 lo = vtr(vp + d0 * 4096 + ks * 1024), hi4 = vtr(vp + d0 * 4096 + ks * 1024 + 512);
            vf[d0 * 4 + ks] = (bf16x8){lo[0], lo[1], lo[2], lo[3], hi4[0], hi4[1], hi4[2], hi4[3]}; }
}
__device__ __forceinline__ void pv64(f32x16& o0, f32x16& o1, const bf16x8 (&vf)[8], const bf16x8 (&pa)[4]) {
    __builtin_amdgcn_s_setprio(1);
#pragma unroll
    for (int ks = 0; ks < 4; ++ks) { o0 = __builtin_amdgcn_mfma_f32_32x32x16_bf16(pa[ks], vf[ks], o0, 0, 0, 0); o1 = __builtin_amdgcn_mfma_f32_32x32x16_bf16(pa[ks], vf[4 + ks], o1, 0, 0, 0); }
    __builtin_amdgcn_s_setprio(0);
}
__device__ __forceinline__ void pack_p(bf16x8 (&pa)[4], const f32x16& p0, const f32x16& p1) {
    u32x4 w0, w1, w2, w3;
    w0.x = cvt_pk_bf16(p0[0], p0[1]); w0.y = cvt_pk_bf16(p0[2], p0[3]); w0.z = cvt_pk_bf16(p0[4], p0[5]); w0.w = cvt_pk_bf16(p0[6], p0[7]);
    w1.x = cvt_pk_bf16(p0[8], p0[9]); w1.y = cvt_pk_bf16(p0[10], p0[11]); w1.z = cvt_pk_bf16(p0[12], p0[13]); w1.w = cvt_pk_bf16(p0[14], p0[15]);
    w2.x = cvt_pk_bf16(p1[0], p1[1]); w2.y = cvt_pk_bf16(p1[2], p1[3]); w2.z = cvt_pk_bf16(p1[4], p1[5]); w2.w = cvt_pk_bf16(p1[6], p1[7]);
    w3.x = cvt_pk_bf16(p1[8], p1[9]); w3.y = cvt_pk_bf16(p1[10], p1[11]); w3.z = cvt_pk_bf16(p1[12], p1[13]); w3.w = cvt_pk_bf16(p1[14], p1[15]);
    pa[0] = __builtin_bit_cast(bf16x8, w0); pa[1] = __builtin_bit_cast(bf16x8, w1); pa[2] = __builtin_bit_cast(bf16x8, w2); pa[3] = __builtin_bit_cast(bf16x8, w3);
}

#define ATT_WAIT_BAR(N) asm volatile("s_waitcnt vmcnt(" #N ") lgkmcnt(0)\n\ts_barrier" ::: "memory")
#define ATT_BAR() asm volatile("s_waitcnt lgkmcnt(0)\n\ts_barrier" ::: "memory")
__device__ __forceinline__ void sb_probs(f32x16& p0, f32x16& p1) {
#pragma unroll
    for (int r = 0; r < 16; ++r) { p0[r] = __builtin_amdgcn_rcpf(1.0f + __builtin_amdgcn_exp2f(p0[r])); p1[r] = __builtin_amdgcn_rcpf(1.0f + __builtin_amdgcn_exp2f(p1[r])); }
}
__device__ __forceinline__ void sb_mask(f32x16& p0, f32x16& p1, int lim, int hi) {
#pragma unroll
    for (int r = 0; r < 16; ++r) { const int kl = crow(r, hi); if (kl >= lim) p0[r] = 1.0f; if (kl + 32 >= lim) p1[r] = 1.0f; }
}
__device__ __forceinline__ void sb_scan(f32x16& p0, f32x16& p1, float& carry, bool hib) {
    float G[8], Gp[8];
#pragma unroll
    for (int gi = 0; gi < 4; ++gi) { G[gi] = (p0[4 * gi] * p0[4 * gi + 1]) * (p0[4 * gi + 2] * p0[4 * gi + 3]); G[4 + gi] = (p1[4 * gi] * p1[4 * gi + 1]) * (p1[4 * gi + 2] * p1[4 * gi + 3]); }
#pragma unroll
    for (int gi = 0; gi < 8; ++gi) Gp[gi] = partner32(G[gi], hib);
    float u = carry;
#pragma unroll
    for (int gi = 7; gi >= 0; --gi) {
        const float ug = u * Gp[gi]; float tt = hib ? u : ug;
#pragma unroll
        for (int i = 3; i >= 0; --i) { if (gi >= 4) { const float tn = tt * p1[4 * (gi - 4) + i]; p1[4 * (gi - 4) + i] = tt - tn; tt = tn; } else { const float tn = tt * p0[4 * gi + i]; p0[4 * gi + i] = tt - tn; tt = tn; } }
        u = ug * G[gi];
    }
    carry = u;
}
__device__ __forceinline__ void sb_head(LAS unsigned char* lds, const bf16_t* PROJ, const bf16_t* METAKV, bf16_t* MIX, int b, int h) {
    int tid = threadIdx.x; asm volatile("" : "+v"(tid));
    const int lane = tid & 63, r32 = lane & 31, hi = lane >> 5; const int wid = __builtin_amdgcn_readfirstlane(tid >> 6);
    const bool hib = hi != 0;
    const bf16_t* Kg = PROJ + (size_t)b * SEQ * DIN + COL_SBK + h * 64; const bf16_t* Vg = PROJ + (size_t)b * SEQ * DIN + COL_SBV + h * 64;
    const bf16_t* Km = METAKV + COL_SBK + h * 64; const bf16_t* Vm = METAKV + COL_SBV + h * 64;
    const int vrow = 16 * (wid & 3) + (lane >> 2), vcol = (wid >> 2) * 32 + (lane & 3) * 8;
    const int voff_lane = ((lane >> 4) & 1) * 32 + (lane & 3) * 8 + (4 * hi + ((lane & 15) >> 2)) * 64;
    int c_qb = 7, c_ip = 0, n_iss = 0, s_iss = 0;
#define SB_ISSUE_NEXT() do { if (c_qb >= 0) { LAS unsigned char* bb_ = lds + s_iss * 32768; const int NT_ = 4 * c_qb + 4, NP_ = NT_ >> 1; \
        if (c_ip < NP_) { const int keyA_ = 64 * (NT_ - 1 - 2 * c_ip), keyB_ = keyA_ - 64; \
            glds16(Kg + (size_t)(keyA_ + lane) * DIN + wid * 8, bb_ + wid * 1024); glds16(Vg + (size_t)(keyA_ + vrow) * DIN + vcol, bb_ + 8192 + wid * 1024); \
            glds16(Kg + (size_t)(keyB_ + lane) * DIN + wid * 8, bb_ + 16384 + wid * 1024); glds16(Vg + (size_t)(keyB_ + vrow) * DIN + vcol, bb_ + 24576 + wid * 1024); } \
        else { glds16(Km + (size_t)(lane < 16 ? lane : 15) * DIN + wid * 8, bb_ + wid * 1024); glds16(Vm + (size_t)(vrow < 16 ? vrow : 15) * DIN + vcol, bb_ + 8192 + wid * 1024); \
            glds16(Km + (size_t)(lane < 16 ? lane : 15) * DIN + wid * 8, bb_ + 16384 + wid * 1024); glds16(Vm + (size_t)(vrow < 16 ? vrow : 15) * DIN + vcol, bb_ + 24576 + wid * 1024); } \
        ++n_iss; s_iss = s_iss == 2 ? 0 : s_iss + 1; if (++c_ip > NP_) { c_ip = 0; --c_qb; } } } while (0)
    SB_ISSUE_NEXT(); SB_ISSUE_NEXT();
    bf16x8 qr[4];
    { const bf16_t* qp = PROJ + ((size_t)b * SEQ + 7 * 256 + wid * 32 + r32) * DIN + COL_SBQ + h * 64 + hi * 8;
#pragma unroll
      for (int d0 = 0; d0 < 4; ++d0) qr[d0] = *(const bf16x8*)(qp + d0 * 16); }
    asm volatile("" : "+v"(qr[0]), "+v"(qr[1]), "+v"(qr[2]), "+v"(qr[3]));
    int js = 0, s_cmp = 0;
    for (int qb = 7; qb >= 0; --qb) {
        const int NT = 4 * qb + 4, NP = NT / 2, q0w = qb * 256 + wid * 32, my_diag = 4 * qb + (wid >> 1);
        f32x16 o0 = {}, o1 = {}; float carry = 1.0f;
        bf16x8 qn[4] = {qr[0], qr[1], qr[2], qr[3]};
        for (int ip = 0; ip <= NP; ++ip) {
            if (ip == 0) ATT_BAR(); else if (js + 1 < n_iss) ATT_WAIT_BAR(4); else ATT_WAIT_BAR(0);
            SB_ISSUE_NEXT();
            if (ip == NP && qb > 0) { const bf16_t* qp = PROJ + ((size_t)b * SEQ + (qb - 1) * 256 + wid * 32 + r32) * DIN + COL_SBQ + h * 64 + hi * 8;
#pragma unroll
                for (int d0 = 0; d0 < 4; ++d0) qn[d0] = *(const bf16x8*)(qp + d0 * 16); }
            lptr bb = lds + s_cmp * 32768;
            const f32x16 z16 = {};
            if (ip == NP) {
                f32x16 p0;
                { lptr kb = bb + hi * 1024 + r32 * 16; bf16x8 k4[4];
#pragma unroll
                  for (int d0 = 0; d0 < 4; ++d0) k4[d0] = *(const LAS bf16x8*)(kb + d0 * 2048);
                  p0 = __builtin_amdgcn_mfma_f32_32x32x16_bf16(k4[0], qr[0], z16, 0, 0, 0);
#pragma unroll
                  for (int d0 = 1; d0 < 4; ++d0) p0 = __builtin_amdgcn_mfma_f32_32x32x16_bf16(k4[d0], qr[d0], p0, 0, 0, 0); }
                lptr vp = bb + 8192 + voff_lane;
                const s16x4 vl0 = vtr(vp), vh0 = vtr(vp + 512), vl1 = vtr(vp + 4096), vh1 = vtr(vp + 4096 + 512);
                float pm[8];
#pragma unroll
                for (int r = 0; r < 8; ++r) pm[r] = __builtin_amdgcn_rcpf(1.0f + __builtin_amdgcn_exp2f(p0[r]));
                const float G0 = (pm[0] * pm[1]) * (pm[2] * pm[3]), G1 = (pm[4] * pm[5]) * (pm[6] * pm[7]);
                const float Gp0 = partner32(G0, hib), Gp1 = partner32(G1, hib);
                float u = carry;
                { const float ug = u * Gp1; float tt = hib ? u : ug;
#pragma unroll
                  for (int i = 3; i >= 0; --i) { const float tn = tt * pm[4 + i]; pm[4 + i] = tt - tn; tt = tn; }
                  u = ug * G1; }
                { const float ug = u * Gp0; float tt = hib ? u : ug;
#pragma unroll
                  for (int i = 3; i >= 0; --i) { const float tn = tt * pm[i]; pm[i] = tt - tn; tt = tn; } }
                u32x4 w0; w0.x = cvt_pk_bf16(pm[0], pm[1]); w0.y = cvt_pk_bf16(pm[2], pm[3]); w0.z = cvt_pk_bf16(pm[4], pm[5]); w0.w = cvt_pk_bf16(pm[6], pm[7]);
                const bf16x8 pa0 = __builtin_bit_cast(bf16x8, w0);
                o0 = __builtin_amdgcn_mfma_f32_32x32x16_bf16(pa0, (bf16x8){vl0[0], vl0[1], vl0[2], vl0[3], vh0[0], vh0[1], vh0[2], vh0[3]}, o0, 0, 0, 0);
                o1 = __builtin_amdgcn_mfma_f32_32x32x16_bf16(pa0, (bf16x8){vl1[0], vl1[1], vl1[2], vl1[3], vh1[0], vh1[1], vh1[2], vh1[3]}, o1, 0, 0, 0);
            } else {
                const int tA = NT - 1 - 2 * ip, tB = tA - 1;
                if (tA <= my_diag) {
                    f32x16 a0, a1, b0, b1; bf16x8 kf[8];
                    kload(kf, bb, r32, hi); qkt(a0, a1, kf, qr, z16);
                    kload(kf, bb + 16384, r32, hi); qkt(b0, b1, kf, qr, z16);
                    sb_probs(a0, a1); sb_probs(b0, b1);
                    if (tA == my_diag) sb_mask(a0, a1, q0w + r32 - 64 * tA, hi);
                    sb_scan(a0, a1, carry, hib);
                    { bf16x8 vf[8]; vload(vf, bb + 8192 + voff_lane); bf16x8 pa[4]; pack_p(pa, a0, a1); pv64(o0, o1, vf, pa); }
                    sb_scan(b0, b1, carry, hib);
                    { bf16x8 vf[8]; vload(vf, bb + 24576 + voff_lane); bf16x8 pa[4]; pack_p(pa, b0, b1); pv64(o0, o1, vf, pa); }
                } else if (tB <= my_diag) {
                    f32x16 p0, p1; bf16x8 kf[8]; kload(kf, bb + 16384, r32, hi); qkt(p0, p1, kf, qr, z16);
                    bf16x8 vf[8]; vload(vf, bb + 24576 + voff_lane);
                    sb_probs(p0, p1); if (tB == my_diag) sb_mask(p0, p1, q0w + r32 - 64 * tB, hi); sb_scan(p0, p1, carry, hib);
                    bf16x8 pa[4]; pack_p(pa, p0, p1); pv64(o0, o1, vf, pa);
                }
            }
            ++js; s_cmp = s_cmp == 2 ? 0 : s_cmp + 1;
        }
        if (qb > 0) asm volatile("" : "+v"(qn[0]), "+v"(qn[1]), "+v"(qn[2]), "+v"(qn[3]));
        { LAS bf16_t* stg = (LAS bf16_t*)(lds + 98304 + wid * 4096);
#pragma unroll
          for (int r = 0; r < 16; ++r) { const int orow = crow(r, hi); stg[orow * 64 + r32] = (bf16_t)f2bf(o0[r]); stg[orow * 64 + 32 + r32] = (bf16_t)f2bf(o1[r]); }
          bf16_t* Ow = MIX + ((size_t)b * SEQ + q0w) * D + h * 64;
#pragma unroll
          for (int i = 0; i < 4; ++i) { const int row = i * 8 + (lane >> 3), ch = lane & 7; const u32x4 v = *(const LAS u32x4*)(stg + row * 64 + ch * 8); *(u32x4*)(Ow + (size_t)row * D + ch * 8) = v; } }
#pragma unroll
        for (int d0 = 0; d0 < 4; ++d0) qr[d0] = qn[d0];
    }
    asm volatile("s_waitcnt vmcnt(0) lgkmcnt(0)\n\ts_barrier" ::: "memory");
#undef SB_ISSUE_NEXT
}

constexpr float DF_THR = 8.0f;
__device__ __forceinline__ void df_head(LAS unsigned char* lds, LAS float* wsf_all, const LAS float* btab, float lam, const float* sgain, const bf16_t* PROJ, const bf16_t* METAKV, bf16_t* MIX, int b, int hd, int which) {
    int tid = threadIdx.x; asm volatile("" : "+v"(tid));
    const int lane = tid & 63, r32 = lane & 31, hi = lane >> 5; const int wid = __builtin_amdgcn_readfirstlane(tid >> 6);
    const bool hib = hi != 0; const int s = wid >> 2, qw = wid & 3;
    const size_t rb = (size_t)b * SEQ * DIN;
    const bf16_t* K0g = PROJ + rb + COL_DFK + (2 * hd) * 64; const bf16_t* K1g = K0g + 64; const bf16_t* Vg = PROJ + rb + COL_DFV + hd * 128;
    const bf16_t* K0m = METAKV + COL_DFK + (2 * hd) * 64; const bf16_t* K1m = K0m + 64; const bf16_t* Vm = METAKV + COL_DFV + hd * 128;
    const int vrow = 16 * (wid & 3) + (lane >> 2), vcol = (wid >> 2) * 32 + (lane & 3) * 8;
    const int voff_lane = ((lane >> 4) & 1) * 32 + (lane & 3) * 8 + (4 * hi + ((lane & 15) >> 2)) * 64;
    LAS float* wsf = wsf_all + wid * 64;
    const LAS float* bt = btab + hd * 288 + 96;
    const float bfar = bt[0];
#define DF_UNIT(i8_) (2 * (i8_) + (which ? 1 - ((i8_) & 1) : ((i8_) & 1)))
    int c_i8 = 0, c_it = 0, n_iss = 0, s_iss = 0;
#define DF_ISSUE_NEXT() do { if (c_i8 < 8) { LAS unsigned char* bb_ = lds + s_iss * 32768; const int NTL_ = 2 * DF_UNIT(c_i8) + 2; \
        if (c_it < NTL_) { const int key0_ = 64 * c_it; const size_t ko_ = (size_t)(key0_ + lane) * DIN + wid * 8, vo_ = (size_t)(key0_ + vrow) * DIN + vcol; \
            glds16(K0g + ko_, bb_ + wid * 1024); glds16(K1g + ko_, bb_ + 8192 + wid * 1024); glds16(Vg + vo_, bb_ + 16384 + wid * 1024); glds16(Vg + vo_ + 64, bb_ + 24576 + wid * 1024); } \
        else { const size_t ko_ = (size_t)(lane < 16 ? lane : 15) * DIN + wid * 8, vo_ = (size_t)(vrow < 16 ? vrow : 15) * DIN + vcol; \
            glds16(K0m + ko_, bb_ + wid * 1024); glds16(K1m + ko_, bb_ + 8192 + wid * 1024); glds16(Vm + vo_, bb_ + 16384 + wid * 1024); glds16(Vm + vo_ + 64, bb_ + 24576 + wid * 1024); } \
        ++n_iss; s_iss = s_iss == 2 ? 0 : s_iss + 1; if (++c_it > NTL_) { c_it = 0; ++c_i8; } } } while (0)
    DF_ISSUE_NEXT(); DF_ISSUE_NEXT();
    bf16x8 qr[4];
    { const bf16_t* qp = PROJ + ((size_t)b * SEQ + DF_UNIT(0) * 128 + qw * 32 + r32) * DIN + COL_DFQ + (2 * hd + s) * 64 + hi * 8;
#pragma unroll
      for (int d0 = 0; d0 < 4; ++d0) qr[d0] = *(const bf16x8*)(qp + d0 * 16); }
    float gnv[4];
#pragma unroll
    for (int db = 0; db < 4; ++db) gnv[db] = sgain[db * 32 + r32];
    asm volatile("" : "+v"(qr[0]), "+v"(qr[1]), "+v"(qr[2]), "+v"(qr[3]), "+v"(gnv[0]), "+v"(gnv[1]), "+v"(gnv[2]), "+v"(gnv[3]));
    int js = 0, s_cmp = 0;
    for (int i8 = 0; i8 < 8; ++i8) {
        const int u = DF_UNIT(i8);
        const int NTL = 2 * u + 2;
        const int q0w = u * 128 + qw * 32, mychunk = 2 * u + (qw >> 1);
        f32x16 o[4] = {{}, {}, {}, {}}; float mrun = -1e30f, lsum = 0.f;
        bf16x8 qn[4] = {qr[0], qr[1], qr[2], qr[3]};
        for (int it = 0; it < NTL; ++it) {
            if (it == 0) ATT_BAR(); else ATT_WAIT_BAR(4);
            DF_ISSUE_NEXT();
            if (it <= mychunk) {
                lptr bb = lds + s_cmp * 32768;
                const int kbase = 64 * it;
                const bool near = (q0w - (kbase + 63)) < 128;
                f32x16 p0, p1; const f32x16 c0 = {};
                const float badd = near ? 0.f : bfar;
                bf16x8 kf[8]; kload(kf, bb + s * 8192, r32, hi); __builtin_amdgcn_sched_barrier(0);
                qkt(p0, p1, kf, qr, c0);
                if (near) { const LAS float* btl = bt + (kbase - (q0w + r32) + 128 + 4 * hi);
#pragma unroll
                    for (int r = 0; r < 16; ++r) { p0[r] += btl[crow(r, 0)]; p1[r] += btl[crow(r, 0) + 32]; } }
                float tm = fmaxf(p0[0], p1[0]);
#pragma unroll
                for (int r = 1; r < 16; ++r) tm = fmaxf(tm, fmaxf(p0[r], p1[r]));
                tm = fmaxf(tm, partner32(tm, hib)) + badd;
                if (__any(tm > mrun + DF_THR)) {
                    const float mn = fmaxf(mrun, tm); const float f = __builtin_amdgcn_exp2f(mrun - mn); mrun = mn; lsum *= f;
                    if (!hib) wsf[r32] = f;
#pragma unroll
                    for (int r = 0; r < 16; ++r) { const float fr_ = wsf[crow(r, hi)]; o[0][r] *= fr_; o[1][r] *= fr_; o[2][r] *= fr_; o[3][r] *= fr_; }
                }
                float ps = 0.f;
                const float msub = mrun - badd;
#pragma unroll
                for (int r = 0; r < 16; ++r) { p0[r] = __builtin_amdgcn_exp2f(p0[r] - msub); p1[r] = __builtin_amdgcn_exp2f(p1[r] - msub); ps += p0[r] + p1[r]; }
                lsum += ps;
                bf16x8 pa[4]; pack_p(pa, p0, p1);
                bf16x8 vf[8]; vload(vf, bb + 16384 + voff_lane); __builtin_amdgcn_sched_barrier(0);
                pv64(o[0], o[1], vf, pa);
                vload(vf, bb + 24576 + voff_lane); __builtin_amdgcn_sched_barrier(0);
                pv64(o[2], o[3], vf, pa);
            }
            ++js; s_cmp = s_cmp == 2 ? 0 : s_cmp + 1;
        }
        {
            if (js + 1 < n_iss) ATT_WAIT_BAR(4); else ATT_WAIT_BAR(0);
            DF_ISSUE_NEXT();
            if (i8 < 7) { const bf16_t* qp = PROJ + ((size_t)b * SEQ + DF_UNIT(i8 + 1) * 128 + qw * 32 + r32) * DIN + COL_DFQ + (2 * hd + s) * 64 + hi * 8;
#pragma unroll
                for (int d0 = 0; d0 < 4; ++d0) qn[d0] = *(const bf16x8*)(qp + d0 * 16); }
            {
                lptr bb = lds + s_cmp * 32768;
                const bool near = (q0w + 16 - 15) < 128;
                const float badd = near ? 0.f : bfar;
                f32x16 p0; const f32x16 c0 = {};
                { lptr kb = bb + s * 8192 + hi * 1024 + r32 * 16; bf16x8 k4[4];
#pragma unroll
                  for (int d0 = 0; d0 < 4; ++d0) k4[d0] = *(const LAS bf16x8*)(kb + d0 * 2048);
                  p0 = __builtin_amdgcn_mfma_f32_32x32x16_bf16(k4[0], qr[0], c0, 0, 0, 0);
#pragma unroll
                  for (int d0 = 1; d0 < 4; ++d0) p0 = __builtin_amdgcn_mfma_f32_32x32x16_bf16(k4[d0], qr[d0], p0, 0, 0, 0); }
                lptr vpa = bb + 16384 + voff_lane; lptr vpb = bb + 24576 + voff_lane;
                const s16x4 al0 = vtr(vpa), ah0 = vtr(vpa + 512), al1 = vtr(vpa + 4096), ah1 = vtr(vpa + 4096 + 512);
                const s16x4 bl0 = vtr(vpb), bh0 = vtr(vpb + 512), bl1 = vtr(vpb + 4096), bh1 = vtr(vpb + 4096 + 512);
                float pm[8];
#pragma unroll
                for (int r = 0; r < 8; ++r) pm[r] = p0[r];
                if (near) { const int base = -16 - (q0w + r32) + 128;
#pragma unroll
                    for (int r = 0; r < 8; ++r) pm[r] += bt[base + crow(r, hi)]; }
                float tm = fmaxf(fmaxf(pm[0], pm[1]), fmaxf(pm[2], pm[3])); tm = fmaxf(tm, fmaxf(fmaxf(pm[4], pm[5]), fmaxf(pm[6], pm[7])));
                tm = fmaxf(tm, partner32(tm, hib)) + badd;
                if (__any(tm > mrun + DF_THR)) {
                    const float mn = fmaxf(mrun, tm); const float f = __builtin_amdgcn_exp2f(mrun - mn); mrun = mn; lsum *= f;
                    if (!hib) wsf[r32] = f;
#pragma unroll
                    for (int r = 0; r < 16; ++r) { const float fr_ = wsf[crow(r, hi)]; o[0][r] *= fr_; o[1][r] *= fr_; o[2][r] *= fr_; o[3][r] *= fr_; }
                }
                float ps = 0.f; const float msub = mrun - badd;
#pragma unroll
                for (int r = 0; r < 8; ++r) { pm[r] = __builtin_amdgcn_exp2f(pm[r] - msub); ps += pm[r]; }
                lsum += ps;
                u32x4 w0; w0.x = cvt_pk_bf16(pm[0], pm[1]); w0.y = cvt_pk_bf16(pm[2], pm[3]); w0.z = cvt_pk_bf16(pm[4], pm[5]); w0.w = cvt_pk_bf16(pm[6], pm[7]);
                const bf16x8 pa0 = __builtin_bit_cast(bf16x8, w0);
#define DF_FR(l_, h_) (bf16x8){l_[0], l_[1], l_[2], l_[3], h_[0], h_[1], h_[2], h_[3]}
                o[0] = __builtin_amdgcn_mfma_f32_32x32x16_bf16(pa0, DF_FR(al0, ah0), o[0], 0, 0, 0); o[1] = __builtin_amdgcn_mfma_f32_32x32x16_bf16(pa0, DF_FR(al1, ah1), o[1], 0, 0, 0);
                o[2] = __builtin_amdgcn_mfma_f32_32x32x16_bf16(pa0, DF_FR(bl0, bh0), o[2], 0, 0, 0); o[3] = __builtin_amdgcn_mfma_f32_32x32x16_bf16(pa0, DF_FR(bl1, bh1), o[3], 0, 0, 0);
#undef DF_FR
            }
            ++js; s_cmp = s_cmp == 2 ? 0 : s_cmp + 1;
        }
        if (i8 < 7) asm volatile("" : "+v"(qn[0]), "+v"(qn[1]), "+v"(qn[2]), "+v"(qn[3]));
        const float ltot = lsum + partner32(lsum, hib);
        if (!hib) wsf[r32] = (s ? lam : 1.0f) / ltot;
        float sc[16];
#pragma unroll
        for (int r = 0; r < 16; ++r) sc[r] = wsf[crow(r, hi)];
        LAS unsigned* X = (LAS unsigned*)(lds + 98304 + qw * 8192);
        if (s == 1) {
#pragma unroll
            for (int db = 0; db < 4; ++db)
#pragma unroll
                for (int rp = 0; rp < 8; ++rp) X[(db * 8 + rp) * 64 + lane] = cvt_pk_bf16(o[db][2 * rp] * sc[2 * rp], o[db][2 * rp + 1] * sc[2 * rp + 1]);
        }
        ATT_BAR();
        if (s == 0) {
            float ssq[16];
#pragma unroll
            for (int r = 0; r < 16; ++r) ssq[r] = 0.f;
#pragma unroll
            for (int db = 0; db < 4; ++db)
#pragma unroll
                for (int rp = 0; rp < 8; ++rp) { const unsigned xx = X[(db * 8 + rp) * 64 + lane];
                    const float a0 = o[db][2 * rp] * sc[2 * rp] - bf_lo(xx), a1 = o[db][2 * rp + 1] * sc[2 * rp + 1] - bf_hi(xx);
                    o[db][2 * rp] = a0; o[db][2 * rp + 1] = a1; ssq[2 * rp] += a0 * a0; ssq[2 * rp + 1] += a1 * a1; }
#pragma unroll
            for (int r = 0; r < 16; ++r) {
#pragma unroll
                for (int of = 1; of < 32; of <<= 1) ssq[r] += __shfl_xor(ssq[r], of);
                ssq[r] = (1.0f - LAMBDA_INIT) / sqrtf(ssq[r] * (1.0f / 128.0f) + SUBLN_EPS); }
            LAS bf16_t* stg = (LAS bf16_t*)X;
#pragma unroll
            for (int db = 0; db < 4; ++db)
#pragma unroll
                for (int r = 0; r < 16; ++r) stg[crow(r, hi) * 128 + db * 32 + r32] = (bf16_t)f2bf(o[db][r] * ssq[r] * gnv[db]);
            bf16_t* Ow = MIX + ((size_t)b * SEQ + q0w) * D + 512 + hd * 128;
            const int row0 = lane >> 4, ch = lane & 15;
#pragma unroll
            for (int i = 0; i < 8; ++i) { const int row = row0 + 4 * i; const u32x4 v = *(const LAS u32x4*)(stg + row * 128 + ch * 8); *(u32x4*)(Ow + (size_t)row * D + ch * 8) = v; }
        }
#pragma unroll
        for (int d0 = 0; d0 < 4; ++d0) qr[d0] = qn[d0];
    }
    asm volatile("s_waitcnt vmcnt(0) lgkmcnt(0)\n\ts_barrier" ::: "memory");
#undef DF_ISSUE_NEXT
#undef DF_UNIT
}
}

#define XB_TMO      128
#define XB_XCNT(j)  (256  + 64 * (j))
#define XB_XSUB(j)  (1280 + 64 * (j))
#define XB_XGEN(j)  (2304 + 64 * (j))
#define XB_TOP      3328
#define XB_TOPGEN   3392
#define XCD_BAR_WORDS 3456
#define XB_SPIN_CAP (1u << 18)
__device__ __forceinline__ unsigned xb_ld(unsigned* p)              { return __hip_atomic_load(p, __ATOMIC_RELAXED, __HIP_MEMORY_SCOPE_AGENT); }
__device__ __forceinline__ unsigned xb_add(unsigned* p, unsigned v) { return __hip_atomic_fetch_add(p, v, __ATOMIC_RELAXED, __HIP_MEMORY_SCOPE_AGENT); }
__device__ __forceinline__ unsigned xb_xcc_id() { return (unsigned)__builtin_amdgcn_s_getreg((3 << 11) | 20) & 0xFu; }
#define XB_SPIN(cond, bar) do { unsigned _sp = 0; while (cond) { __builtin_amdgcn_s_sleep(1); \
    if ((++_sp & 255u) == 0u) { if (xb_ld(&(bar)[XB_TMO])) break; if (_sp > XB_SPIN_CAP) { atomicAdd(&(bar)[XB_TMO], 1u); break; } } } } while (0)
struct XcdBarrier { unsigned* bar; unsigned x; volatile LAS unsigned* st; };
__device__ __forceinline__ XcdBarrier xcd_barrier_post(unsigned* bar, volatile LAS unsigned* st) {
    XcdBarrier b; b.bar = bar; b.x = xb_xcc_id(); b.st = st;
    if (threadIdx.x == 0) (void)xb_add(&bar[XB_XCNT(b.x)], 1u);
    return b;
}
__device__ __forceinline__ void xcd_barrier_complete(unsigned* bar, unsigned x, unsigned& nloc, unsigned& nx) {
    const unsigned G = gridDim.x * gridDim.y * gridDim.z;
    unsigned sum, cnt, mine, sp = 0u;
    for (;;) {
        sum = 0u; cnt = 0u; mine = 0u;
#pragma unroll
        for (unsigned j = 0; j < 16; ++j) { const unsigned c = xb_ld(&bar[XB_XCNT(j)]); sum += c; cnt += (c > 0u) ? 1u : 0u; mine = (j == x) ? c : mine; }
        if (sum == G) break;
        __builtin_amdgcn_s_sleep(1);
        if ((++sp & 255u) == 0u) { if (xb_ld(&bar[XB_TMO])) break; if (sp > XB_SPIN_CAP) { atomicAdd(&bar[XB_TMO], 1u); break; } }
    }
    nloc = mine > 0u ? mine : 1u; nx = cnt > 0u ? cnt : 1u;
}
__device__ __forceinline__ void xcd_barrier(const XcdBarrier& b) {
    asm volatile("s_waitcnt vmcnt(0)" ::: "memory");
    __syncthreads();
    if (threadIdx.x == 0) {
        unsigned* bar = b.bar;
        __builtin_amdgcn_s_waitcnt(0);
        unsigned nloc = b.st[0], nx = b.st[1];
        if (nloc == 0u) { xcd_barrier_complete(bar, b.x, nloc, nx); b.st[0] = nloc; b.st[1] = nx; }
        const unsigned old = xb_add(&bar[XB_XSUB(b.x)], 1u);
        const unsigned gen = old / nloc;
        if (old + 1u == (gen + 1u) * nloc) {
            __builtin_amdgcn_fence(__ATOMIC_RELEASE, "agent");
            asm volatile("s_waitcnt vmcnt(0)" ::: "memory");
            const unsigned og = xb_add(&bar[XB_TOP], 1u);
            const unsigned tg = og / nx;
            if (og + 1u == (tg + 1u) * nx) xb_add(&bar[XB_TOPGEN], 1u);
            else XB_SPIN(xb_ld(&bar[XB_TOPGEN]) == tg, bar);
            __builtin_amdgcn_fence(__ATOMIC_ACQUIRE, "agent");
            xb_add(&bar[XB_XGEN(b.x)], 1u);
            asm volatile("s_waitcnt vmcnt(0)" ::: "memory");
        } else {
            XB_SPIN(xb_ld(&bar[XB_XGEN(b.x)]) == gen, bar);
            __builtin_amdgcn_fence(__ATOMIC_ACQUIRE, "agent");
            asm volatile("s_waitcnt vmcnt(0)" ::: "memory");
        }
    }
    __syncthreads();
}

struct Args { const float* in[19]; float* out; unsigned char* ws; int ph_lo, ph_hi; };
enum { I_X = 0, I_META, I_RELB, I_ANORM, I_WIN, I_WOUT, I_LQ1, I_LK1, I_LQ2, I_LK2, I_SUBLN, I_FNORM, I_WR, I_BR, I_W1, I_B1, I_W2, I_B2, I_FINAL };

__device__ __forceinline__ void rms_row_to_bf16(const float* xrow, const f32x4 (&gn)[4], bf16_t* orow, int lane) {
    const f32x4* xr = (const f32x4*)xrow + lane;
    f32x4 v[4]; float s = 0.f;
#pragma unroll
    for (int j = 0; j < 4; ++j) { v[j] = xr[64 * j]; s += (v[j].x * v[j].x + v[j].y * v[j].y) + (v[j].z * v[j].z + v[j].w * v[j].w); }
    const float r = 1.0f / sqrtf(wave_sum(s) * (1.f / D) + NORM_EPS);
    unsigned long long* o8 = (unsigned long long*)orow + lane;
#pragma unroll
    for (int j = 0; j < 4; ++j) { const f32x4 y = v[j] * r * gn[j]; o8[64 * j] = (unsigned long long)pk2(y.x, y.y) | ((unsigned long long)pk2(y.z, y.w) << 32); }
}

__device__ __forceinline__ void p0_transpose_item(const float* W, int K, int N, bf16_t* WT, LAS float* scr, int item, int lane, int mode) {
    const int nblk = N / 32, kb = item / nblk, nb = item % nblk, k0 = 64 * kb, n0 = 32 * nb;
#pragma unroll 8
    for (int i = 0; i < 32; ++i) { const int kk = 2 * i + (lane >> 5); scr[kk * 33 + (lane & 31)] = W[(size_t)(k0 + kk) * N + n0 + (lane & 31)]; }
    LDS_WAIT(); asm volatile("" ::: "memory");
    int d0 = n0;
    if (mode == 1) { const int half = n0 >> 10, jj = n0 & 1023; d0 = (jj >> 7) * 256 + half * 128 + (jj & 127); }
    const int c = lane & 7;
#pragma unroll
    for (int j = 0; j < 4; ++j) { const int n = (lane >> 3) + 8 * j; const LAS float* s = scr + (8 * c) * 33 + n;
        u32x4 o; o.x = pk2(s[0 * 33], s[1 * 33]); o.y = pk2(s[2 * 33], s[3 * 33]); o.z = pk2(s[4 * 33], s[5 * 33]); o.w = pk2(s[6 * 33], s[7 * 33]);
        *(u32x4*)(WT + (size_t)(d0 + n) * K + k0 + 8 * c) = o; }
    LDS_WAIT(); asm volatile("" ::: "memory");
}

__device__ __forceinline__ void p0_transpose_item8(const float* W, int K, int N, unsigned char* WT, LAS float* scr, int item, int lane, int mode) {
    const int nblk = N / 32, kb = item / nblk, nb = item % nblk, k0 = 64 * kb, n0 = 32 * nb;
#pragma unroll 8
    for (int i = 0; i < 32; ++i) { const int kk = 2 * i + (lane >> 5); scr[kk * 33 + (lane & 31)] = W[(size_t)(k0 + kk) * N + n0 + (lane & 31)]; }
    LDS_WAIT(); asm volatile("" ::: "memory");
    int d0 = n0;
    if (mode == 1) { const int half = n0 >> 10, jj = n0 & 1023; d0 = (jj >> 7) * 256 + half * 128 + (jj & 127); }
    const int c = lane & 3;
#pragma unroll
    for (int j = 0; j < 2; ++j) { const int n = (lane >> 2) + 16 * j; const LAS float* sp = scr + (16 * c) * 33 + n;
        u32x4 o;
        o.x = pk4_fp8(sp[0 * 33] * 32.f, sp[1 * 33] * 32.f, sp[2 * 33] * 32.f, sp[3 * 33] * 32.f); o.y = pk4_fp8(sp[4 * 33] * 32.f, sp[5 * 33] * 32.f, sp[6 * 33] * 32.f, sp[7 * 33] * 32.f);
        o.z = pk4_fp8(sp[8 * 33] * 32.f, sp[9 * 33] * 32.f, sp[10 * 33] * 32.f, sp[11 * 33] * 32.f); o.w = pk4_fp8(sp[12 * 33] * 32.f, sp[13 * 33] * 32.f, sp[14 * 33] * 32.f, sp[15 * 33] * 32.f);
        *(u32x4*)(WT + (size_t)(d0 + n) * K + k0 + 16 * c) = o; }
    LDS_WAIT(); asm volatile("" ::: "memory");
}

__device__ __forceinline__ int t5_bucket(int rel) {
    const int n = rel < 0 ? -rel : rel; int b = rel > 0 ? 16 : 0;
    int large = 8 + (n >= 12) + (n >= 16) + (n >= 23) + (n >= 32) + (n >= 46) + (n >= 64) + (n >= 91);
    return b + (n < 8 ? n : large);
}

template <int CLS> __global__ void __launch_bounds__(NWAVES * 64, 2) fwd_kernel(Args args) {
    extern __shared__ __attribute__((aligned(16))) unsigned char lds_raw[];
    LAS unsigned char* lds = (LAS unsigned char*)lds_raw;
    volatile LAS unsigned* MISC = (volatile LAS unsigned*)(lds + MISC_OFF);
    const int tid = threadIdx.x, lane = tid & 63, wave = __builtin_amdgcn_readfirstlane(tid >> 6);
    const int G = gridDim.x, bx = blockIdx.x;
    const int gw = bx * NWAVES + wave, NGW = G * NWAVES;
    unsigned char* ws = args.ws;
    unsigned* ctl = (unsigned*)(ws + WS_CTL);
    const float* x = args.in[I_X];
    bf16_t* WinT = (bf16_t*)(ws + WS_WIN); bf16_t* WoutT = (bf16_t*)(ws + WS_WOUT); unsigned char* W1T = ws + WS_W1; unsigned char* W2T = ws + WS_W2; unsigned char* XN8 = ws + WS_XN8;
    bf16_t* METAKV = (bf16_t*)(ws + WS_METAKV); bf16_t* XN = (bf16_t*)(ws + WS_XN); bf16_t* PROJ = (bf16_t*)(ws + WS_PROJ); bf16_t* MIX = (bf16_t*)(ws + WS_MIX);
    float* TMP = (float*)(ws + WS_TMP); unsigned char* Y = ws + WS_Y; unsigned char* ACT = ws + WS_ACT;
    int* tok_e = (int*)(ws + WS_TOKE); float* tok_g = (float*)(ws + WS_TOKG); int* tok_lr = (int*)(ws + WS_TOKLR); int* cnt = (int*)(ws + WS_CNT);
    unsigned* rowtok = (unsigned*)(ws + WS_ROWTOK); int* rowsg = (int*)(ws + WS_ROWSG); int* tilee_hdr = (int*)(ws + WS_TILEE); unsigned char* tilee = (unsigned char*)(ws + WS_TILEE) + 64;
    bf16_t* H1 = (bf16_t*)(ws + WS_H1);

    if (tid < 32) MISC[tid] = 0u;
    __syncthreads();
#if ONE_LAUNCH
    XcdBarrier bar = xcd_barrier_post(ctl + CW_BAR, MISC + 8);
#define GRID_BAR() xcd_barrier(bar)
#else
#define GRID_BAR() do {} while (0)
#endif
    const int lo = args.ph_lo, hi = args.ph_hi;
#define INC(k, cls) ((CLS == -1 || CLS == (cls)) && lo <= (k) && (k) < hi)
#define IN(k) INC(k, k)
#define BOTH(k) (CLS == -1 && lo <= (k) && (k) + 1 < hi)

    if (IN(0)) {
        REP_BEGIN(0)
        int tid = threadIdx.x; asm volatile("" : "+v"(tid)); const int lane = tid & 63;
        LAS float* scr = (LAS float*)(lds + wave * 16384);
        constexpr int I_IN = 16 * 96, I_OUT = 16 * 32, I_1 = 16 * 64, I_2 = 16 * 32;
        constexpr int NITEMS = I_IN + I_OUT + NEXP * (I_1 + I_2);
        for (int it = gw; it < NITEMS; it += NGW) {
            int r = it;
            if (r < I_IN) { p0_transpose_item(args.in[I_WIN], D, DIN, WinT, scr, r, lane, 0); continue; } r -= I_IN;
            if (r < I_OUT) { p0_transpose_item(args.in[I_WOUT], D, D, WoutT, scr, r, lane, 0); continue; } r -= I_OUT;
            if (r < NEXP * I_1) { const int e = r / I_1; p0_transpose_item8(args.in[I_W1] + (size_t)e * D * 2048, D, 2048, W1T + (size_t)e * 2048 * D, scr, r % I_1, lane, 1); continue; } r -= NEXP * I_1;
            { const int e = r / I_2; p0_transpose_item8(args.in[I_W2] + (size_t)e * D * D, D, D, W2T + (size_t)e * D * D, scr, r % I_2, lane, 0); }
        }
        f32x4 gn[4];
#pragma unroll
        for (int j = 0; j < 4; ++j) gn[j] = ((const f32x4*)args.in[I_ANORM])[lane + 64 * j];
        for (int m = gw; m < T; m += NGW) rms_row_to_bf16(x + (size_t)m * D, gn, XN + (size_t)m * D, lane);
        __syncthreads();
        LAS float* xm = (LAS float*)lds;
        for (int rr = 0; rr < 2; ++rr) { const int m = wave * 2 + rr; const f32x4* xr = (const f32x4*)(args.in[I_META] + (size_t)m * D) + lane;
            f32x4 v[4]; float s = 0.f;
#pragma unroll
            for (int j = 0; j < 4; ++j) { v[j] = xr[64 * j]; s += (v[j].x * v[j].x + v[j].y * v[j].y) + (v[j].z * v[j].z + v[j].w * v[j].w); }
            const float r = 1.0f / sqrtf(wave_sum(s) * (1.f / D) + NORM_EPS);
#pragma unroll
            for (int j = 0; j < 4; ++j) { const f32x4 y = v[j] * r * gn[j]; *(LAS f32x4*)(xm + m * D + 4 * lane + 256 * j) = y; } }
        __syncthreads();
        for (int cb = bx; cb < 256; cb += G) {
            const int q0 = cb * 8; const int n0 = q0 < 1024 ? q0 + 512 : q0 + 1024;
            const int m = tid >> 5, kp = tid & 31; float a8[8];
#pragma unroll
            for (int c = 0; c < 8; ++c) a8[c] = 0.f;
            const float* win = args.in[I_WIN];
            for (int kk = 0; kk < 32; ++kk) { const int k = kk * 32 + kp; const float xv = xm[m * D + k];
                const f32x4 w0 = *(const f32x4*)(win + (size_t)k * DIN + n0), w1 = *(const f32x4*)(win + (size_t)k * DIN + n0 + 4);
                a8[0] += xv * w0.x; a8[1] += xv * w0.y; a8[2] += xv * w0.z; a8[3] += xv * w0.w; a8[4] += xv * w1.x; a8[5] += xv * w1.y; a8[6] += xv * w1.z; a8[7] += xv * w1.w; }
#pragma unroll
            for (int c = 0; c < 8; ++c) {
#pragma unroll
                for (int o = 1; o < 32; o <<= 1) a8[c] += __shfl_xor(a8[c], o); }
            if (kp == 0) { u32x4 w; w.x = pk2(a8[0], a8[1]); w.y = pk2(a8[2], a8[3]); w.z = pk2(a8[4], a8[5]); w.w = pk2(a8[6], a8[7]); *(u32x4*)(METAKV + (size_t)m * DIN + n0) = w; }
        }
        __syncthreads();
        REP_END(0)
        if (BOTH(0)) GRID_BAR();
    }

    if (IN(1)) {
        REP_BEGIN(1)
        pg8::Gemm g{XN, WinT, 0, nullptr}; pg8::StaticOrder S; S.init(T, DIN, G, bx);
        pg8::EpiProj E{PROJ};
        pg8::gemm_phase<pg8::EpiProj, pg8::StaticOrder, false, false>(lds, g, S, E, 0);
        REP_END(1)
        if (BOTH(1)) GRID_BAR();
    }

    if (IN(2)) {
        int tid = threadIdx.x; asm volatile("" : "+v"(tid)); const int lane = tid & 63;
        LAS float* btab = (LAS float*)(lds + GIDX_OFF + 2048);
        LAS float* lamp = (LAS float*)(lds + EXTRA_OFF);
        for (int i = tid; i < 1152; i += NWAVES * 64) { const int h = i / 288, idx = i % 288 - 96; const int rel = idx < 0 ? -128 : idx - 128; btab[i] = args.in[I_RELB][t5_bucket(rel) * 4 + h] * LOG2E; }
        if (wave == 0) { const float a = wave_sum(args.in[I_LQ1][lane] * args.in[I_LK1][lane]), b = wave_sum(args.in[I_LQ2][lane] * args.in[I_LK2][lane]); if (lane == 0) lamp[0] = expf(a) - expf(b) + LAMBDA_INIT; }
        __syncthreads();
        const float lam = lamp[0];
#if !NAIVE_SB
        REP_BEGIN(20)
        for (int vb = bx; vb < 256; vb += G) att::sb_head(lds, PROJ, METAKV, MIX, vb >> 3, vb & 7);
        REP_END(20)
#else
        for (int it = gw; it < BATCH * 8 * 32; it += NGW) {
            const int qb = it & 31, h = (it >> 5) & 7, b = it >> 8; const int r = qb * 64 + lane;
            const size_t rowq = (size_t)b * SEQ + r;
            unsigned q[32];
            { const u32x4* qp = (const u32x4*)(PROJ + rowq * DIN + COL_SBQ + h * 64);
#pragma unroll
              for (int i = 0; i < 8; ++i) { const u32x4 t4 = qp[i]; q[4 * i] = t4.x; q[4 * i + 1] = t4.y; q[4 * i + 2] = t4.z; q[4 * i + 3] = t4.w; } }
            float o[64];
#pragma unroll
            for (int d = 0; d < 64; ++d) o[d] = 0.f;
            float carry = 1.0f;
            const int jmax = qb * 64 + 62;
            for (int jj = jmax + 16; jj >= 0; --jj) {
                const bool meta = jj < 16; const int j = jj - 16;
                const bf16_t* krow = meta ? METAKV + (size_t)jj * DIN : PROJ + ((size_t)b * SEQ + j) * DIN;
                const u32x4* kp = (const u32x4*)(krow + COL_SBK + h * 64); const u32x4* vp = (const u32x4*)(krow + COL_SBV + h * 64);
                float z = 0.f;
#pragma unroll
                for (int i = 0; i < 8; ++i) { const u32x4 k4 = kp[i];
                    z += bf_lo(q[4 * i]) * bf_lo(k4.x) + bf_hi(q[4 * i]) * bf_hi(k4.x); z += bf_lo(q[4 * i + 1]) * bf_lo(k4.y) + bf_hi(q[4 * i + 1]) * bf_hi(k4.y);
                    z += bf_lo(q[4 * i + 2]) * bf_lo(k4.z) + bf_hi(q[4 * i + 2]) * bf_hi(k4.z); z += bf_lo(q[4 * i + 3]) * bf_lo(k4.w) + bf_hi(q[4 * i + 3]) * bf_hi(k4.w); }
                const float e = __builtin_amdgcn_exp2f(fminf(z, 100.f)); const float p = 1.0f / (1.0f + e);
                const bool vis = meta || (j < r);
                const float w = vis ? (1.0f - p) * carry : 0.f; carry = vis ? carry * p : carry;
#pragma unroll
                for (int i = 0; i < 8; ++i) { const u32x4 v4 = vp[i];
                    o[8 * i] += w * bf_lo(v4.x); o[8 * i + 1] += w * bf_hi(v4.x); o[8 * i + 2] += w * bf_lo(v4.y); o[8 * i + 3] += w * bf_hi(v4.y);
                    o[8 * i + 4] += w * bf_lo(v4.z); o[8 * i + 5] += w * bf_hi(v4.z); o[8 * i + 6] += w * bf_lo(v4.w); o[8 * i + 7] += w * bf_hi(v4.w); }
            }
            u32x4* op = (u32x4*)(MIX + rowq * D + h * 64);
#pragma unroll
            for (int i = 0; i < 8; ++i) { u32x4 w; w.x = pk2(o[8 * i], o[8 * i + 1]); w.y = pk2(o[8 * i + 2], o[8 * i + 3]); w.z = pk2(o[8 * i + 4], o[8 * i + 5]); w.w = pk2(o[8 * i + 6], o[8 * i + 7]); op[i] = w; }
        }
#endif
#if !NAIVE_DF
        __syncthreads();
        REP_BEGIN(21)
        for (int vb = bx; vb < 256; vb += G) { const int pairi = (vb >> 4) * 8 + (vb & 7), which = (vb >> 3) & 1;
            att::df_head(lds, (LAS float*)(lds + GIDX_OFF), btab, lam, args.in[I_SUBLN], PROJ, METAKV, MIX, pairi >> 2, pairi & 3, which); }
        REP_END(21)
#else
        for (int it = gw; it < BATCH * 4 * 32; it += NGW) {
            const int c = it & 31, hd = (it >> 5) & 3, b = it >> 7; const int r = c * 64 + lane;
            const size_t rowq = (size_t)b * SEQ + r;
            float* tmp = TMP + (rowq * 4 + hd) * 128;
            const int nreal = c * 64 + 64;
            for (int s = 0; s < 2; ++s) {
                const int gh = 2 * hd + s;
                unsigned q[32];
                { const u32x4* qp = (const u32x4*)(PROJ + rowq * DIN + COL_DFQ + gh * 64);
#pragma unroll
                  for (int i = 0; i < 8; ++i) { const u32x4 t4 = qp[i]; q[4 * i] = t4.x; q[4 * i + 1] = t4.y; q[4 * i + 2] = t4.z; q[4 * i + 3] = t4.w; } }
                float mx = -1e30f, l = 0.f, ss = 0.f;
                for (int pass = 0; pass < 3; ++pass) {
                    float o[64];
#pragma unroll
                    for (int d = 0; d < 64; ++d) o[d] = 0.f;
                    const float il = pass >= 1 ? 1.0f / l : 0.f; const int dh = pass == 2 ? 64 : 0;
                    for (int jj = 0; jj < nreal + 16; ++jj) {
                        const bool meta = jj < 16; const int j = jj - 16;
                        const bf16_t* krow = meta ? METAKV + (size_t)jj * DIN : PROJ + ((size_t)b * SEQ + j) * DIN;
                        const u32x4* kp = (const u32x4*)(krow + COL_DFK + gh * 64);
                        float z = 0.f;
#pragma unroll
                        for (int i = 0; i < 8; ++i) { const u32x4 k4 = kp[i];
                            z += bf_lo(q[4 * i]) * bf_lo(k4.x) + bf_hi(q[4 * i]) * bf_hi(k4.x); z += bf_lo(q[4 * i + 1]) * bf_lo(k4.y) + bf_hi(q[4 * i + 1]) * bf_hi(k4.y);
                            z += bf_lo(q[4 * i + 2]) * bf_lo(k4.z) + bf_hi(q[4 * i + 2]) * bf_hi(k4.z); z += bf_lo(q[4 * i + 3]) * bf_lo(k4.w) + bf_hi(q[4 * i + 3]) * bf_hi(k4.w); }
                        int rel = meta ? (jj - 16 - r) : (j - r); rel = rel < -128 ? -128 : rel;
                        z += btab[hd * 192 + rel + 128];
                        if (pass == 0) { const float mn = fmaxf(mx, z); l = l * __builtin_amdgcn_exp2f(mx - mn) + __builtin_amdgcn_exp2f(z - mn); mx = mn; }
                        else { const float w = __builtin_amdgcn_exp2f(z - mx) * il; const u32x4* vp = (const u32x4*)(krow + COL_DFV + hd * 128 + dh);
#pragma unroll
                            for (int i = 0; i < 8; ++i) { const u32x4 v4 = vp[i];
                                o[8 * i] += w * bf_lo(v4.x); o[8 * i + 1] += w * bf_hi(v4.x); o[8 * i + 2] += w * bf_lo(v4.y); o[8 * i + 3] += w * bf_hi(v4.y);
                                o[8 * i + 4] += w * bf_lo(v4.z); o[8 * i + 5] += w * bf_hi(v4.z); o[8 * i + 6] += w * bf_lo(v4.w); o[8 * i + 7] += w * bf_hi(v4.w); } }
                    }
                    if (pass >= 1) {
                        if (s == 0) {
#pragma unroll
                            for (int d = 0; d < 64; d += 4) *(f32x4*)(tmp + dh + d) = (f32x4){o[d], o[d + 1], o[d + 2], o[d + 3]};
                        } else {
#pragma unroll
                            for (int d = 0; d < 64; d += 4) { const f32x4 o0 = *(const f32x4*)(tmp + dh + d); f32x4 a; a.x = o0.x - lam * o[d]; a.y = o0.y - lam * o[d + 1]; a.z = o0.z - lam * o[d + 2]; a.w = o0.w - lam * o[d + 3];
                                ss += (a.x * a.x + a.y * a.y) + (a.z * a.z + a.w * a.w); *(f32x4*)(tmp + dh + d) = a; }
                        }
                    }
                }
                if (s == 1) {
                    const float rr = (1.0f - LAMBDA_INIT) / sqrtf(ss * (1.0f / 128.0f) + SUBLN_EPS);
                    const float* sg = args.in[I_SUBLN];
                    u32x4* op = (u32x4*)(MIX + rowq * D + 512 + hd * 128);
#pragma unroll 4
                    for (int i = 0; i < 16; ++i) { const f32x4 a0 = *(const f32x4*)(tmp + 8 * i), a1 = *(const f32x4*)(tmp + 8 * i + 4); const f32x4 g0 = *(const f32x4*)(sg + 8 * i), g1 = *(const f32x4*)(sg + 8 * i + 4);
                        u32x4 w; w.x = pk2(a0.x * rr * g0.x, a0.y * rr * g0.y); w.y = pk2(a0.z * rr * g0.z, a0.w * rr * g0.w); w.z = pk2(a1.x * rr * g1.x, a1.y * rr * g1.y); w.w = pk2(a1.z * rr * g1.z, a1.w * rr * g1.w); op[i] = w; }
                }
            }
        }
#endif
        if (BOTH(2)) GRID_BAR();
    }

    if (IN(3)) {
        REP_BEGIN(3)
        pg8::Gemm g{MIX, WoutT, 0, nullptr}; pg8::StaticOrder S; S.init(T, D, G, bx);
        pg8::EpiRes E{x, H1, (float*)(ws + WS_ROWSS)};
        pg8::gemm_phase<pg8::EpiRes, pg8::StaticOrder, false, false>(lds, g, S, E, 0);
        REP_END(3)
        if (BOTH(3)) GRID_BAR();
    }

    if (IN(4)) {
        REP_BEGIN(4)
        int tid = threadIdx.x; asm volatile("" : "+v"(tid)); const int lane = tid & 63, r32 = lane & 31, hi = lane >> 5; const bool hib = hi != 0;
        LAS bf16_t* wt = (LAS bf16_t*)lds;
        LAS float* gl = (LAS float*)(lds + 66048);
        LAS int* hist = (LAS int*)(lds + EXTRA_OFF);
        const float* wr_g = args.in[I_WR];
        for (int idx = tid; idx < 32 * 1024; idx += NWAVES * 64) wt[(idx & 31) * 1032 + (idx >> 5)] = (bf16_t)f2bf(wr_g[idx]);
        for (int idx = tid; idx < 1024; idx += NWAVES * 64) gl[idx] = args.in[I_FNORM][idx];
        const float* rowss = (const float*)(ws + WS_ROWSS);
        float bias[16];
#pragma unroll
        for (int r = 0; r < 16; ++r) bias[r] = args.in[I_BR][att::crow(r, hi)];
        for (int blk = bx; blk < 256; blk += G) {
            __syncthreads();
            if (tid < 32) hist[tid] = 0;
            __syncthreads();
            const int tok = blk * 256 + wave * 32 + r32;
            float rs;
            { const f32x4* sp = (const f32x4*)(rowss + (size_t)tok * 16); const f32x4 s0 = sp[0], s1 = sp[1], s2 = sp[2], s3 = sp[3];
              const float ssum = (((s0[0] + s0[1]) + (s0[2] + s0[3])) + ((s1[0] + s1[1]) + (s1[2] + s1[3]))) + (((s2[0] + s2[1]) + (s2[2] + s2[3])) + ((s3[0] + s3[1]) + (s3[2] + s3[3])));
              rs = 1.0f / sqrtf(ssum * (1.f / D) + NORM_EPS); }
            const bf16_t* xrow = H1 + (size_t)tok * D + 8 * hi;
            unsigned char* orow = XN8 + (size_t)tok * D + 8 * hi;
            const LAS bf16_t* wrow = wt + r32 * 1032 + 8 * hi;
            att::f32x16 acc = {};
#pragma unroll 1
            for (int sc = 0; sc < 8; ++sc) {
                f32x4 xv[16];
#pragma unroll
                for (int s8 = 0; s8 < 8; ++s8) { const u32x4 hb = *(const u32x4*)(xrow + (sc * 8 + s8) * 16);
                    xv[2 * s8] = (f32x4){bf_lo(hb.x), bf_hi(hb.x), bf_lo(hb.y), bf_hi(hb.y)}; xv[2 * s8 + 1] = (f32x4){bf_lo(hb.z), bf_hi(hb.z), bf_lo(hb.w), bf_hi(hb.w)}; }
#pragma unroll
                for (int s8 = 0; s8 < 8; ++s8) { const int sk = (sc * 8 + s8) * 16;
                    const f32x4 g0 = *(const LAS f32x4*)(gl + sk + 8 * hi), g1 = *(const LAS f32x4*)(gl + sk + 8 * hi + 4);
                    const f32x4 y0 = xv[2 * s8] * g0 * rs, y1 = xv[2 * s8 + 1] * g1 * rs;
                    u32x4 bw; bw.x = cvt_pk_bf16(y0[0], y0[1]); bw.y = cvt_pk_bf16(y0[2], y0[3]); bw.z = cvt_pk_bf16(y1[0], y1[1]); bw.w = cvt_pk_bf16(y1[2], y1[3]);
                    u32x2 o8; o8.x = pk4_fp8(y0[0], y0[1], y0[2], y0[3]); o8.y = pk4_fp8(y1[0], y1[1], y1[2], y1[3]);
                    *(u32x2*)(orow + sk) = o8;
                    const bf16x8 af = *(const LAS bf16x8*)(wrow + sk);
                    acc = __builtin_amdgcn_mfma_f32_32x32x16_bf16(af, __builtin_bit_cast(bf16x8, bw), acc, 0, 0, 0); }
            }
            float v[16];
#pragma unroll
            for (int r = 0; r < 16; ++r) v[r] = acc[r] + bias[r];
            float cv[8]; int ce[8];
#pragma unroll
            for (int k = 0; k < 4; ++k) { float m = v[0]; int mi = 0;
#pragma unroll
                for (int r = 1; r < 16; ++r) { const bool c = v[r] > m; m = c ? v[r] : m; mi = c ? r : mi; }
#pragma unroll
                for (int r = 0; r < 16; ++r) v[r] = (r == mi) ? -3.0e38f : v[r];
                cv[k] = m; ce[k] = (mi & 3) + 8 * (mi >> 2) + 4 * hi; }
#pragma unroll
            for (int k = 0; k < 4; ++k) { cv[4 + k] = att::partner32(cv[k], hib); ce[4 + k] = __builtin_bit_cast(int, att::partner32(__builtin_bit_cast(float, ce[k]), hib)); }
            float tv[4]; int te4[4];
#pragma unroll
            for (int k = 0; k < 4; ++k) { float m = cv[0]; int mi = 0, me = ce[0];
#pragma unroll
                for (int c8 = 1; c8 < 8; ++c8) { const bool c = cv[c8] > m || (cv[c8] == m && ce[c8] < me); m = c ? cv[c8] : m; mi = c ? c8 : mi; me = c ? ce[c8] : me; }
                tv[k] = m; te4[k] = me;
#pragma unroll
                for (int c8 = 0; c8 < 8; ++c8) cv[c8] = (c8 == mi) ? -3.0e38f : cv[c8]; }
            const float e1 = __expf(tv[1] - tv[0]), e2 = __expf(tv[2] - tv[0]), e3 = __expf(tv[3] - tv[0]); const float inv = 1.0f / (((1.0f + e1) + e2) + e3);
            if (!hib) {
                { const int lr = atomicAdd((int*)(hist + te4[0]), 1); tok_e[tok * 4 + 0] = te4[0]; tok_g[tok * 4 + 0] = inv; tok_lr[tok * 4 + 0] = lr; }
                { const int lr = atomicAdd((int*)(hist + te4[1]), 1); tok_e[tok * 4 + 1] = te4[1]; tok_g[tok * 4 + 1] = e1 * inv; tok_lr[tok * 4 + 1] = lr; }
                { const int lr = atomicAdd((int*)(hist + te4[2]), 1); tok_e[tok * 4 + 2] = te4[2]; tok_g[tok * 4 + 2] = e2 * inv; tok_lr[tok * 4 + 2] = lr; }
                { const int lr = atomicAdd((int*)(hist + te4[3]), 1); tok_e[tok * 4 + 3] = te4[3]; tok_g[tok * 4 + 3] = e3 * inv; tok_lr[tok * 4 + 3] = lr; } }
            __syncthreads();
            if (tid < 32) cnt[blk * 32 + tid] = hist[tid];
        }
        __syncthreads();
        REP_END(4)
        if (BOTH(4)) GRID_BAR();
    }

    if (IN(5)) {
        int tid = threadIdx.x; asm volatile("" : "+v"(tid)); const int lane = tid & 63;
        LAS int* tot = (LAS int*)(lds + EXTRA_OFF); LAS int* tstart = tot + 32; LAS int* pref = tstart + 40;
        if (tid < 32) { int s = 0; for (int w = 0; w < 256; ++w) s += cnt[w * 32 + tid]; tot[tid] = s; }
        __syncthreads();
        if (tid == 0) { int a = 0; for (int e = 0; e < 32; ++e) { tstart[e] = a; a += (tot[e] + 255) >> 8; } tstart[32] = a; }
        __syncthreads();
        for (int blk = bx; blk < 256; blk += G) {
            if (tid < 32) { int s = 0; for (int w = 0; w < blk; ++w) s += cnt[w * 32 + tid]; pref[tid] = s; }
            __syncthreads();
            for (int a = tid; a < 1024; a += NWAVES * 64) { const int idx = blk * 1024 + a; const int e = tok_e[idx]; const int pos = tstart[e] * 256 + pref[e] + tok_lr[idx];
                rowtok[pos] = (unsigned)(idx >> 2); rowsg[2 * pos] = idx; rowsg[2 * pos + 1] = __builtin_bit_cast(int, tok_g[idx]); }
            __syncthreads();
        }
        for (int e = bx; e < 32; e += G)
            for (int p = tstart[e] * 256 + tot[e] + tid; p < tstart[e + 1] * 256; p += NWAVES * 64) { rowtok[p] = 0u; rowsg[2 * p] = -1; rowsg[2 * p + 1] = 0; }
        if (bx == 0) { if (tid < 32) for (int tl = tstart[tid]; tl < tstart[tid + 1]; ++tl) tilee[tl] = (unsigned char)tid; if (tid == 0) tilee_hdr[0] = tstart[32]; }
        __syncthreads();
        if (BOTH(5)) GRID_BAR();
    }

    if (IN(6)) {
        REP_BEGIN(6)
        int tid = threadIdx.x; asm volatile("" : "+v"(tid)); const int lane = tid & 63;
        const int NTl = tilee_hdr[0];
        LAS unsigned char* te = lds + TE_OFF; LAS unsigned short* gidx = (LAS unsigned short*)(lds + GIDX_OFF);
        for (int i = tid; i < MAXTILES; i += NWAVES * 64) te[i] = i < NTl ? tilee[i] : (unsigned char)0;
        __syncthreads();
        pg8::GroupedOrder S; S.init(NTl, 8, G, bx, 0, te);
        for (int i = 0; i < MAXSLOTS; ++i) { pg8::Unit u; if (S.next(i, u)) { if (tid < 256) gidx[i * 256 + tid] = (unsigned short)rowtok[u.pm * 256 + tid]; } }
        __syncthreads();
        pg8::Gemm g{XN8, W1T, (size_t)2048 * D, gidx};
        pg8::EpiSwiglu E{ACT, args.in[I_B1]};
        pg8::gemm_phase<pg8::EpiSwiglu, pg8::GroupedOrder, true, true>(lds, g, S, E, 0);
        REP_END(6)
        if (BOTH(6)) GRID_BAR();
    }
    if (IN(7)) {
        REP_BEGIN(7)
        int tid = threadIdx.x; asm volatile("" : "+v"(tid)); const int lane = tid & 63;
        const int NTl = tilee_hdr[0];
        LAS unsigned char* te = lds + TE_OFF;
        __syncthreads();
        for (int i = tid; i < MAXTILES; i += NWAVES * 64) te[i] = i < NTl ? tilee[i] : (unsigned char)0;
        __syncthreads();
        pg8::GroupedOrder S; S.init(NTl, 4, G, bx, 0, te);
        pg8::Gemm g{ACT, W2T, (size_t)D * D, nullptr};
        pg8::EpiDown E{Y, args.in[I_B2], rowsg, ws + WS_DUMP};
        pg8::gemm_phase<pg8::EpiDown, pg8::GroupedOrder, false, true>(lds, g, S, E, 0);
        REP_END(7)
        if (BOTH(7)) GRID_BAR();
    }

    if (IN(8)) {
        int tid = threadIdx.x; asm volatile("" : "+v"(tid)); const int lane = tid & 63;
        f32x4 gn[4];
#pragma unroll
        for (int j = 0; j < 4; ++j) gn[j] = ((const f32x4*)args.in[I_FINAL])[lane + 64 * j];
        for (int tok = gw; tok < T; tok += NGW) {
            f32x4* hp = (f32x4*)(args.out + (size_t)tok * D) + lane; const u32x2* hb = (const u32x2*)(H1 + (size_t)tok * D) + lane; f32x4 v[4]; float s = 0.f;
#pragma unroll
            for (int j = 0; j < 4; ++j) { const u32x2 h2 = hb[64 * j]; v[j] = (f32x4){bf_lo(h2.x), bf_hi(h2.x), bf_lo(h2.y), bf_hi(h2.y)}; }
#pragma unroll
            for (int k = 0; k < 4; ++k) { const unsigned* yp = (const unsigned*)(Y + ((size_t)tok * 4 + k) * D) + lane;
#pragma unroll
                for (int j = 0; j < 4; ++j) { const int y4 = (int)yp[64 * j]; v[j].x += __builtin_amdgcn_cvt_f32_fp8(y4, 0); v[j].y += __builtin_amdgcn_cvt_f32_fp8(y4, 1); v[j].z += __builtin_amdgcn_cvt_f32_fp8(y4, 2); v[j].w += __builtin_amdgcn_cvt_f32_fp8(y4, 3); } }
#pragma unroll
            for (int j = 0; j < 4; ++j) s += (v[j].x * v[j].x + v[j].y * v[j].y) + (v[j].z * v[j].z + v[j].w * v[j].w);
            const float r = 1.0f / sqrtf(wave_sum(s) * (1.f / D) + NORM_EPS);
#pragma unroll
            for (int j = 0; j < 4; ++j) hp[64 * j] = v[j] * r * gn[j];
        }
    }
#undef IN
#undef INC
#undef BOTH
}

#if ONE_LAUNCH
constexpr int NKERN = 1;
static const void* kern_of(int) { return (const void*)fwd_kernel<-1>; }
#else
constexpr int NKERN = 9;
static const void* kern_of(int c) {
    switch (c) { case 0: return (const void*)fwd_kernel<0>; case 1: return (const void*)fwd_kernel<1>; case 2: return (const void*)fwd_kernel<2>; case 3: return (const void*)fwd_kernel<3>; case 4: return (const void*)fwd_kernel<4>;
        case 5: return (const void*)fwd_kernel<5>; case 6: return (const void*)fwd_kernel<6>; case 7: return (const void*)fwd_kernel<7>; default: return (const void*)fwd_kernel<8>; }
}
#endif
extern "C" void kernel_launch(void* const* d_in, const int* in_sizes, int n_in, void* d_out, int out_size, void* d_ws, size_t ws_size, hipStream_t stream) {
    static int grid = 0;
    if (grid == 0) {
        if (n_in != 19 || out_size != T * D || ws_size < WS_END) { fprintf(stderr, "kernel_launch: unexpected shapes (n_in %d, out %d, ws %zu)\n", n_in, out_size, ws_size); grid = -1; return; }
        for (int c = 0; c < NKERN; ++c) if (hipFuncSetAttribute(kern_of(c), hipFuncAttributeMaxDynamicSharedMemorySize, LDS_BYTES) != hipSuccess) { fprintf(stderr, "kernel_launch: hipFuncSetAttribute failed\n"); grid = -1; return; }
        int dev = 0, cus = 0, per_cu = 0;
        (void)hipGetDevice(&dev); (void)hipDeviceGetAttribute(&cus, hipDeviceAttributeMultiprocessorCount, dev);
        (void)hipOccupancyMaxActiveBlocksPerMultiprocessor(&per_cu, kern_of(0), NWAVES * 64, LDS_BYTES);
        (void)hipGetLastError();
        grid = cus > 0 ? cus : 256;
        if (grid > 256) grid = 256;
    }
    if (grid < 0) return;
    (void)hipMemsetAsync((char*)d_ws + WS_CTL, 0, CTL_ZERO_BYTES, stream);
    Args a{};
    for (int i = 0; i < 19; ++i) a.in[i] = (const float*)d_in[i];
    a.out = (float*)d_out; a.ws = (unsigned char*)d_ws;
    constexpr int NPH = 9;
#if ONE_LAUNCH
    a.ph_lo = 0; a.ph_hi = NPH;
    hipLaunchKernelGGL(fwd_kernel<-1>, dim3(grid), dim3(NWAVES * 64), LDS_BYTES, stream, a);
#else
    for (int p = 0; p < NPH; ++p) { a.ph_lo = p; a.ph_hi = p + 1; const int cls = p; void* kargs[] = {&a};
        (void)hipLaunchKernel(kern_of(cls), dim3(grid), dim3(NWAVES * 64), kargs, LDS_BYTES, stream); }
#endif
}
```

```cpp
#include <hip/hip_runtime.h>
#include <cstdio>
#include <cstdint>

#ifndef ONE_LAUNCH
#define ONE_LAUNCH 1
#endif
#ifndef REP_PHASE
#define REP_PHASE -1
#endif
#define REP_COUNT 3
#define NREP(k) ((REP_PHASE == (k)) ? REP_COUNT : 1)
#define REP_BEGIN(k) for (int rep_ = 0; rep_ < NREP(k); ++rep_) {
#define REP_END(k) if (rep_ + 1 < NREP(k)) GRID_BAR(); }
#ifndef NAIVE_SB
#define NAIVE_SB 0
#endif
#ifndef NAIVE_DF
#define NAIVE_DF 0
#endif

#define LAS __attribute__((address_space(3)))
#define GAS __attribute__((address_space(1)))
typedef unsigned short bf16_t;
typedef short bf16x8 __attribute__((ext_vector_type(8)));
typedef float f32x4 __attribute__((ext_vector_type(4)));
typedef float f32x2 __attribute__((ext_vector_type(2)));
typedef unsigned u32x4 __attribute__((ext_vector_type(4)));
typedef unsigned u32x2 __attribute__((ext_vector_type(2)));

constexpr int D = 1024, BATCH = 32, SEQ = 2048, T = BATCH * SEQ, NMETA = 16, DIN = 3072, NEXP = 32, TOPK = 4;
constexpr int COL_SBQ = 0, COL_SBK = 512, COL_SBV = 1024, COL_DFQ = 1536, COL_DFK = 2048, COL_DFV = 2560;
constexpr int MAXTILES = 1024 + 32, MAXSLOTS = 33;
constexpr float LOG2E = 1.4426950408889634f;
constexpr float C2 = 0.125f * LOG2E;
constexpr float NORM_EPS = 1e-6f, SUBLN_EPS = 1e-5f, LAMBDA_INIT = 0.2f;
constexpr int NWAVES = 8;

constexpr size_t MiB = 1u << 20;
constexpr size_t WS_CTL = 0, CTL_ZERO_BYTES = 32768;
constexpr size_t WS_WIN = 2 * MiB;
constexpr size_t WS_WOUT = 8 * MiB;
constexpr size_t WS_W1 = 10 * MiB;
constexpr size_t WS_W2 = 74 * MiB;
constexpr size_t WS_SMALL = 106 * MiB;
constexpr size_t WS_METAKV = WS_SMALL;
constexpr size_t WS_TOKE = WS_SMALL + 1 * MiB;
constexpr size_t WS_TOKG = WS_SMALL + 2 * MiB;
constexpr size_t WS_TOKLR = WS_SMALL + 3 * MiB;
constexpr size_t WS_CNT = WS_SMALL + 4 * MiB;
constexpr size_t WS_ROWTOK = WS_SMALL + 5 * MiB;
constexpr size_t WS_ROWSG = WS_SMALL + 7 * MiB;
constexpr size_t WS_TILEE = WS_SMALL + 10 * MiB;
constexpr size_t WS_DUMP = WS_SMALL + 11 * MiB;
constexpr size_t WS_ROWSS = WS_SMALL + 12 * MiB;
constexpr size_t WS_XN8 = 122 * MiB;
constexpr size_t WS_Y = 186 * MiB;
constexpr size_t WS_PROJ = WS_Y;
constexpr size_t WS_MIX = WS_Y + 384 * MiB;
constexpr size_t WS_H1 = 442 * MiB;
constexpr size_t WS_ACT = 698 * MiB;
constexpr size_t WS_XN = WS_ACT;
constexpr size_t WS_TMP = WS_ACT + 128 * MiB;
constexpr size_t WS_END = 962 * MiB;
constexpr int CW_BAR = 4096;

constexpr int RING_BYTES = 131072;
constexpr int GIDX_OFF = RING_BYTES;
constexpr int TE_OFF = GIDX_OFF + 16896;
constexpr int EXTRA_OFF = TE_OFF + 1088;
constexpr int MISC_OFF = EXTRA_OFF + 4096;
constexpr int LDS_BYTES = 155648;
static_assert(MISC_OFF + 128 <= LDS_BYTES, "LDS map");

#define LDS_WAIT() asm volatile("s_waitcnt lgkmcnt(0)" ::: "memory")
#define VM_WAIT() asm volatile("s_waitcnt vmcnt(0)" ::: "memory")
__device__ __forceinline__ unsigned f2bf(float f) { unsigned u = __builtin_bit_cast(unsigned, f); return (u + 0x7fffu + ((u >> 16) & 1u)) >> 16; }
__device__ __forceinline__ unsigned pk2(float lo, float hi) { return f2bf(lo) | (f2bf(hi) << 16); }
__device__ __forceinline__ float bf_lo(unsigned u) { return __builtin_bit_cast(float, u << 16); }
__device__ __forceinline__ float bf_hi(unsigned u) { return __builtin_bit_cast(float, u & 0xffff0000u); }
__device__ __forceinline__ unsigned cvt_pk_bf16(float lo, float hi) { unsigned r; asm volatile("v_cvt_pk_bf16_f32 %0, %1, %2" : "=v"(r) : "v"(lo), "v"(hi)); return r; }
__device__ __forceinline__ unsigned pk4_fp8(float a, float b, float c, float d) { int w = __builtin_amdgcn_cvt_pk_fp8_f32(a, b, 0, false); w = __builtin_amdgcn_cvt_pk_fp8_f32(c, d, w, true); return (unsigned)w; }
__device__ __forceinline__ void swap16(unsigned& a, unsigned& b) { auto rr = __builtin_amdgcn_permlane16_swap(a, b, false, false); a = rr[0]; b = rr[1]; }
__device__ __forceinline__ float wave_sum(float v) {
#pragma unroll
    for (int o = 1; o < 64; o <<= 1) v += __shfl_xor(v, o);
    return v;
}

namespace pg8 {
constexpr int BM = 256, BK = 64, HALF = 128, HTB = HALF * BK * 2, STAGE_BYTES = 8 * HTB, NXCD = 8, WGM = 8, K = 1024, NT_K = K / BK;
__host__ __device__ __forceinline__ int lds_byte(int r, int c, int SH = 5) { const int st = (r >> 4) * 2 + (c >> 5), rr = r & 15, cc = c & 31, ob = rr * 64 + cc * 2; return st * 1024 + (ob ^ (((ob >> 9) & 1) << SH)); }
__host__ __device__ __forceinline__ void stage_rc(int b, int& R, int& C, int SH = 5) { const int st = b / 1024, sb = b % 1024, swz = sb ^ (((sb >> 9) & 1) << SH); R = (st >> 1) * 16 + swz / 64; C = (st & 1) * 32 + (swz % 64) / 2; }
__host__ __device__ __forceinline__ int perm32(int rho) { const int n = rho >> 4, i = rho & 15; return 8 * (i >> 2) + 4 * n + (i & 3); }

struct Unit { int pm, pn, e; };
struct Gemm { const void* A; const void* Bt; size_t estride; const LAS unsigned short* gidx; };

struct StaticOrder {
    int nM, nN, nwg, G, c;
    __device__ void init(int M, int N, int G_, int c_) { nM = M / BM; nN = N / BM; nwg = nM * nN; G = G_; c = c_; }
    __device__ bool next(int i, Unit& u) const {
        const long L = (long)i * G + c; if (L >= nwg) return false;
        int wgid = (int)L; { const int q = nwg / NXCD, r = nwg % NXCD, xcd = wgid % NXCD, off = wgid / NXCD; wgid = (xcd < r ? xcd * (q + 1) : r * (q + 1) + (xcd - r) * q) + off; }
        const int nig = WGM * nN, gid = wgid / nig, fm = gid * WGM, gsz = (nM - fm) < WGM ? (nM - fm) : WGM;
        u.pm = fm + ((wgid % nig) % gsz); u.pn = (wgid % nig) / gsz; u.e = 0; return true;
    }
};
struct GroupedOrder {
    int nM, nN, nwg, G, c, tile0; const LAS unsigned char* te; bool rev;
    __device__ void init(int ntiles, int nN_, int G_, int c_, int tile0_, const LAS unsigned char* te_, bool rev_ = false) { nM = ntiles; nN = nN_; nwg = nM * nN; G = G_; c = c_; tile0 = tile0_; te = te_; rev = rev_; }
    __device__ bool next(int i, Unit& u) const {
        const long L = (long)i * G + c; if (L >= nwg) return false;
        int wgid = (int)L; { const int q = nwg / NXCD, r = nwg % NXCD, xcd = wgid % NXCD, off = wgid / NXCD; wgid = (xcd < r ? xcd * (q + 1) : r * (q + 1) + (xcd - r) * q) + off; }
        if (rev) wgid = nwg - 1 - wgid;
        const int nig = WGM * nN, gid = wgid / nig, fm = gid * WGM, gsz = (nM - fm) < WGM ? (nM - fm) : WGM;
        u.pm = tile0 + fm + ((wgid % nig) % gsz); u.pn = (wgid % nig) / gsz; u.e = __builtin_amdgcn_readfirstlane((int)te[u.pm]); return true;
    }
};

struct EpiProj {
    static constexpr bool PERM = true;
    bf16_t* O;
    __device__ __forceinline__ void operator()(const f32x4 (&acc)[2][2][4][2], const Unit& u, int wr, int wc, int fr, int fq) const {
        const int row0 = u.pm * BM + wr * 64 + fr; const int col0 = u.pn * BM + wc * 32 + 8 * fq;
        const float sc = (u.pn < 2 || u.pn == 6 || u.pn == 7) ? C2 : 1.0f;
#pragma unroll
        for (int ai = 0; ai < 2; ++ai)
#pragma unroll
            for (int m = 0; m < 4; ++m) { bf16_t* rowp = O + (size_t)(row0 + ai * HALF + m * 16) * DIN + col0;
#pragma unroll
                for (int bj = 0; bj < 2; ++bj) { const f32x4 v0 = acc[ai][bj][m][0] * sc, v1 = acc[ai][bj][m][1] * sc;
                    u32x4 w; w.x = cvt_pk_bf16(v0[0], v0[1]); w.y = cvt_pk_bf16(v0[2], v0[3]); w.z = cvt_pk_bf16(v1[0], v1[1]); w.w = cvt_pk_bf16(v1[2], v1[3]);
                    *(u32x4*)(rowp + bj * HALF) = w; } }
    }
};
struct EpiRes {
    static constexpr bool PERM = true;
    const float* base; bf16_t* out; float* rowss;
    __device__ __forceinline__ void operator()(const f32x4 (&acc)[2][2][4][2], const Unit& u, int wr, int wc, int fr, int fq) const {
        const int col0 = u.pn * BM + wc * 32 + 8 * fq;
#pragma unroll
        for (int ai = 0; ai < 2; ++ai) {
            f32x4 rs[4][2][2];
#pragma unroll
            for (int m = 0; m < 4; ++m) { const float* rp = base + (size_t)(u.pm * BM + ai * HALF + wr * 64 + m * 16 + fr) * D + col0;
#pragma unroll
                for (int bj = 0; bj < 2; ++bj) { rs[m][bj][0] = *(const f32x4*)(rp + bj * HALF); rs[m][bj][1] = *(const f32x4*)(rp + bj * HALF + 4); } }
#pragma unroll
            for (int m = 0; m < 4; ++m) { const int row = u.pm * BM + ai * HALF + wr * 64 + m * 16 + fr; bf16_t* op = out + (size_t)row * D + col0; float ss = 0.f;
#pragma unroll
                for (int bj = 0; bj < 2; ++bj) { const f32x4 v0 = rs[m][bj][0] + acc[ai][bj][m][0], v1 = rs[m][bj][1] + acc[ai][bj][m][1];
                    u32x4 w; w.x = cvt_pk_bf16(v0[0], v0[1]); w.y = cvt_pk_bf16(v0[2], v0[3]); w.z = cvt_pk_bf16(v1[0], v1[1]); w.w = cvt_pk_bf16(v1[2], v1[3]);
                    *(u32x4*)(op + bj * HALF) = w;
                    ss += ((v0[0] * v0[0] + v0[1] * v0[1]) + (v0[2] * v0[2] + v0[3] * v0[3])) + ((v1[0] * v1[0] + v1[1] * v1[1]) + (v1[2] * v1[2] + v1[3] * v1[3])); }
                ss += __shfl_xor(ss, 16); ss += __shfl_xor(ss, 32);
                if (fq == 0) rowss[(size_t)row * 16 + u.pn * 4 + wc] = ss; }
            asm volatile("" ::: "memory");
        }
    }
};
struct EpiSwiglu {
    static constexpr bool PERM = true;
    unsigned char* act; const float* b1;
    __device__ __forceinline__ void operator()(const f32x4 (&acc)[2][2][4][2], const Unit& u, int wr, int wc, int fr, int fq) const {
        const int row0 = u.pm * BM + wr * 64 + fr; const int lc = u.pn * HALF + wc * 32 + 8 * fq;
        const float* bg = b1 + (size_t)u.e * 2048 + lc; const float* bl = bg + 1024;
        f32x4 bgv[2], blv[2];
#pragma unroll
        for (int n = 0; n < 2; ++n) { bgv[n] = *(const f32x4*)(bg + 4 * n); blv[n] = *(const f32x4*)(bl + 4 * n); }
        unsigned char* const sp = act + (size_t)(row0 + (fq & 1) * 16) * D + (lc - (fq & 1) * 8);
#pragma unroll
        for (int ai = 0; ai < 2; ++ai)
#pragma unroll
            for (int mp = 0; mp < 2; ++mp) { unsigned wx[2], wy[2];
#pragma unroll
                for (int mm = 0; mm < 2; ++mm) { const int m = 2 * mp + mm; float r[8];
#pragma unroll
                    for (int n = 0; n < 2; ++n)
#pragma unroll
                        for (int x = 0; x < 4; ++x) { float g = acc[ai][0][m][n][x] * (1.0f / 32.0f) + bgv[n][x], l = acc[ai][1][m][n][x] * (1.0f / 32.0f) + blv[n][x];
                            g = fminf(g, 7.0f); l = fminf(fmaxf(l, -7.0f), 7.0f);
                            const float sg = __builtin_amdgcn_rcpf(1.0f + __builtin_amdgcn_exp2f(-1.702f * LOG2E * g));
                            r[n * 4 + x] = g * sg * (l + 1.0f); }
                    wx[mm] = pk4_fp8(r[0], r[1], r[2], r[3]); wy[mm] = pk4_fp8(r[4], r[5], r[6], r[7]); }
                swap16(wx[0], wx[1]); swap16(wy[0], wy[1]);
                u32x4 o; o.x = wx[0]; o.y = wy[0]; o.z = wx[1]; o.w = wy[1];
                *(u32x4*)(sp + (size_t)(ai * HALF + mp * 32) * D) = o; }
    }
};
struct EpiDown {
    static constexpr bool PERM = true;
    unsigned char* Y; const float* b2; const int* rowsg; unsigned char* dump;
    __device__ __forceinline__ void operator()(const f32x4 (&acc)[2][2][4][2], const Unit& u, int wr, int wc, int fr, int fq) const {
        const int col0 = u.pn * BM + wc * 32 + 8 * fq;
        f32x4 bv[2][2];
#pragma unroll
        for (int bj = 0; bj < 2; ++bj)
#pragma unroll
            for (int n = 0; n < 2; ++n) bv[bj][n] = *(const f32x4*)(b2 + (size_t)u.e * D + col0 + bj * HALF + 4 * n);
        int slotv[8]; float gtv[8];
#pragma unroll
        for (int ai = 0; ai < 2; ++ai)
#pragma unroll
            for (int m = 0; m < 4; ++m) { const int arow = u.pm * BM + ai * HALF + wr * 64 + m * 16 + fr; slotv[ai * 4 + m] = rowsg[2 * arow]; gtv[ai * 4 + m] = __builtin_bit_cast(float, rowsg[2 * arow + 1]); }
#pragma unroll
        for (int i = 0; i < 8; ++i) asm volatile("" : "+v"(slotv[i]), "+v"(gtv[i]));
        const bool odd = (fq & 1) != 0; const int cs = col0 - (odd ? 8 : 0);
#pragma unroll
        for (int ai = 0; ai < 2; ++ai)
#pragma unroll
            for (int mp = 0; mp < 2; ++mp) {
                const int slot = odd ? slotv[ai * 4 + 2 * mp + 1] : slotv[ai * 4 + 2 * mp];
                unsigned char* rowp = (slot >= 0 ? Y + (size_t)slot * D : dump) + cs;
#pragma unroll
                for (int bj = 0; bj < 2; ++bj) { unsigned wx[2], wy[2];
#pragma unroll
                    for (int mm = 0; mm < 2; ++mm) { const int m = 2 * mp + mm; const float gt = gtv[ai * 4 + m];
                        const f32x4 v0 = (acc[ai][bj][m][0] * (1.0f / 32.0f) + bv[bj][0]) * gt, v1 = (acc[ai][bj][m][1] * (1.0f / 32.0f) + bv[bj][1]) * gt;
                        wx[mm] = pk4_fp8(v0[0], v0[1], v0[2], v0[3]); wy[mm] = pk4_fp8(v1[0], v1[1], v1[2], v1[3]); }
                    swap16(wx[0], wx[1]); swap16(wy[0], wy[1]);
                    u32x4 o; o.x = wx[0]; o.y = wy[0]; o.z = wx[1]; o.w = wy[1];
                    *(u32x4*)(rowp + bj * HALF) = o; }
                asm volatile("" ::: "memory"); }
    }
};

typedef int i32x8 __attribute__((ext_vector_type(8)));
typedef int i32x4 __attribute__((ext_vector_type(4)));
template <bool FP8> struct FragT { typedef bf16x8 A[4][2]; typedef bf16x8 B[2][2]; };
template <> struct FragT<true> { typedef i32x8 A[4]; typedef i32x8 B[2]; };
template <class Epi, class Sched, bool GATHER, bool FP8>
__device__ __forceinline__ void gemm_phase(LAS unsigned char* lds, const Gemm g, const Sched& S, const Epi& E, int tileA0) {
    int tid = threadIdx.x; asm volatile("" : "+v"(tid));
    const int wid = __builtin_amdgcn_readfirstlane(tid >> 6), lane = tid & 63, wr = wid >> 2, wc = wid & 3, fr = lane & 15, fq = lane >> 4;
    constexpr int KB = FP8 ? K : 2 * K;
    constexpr int nt = FP8 ? K / 128 : K / 64;
    unsigned cA[2], voffB[2]; int rA[2];
#pragma unroll
    for (int i = 0; i < 2; ++i) { int R, C; stage_rc(tid * 16 + i * 8192, R, C, FP8 ? 4 : 5); const int Rb = Epi::PERM ? ((R & ~31) + perm32(R & 31)) : R;
        cA[i] = (unsigned)(C * 2); rA[i] = R; voffB[i] = (unsigned)(Rb * KB + C * 2); }
    constexpr size_t kstep = 128;
    constexpr size_t hstep = (size_t)HALF * KB;
    constexpr size_t tstep = 2 * hstep;
    const unsigned ldsw = (unsigned)wid * 1024u;
    const int aoff = FP8 ? lds_byte(wr * 64 + fr, fq * 16, 4) : lds_byte(wr * 64 + fr, fq * 8), boff = FP8 ? lds_byte(wc * 32 + fr, fq * 16, 4) : lds_byte(wc * 32 + fr, fq * 8);
    const int aoff1 = FP8 ? lds_byte(wr * 64 + fr, fq * 16 + 8, 4) : 0, boff1 = FP8 ? lds_byte(wc * 32 + fr, fq * 16 + 8, 4) : 0;
#define PG8_SA(b, h) (((b) * 2 + (h)) * HTB)
#define PG8_SB(b, h) ((4 + (b) * 2 + (h)) * HTB)
#define PG8_STAGE(bufoff, gbase, voff) do { _Pragma("unroll") for (int _i = 0; _i < 2; ++_i) \
        __builtin_amdgcn_global_load_lds((const unsigned*)((const char*)(gbase) + (voff)[_i]), (LAS unsigned*)(lds + (bufoff) + ldsw + _i * 8192), 16, 0, 0); } while (0)
#define PG8_LDA(dst, b, h) do { if constexpr (FP8) { _Pragma("unroll") for (int m = 0; m < 4; ++m) { dst[m].lo = *(const LAS i32x4*)(lds + PG8_SA(b, h) + aoff + m * 2048); dst[m].hi = *(const LAS i32x4*)(lds + PG8_SA(b, h) + aoff1 + m * 2048); } } \
        else { _Pragma("unroll") for (int m = 0; m < 4; ++m) _Pragma("unroll") for (int k = 0; k < 2; ++k) dst[m][k] = *(const LAS bf16x8*)(lds + PG8_SA(b, h) + aoff + m * 2048 + k * 1024); } } while (0)
#define PG8_LDB(dst, b, h) do { if constexpr (FP8) { _Pragma("unroll") for (int n = 0; n < 2; ++n) { dst[n].lo = *(const LAS i32x4*)(lds + PG8_SB(b, h) + boff + n * 2048); dst[n].hi = *(const LAS i32x4*)(lds + PG8_SB(b, h) + boff1 + n * 2048); } } \
        else { _Pragma("unroll") for (int n = 0; n < 2; ++n) _Pragma("unroll") for (int k = 0; k < 2; ++k) dst[n][k] = *(const LAS bf16x8*)(lds + PG8_SB(b, h) + boff + n * 2048 + k * 1024); } } while (0)
#define PG8_MMA(ai, bj, At, Bt) do { __builtin_amdgcn_s_setprio(1); if constexpr (FP8) { _Pragma("unroll") for (int m = 0; m < 4; ++m) _Pragma("unroll") for (int n = 0; n < 2; ++n) \
            acc[ai][bj][m][n] = __builtin_amdgcn_mfma_scale_f32_16x16x128_f8f6f4(Bt[n], At[m], acc[ai][bj][m][n], 0, 0, 0, 0x7f7f7f7f, 0, 0x7f7f7f7f); } \
        else { _Pragma("unroll") for (int m = 0; m < 4; ++m) _Pragma("unroll") for (int n = 0; n < 2; ++n) _Pragma("unroll") for (int k = 0; k < 2; ++k) \
            acc[ai][bj][m][n] = __builtin_amdgcn_mfma_f32_16x16x32_bf16(Bt[n][k], At[m][k], acc[ai][bj][m][n], 0, 0, 0); } __builtin_amdgcn_s_setprio(0); } while (0)
#define PG8_WAIT_V(n) asm volatile("s_waitcnt vmcnt(" #n ")" ::: "memory")
#define PG8_WAIT_L(n) asm volatile("s_waitcnt lgkmcnt(" #n ")" ::: "memory")
#define PG8_BAR __builtin_amdgcn_s_barrier()
#define PG8_SCHED __builtin_amdgcn_sched_barrier(0)
#define PG8_GLOAD(dst, slot, u) do { _Pragma("unroll") for (int h = 0; h < 2; ++h) _Pragma("unroll") for (int i = 0; i < 2; ++i) \
        dst[h][i] = (GATHER ? (unsigned)g.gidx[(slot) * 256 + h * HALF + rA[i]] : (unsigned)(((u).pm - tileA0) * BM + h * HALF + rA[i])) * (unsigned)KB + cA[i]; } while (0)
#define PG8_STAGE_A(bufoff, ptr, h, VG) PG8_STAGE(bufoff, ptr, VG[h])
    Unit cur, nxt; int ui = 0;
    if (!S.next(0, cur)) return;
    f32x4 acc[2][2][4][2];
#pragma unroll
    for (int a = 0; a < 2; ++a)
#pragma unroll
        for (int b = 0; b < 2; ++b)
#pragma unroll
            for (int m = 0; m < 4; ++m)
#pragma unroll
                for (int n = 0; n < 2; ++n) acc[a][b][m][n] = (f32x4){0.f, 0.f, 0.f, 0.f};
    typename FragT<FP8>::A At; typename FragT<FP8>::B B0, B1;
    unsigned vC[2][2];
    PG8_GLOAD(vC, 0, cur);
    const char* const Ab = (const char*)g.A;
    const char* cB = (const char*)g.Bt + (size_t)cur.e * g.estride + (size_t)cur.pn * tstep;
    PG8_STAGE(PG8_SB(0, 0), cB, voffB); PG8_STAGE(PG8_SB(0, 1), cB + hstep, voffB); PG8_STAGE_A(PG8_SA(0, 0), Ab, 0, vC); PG8_STAGE_A(PG8_SA(0, 1), Ab, 1, vC);
    if (wr == 1) PG8_BAR;
    PG8_WAIT_V(2); PG8_BAR;
    PG8_STAGE(PG8_SB(1, 0), cB + kstep, voffB); PG8_STAGE_A(PG8_SA(1, 0), Ab + kstep, 0, vC); PG8_STAGE(PG8_SB(1, 1), cB + hstep + kstep, voffB);
    PG8_WAIT_V(6); PG8_BAR;
    for (;;) {
        const bool has_next = S.next(ui + 1, nxt);
        const char* nB = has_next ? (const char*)g.Bt + (size_t)nxt.e * g.estride + (size_t)nxt.pn * tstep : cB;
#pragma unroll 1
        for (int t = 0; t < nt; t += 2) {
            const bool last = (t == nt - 2);
            const char* a1 = Ab + (size_t)(t + 1) * kstep;
            const char* a2 = last ? Ab : Ab + (size_t)(t + 2) * kstep; const char* b2 = last ? nB : cB + (size_t)(t + 2) * kstep;
            const char* a3 = a2 + kstep; const char* b3 = b2 + kstep;
            PG8_LDB(B0, 0, 0); PG8_LDB(B1, 0, 1); PG8_SCHED; PG8_LDA(At, 0, 0); PG8_STAGE_A(PG8_SA(1, 1), a1, 1, vC);
            if (last && has_next) { PG8_GLOAD(vC, ui + 1, nxt); }
            PG8_WAIT_V(8); PG8_WAIT_L(0); PG8_BAR; PG8_MMA(0, 0, At, B0); PG8_MMA(0, 1, At, B1); PG8_BAR; PG8_SCHED;
            PG8_LDA(At, 0, 1); PG8_STAGE(PG8_SB(0, 0), b2, voffB); PG8_STAGE(PG8_SB(0, 1), b2 + hstep, voffB); PG8_STAGE_A(PG8_SA(0, 0), a2, 0, vC);
            PG8_WAIT_V(8); PG8_WAIT_L(0); PG8_BAR; PG8_MMA(1, 0, At, B0); PG8_MMA(1, 1, At, B1); PG8_BAR; PG8_SCHED;
            PG8_LDB(B0, 1, 0); PG8_LDB(B1, 1, 1); PG8_SCHED; PG8_LDA(At, 1, 0); PG8_STAGE_A(PG8_SA(0, 1), a2, 1, vC);
            PG8_WAIT_V(8); PG8_WAIT_L(0); PG8_BAR; PG8_MMA(0, 0, At, B0); PG8_MMA(0, 1, At, B1); PG8_BAR; PG8_SCHED;
            PG8_LDA(At, 1, 1); PG8_STAGE(PG8_SB(1, 0), b3, voffB); PG8_STAGE(PG8_SB(1, 1), b3 + hstep, voffB); PG8_STAGE_A(PG8_SA(1, 0), a3, 0, vC);
            PG8_WAIT_V(8); PG8_WAIT_L(0); PG8_BAR; PG8_MMA(1, 0, At, B0); PG8_MMA(1, 1, At, B1); PG8_BAR; PG8_SCHED;
        }
        if (wr == 0) PG8_BAR;
        { int fr_ = fr, fq_ = fq; asm volatile("" : "+v"(fr_), "+v"(fq_));
          E(acc, cur, wr, wc, fr_, fq_); }
        if (!has_next) break;
#pragma unroll
        for (int a = 0; a < 2; ++a)
#pragma unroll
            for (int b = 0; b < 2; ++b)
#pragma unroll
                for (int m = 0; m < 4; ++m)
#pragma unroll
                    for (int n = 0; n < 2; ++n) acc[a][b][m][n] = (f32x4){0.f, 0.f, 0.f, 0.f};
        cur = nxt; cB = nB; ++ui;
        if (wr == 1) PG8_BAR;
    }
    PG8_WAIT_V(0);
    PG8_BAR;
#undef PG8_SA
#undef PG8_SB
#undef PG8_STAGE
#undef PG8_LDA
#undef PG8_LDB
#undef PG8_MMA
#undef PG8_WAIT_V
#undef PG8_WAIT_L
#undef PG8_BAR
#undef PG8_SCHED
#undef PG8_GLOAD
#undef PG8_STAGE_A
}
}


namespace att {
typedef float f32x16 __attribute__((ext_vector_type(16)));
typedef short s16x4 __attribute__((ext_vector_type(4)));
typedef short v4i16_t __attribute__((ext_vector_type(4)));
typedef const LAS unsigned char* lptr;
__device__ __forceinline__ int crow(int r, int hi) { return (r & 3) + 8 * (r >> 2) + 4 * hi; }
__device__ __forceinline__ s16x4 vtr(lptr p) { return __builtin_bit_cast(s16x4, __builtin_amdgcn_ds_read_tr16_b64_v4i16((LAS v4i16_t*)p)); }
__device__ __forceinline__ void glds16(const void* g, LAS unsigned char* l) {
    const unsigned dst = (unsigned)__builtin_amdgcn_readfirstlane((int)(unsigned)(size_t)l); unsigned keep;
    asm volatile("s_mov_b32 %0, m0\n\ts_mov_b32 m0, %2\n\ts_nop 0\n\tglobal_load_lds_dwordx4 %1, off\n\ts_mov_b32 m0, %0" : "=&s"(keep) : "v"(g), "s"(dst) : "memory");
}
__device__ __forceinline__ float partner32(float x, bool hi) { auto rr = __builtin_amdgcn_permlane32_swap(__float_as_uint(x), __float_as_uint(x), false, false); return __uint_as_float(hi ? rr[0] : rr[1]); }
__device__ __forceinline__ void kload(bf16x8 (&kf)[8], lptr kslot, int r32, int hi) {
    lptr kb = kslot + hi * 1024 + r32 * 16;
#pragma unroll
    for (int d0 = 0; d0 < 4; ++d0) { kf[2 * d0] = *(const LAS bf16x8*)(kb + d0 * 2048); kf[2 * d0 + 1] = *(const LAS bf16x8*)(kb + d0 * 2048 + 512); }
}
__device__ __forceinline__ void qkt(f32x16& p0, f32x16& p1, const bf16x8 (&kf)[8], const bf16x8 (&qr)[4], const f32x16& c0) {
    __builtin_amdgcn_s_setprio(1);
    p0 = __builtin_amdgcn_mfma_f32_32x32x16_bf16(kf[0], qr[0], c0, 0, 0, 0); p1 = __builtin_amdgcn_mfma_f32_32x32x16_bf16(kf[1], qr[0], c0, 0, 0, 0);
#pragma unroll
    for (int d0 = 1; d0 < 4; ++d0) { p0 = __builtin_amdgcn_mfma_f32_32x32x16_bf16(kf[2 * d0], qr[d0], p0, 0, 0, 0); p1 = __builtin_amdgcn_mfma_f32_32x32x16_bf16(kf[2 * d0 + 1], qr[d0], p1, 0, 0, 0); }
    __builtin_amdgcn_s_setprio(0);
}
__device__ __forceinline__ void vload(bf16x8 (&vf)[8], lptr vp) {
#pragma unroll
    for (int d0 = 0; d0 < 2; ++d0)
#pragma unroll
        for (int ks = 0; ks < 4; ++ks) { const s16x4 lo = vtr(vp + d0 * 4096 + ks * 1024), hi4 = vtr(vp + d0 * 4096 + ks * 1024 + 512);
            vf[d0 * 4 + ks] = (bf16x8){lo[0], lo[1], lo[2], lo[3], hi4[0], hi4[1], hi4[2], hi4[3]}; }
}
__device__ __forceinline__ void pv64(f32x16& o0, f32x16& o1, const bf16x8 (&vf)[8], const bf16x8 (&pa)[4]) {
    __builtin_amdgcn_s_setprio(1);
#pragma unroll
    for (int ks = 0; ks < 4; ++ks) { o0 = __builtin_amdgcn_mfma_f32_32x32x16_bf16(pa[ks], vf[ks], o0, 0, 0, 0); o1 = __builtin_amdgcn_mfma_f32_32x32x16_bf16(pa[ks], vf[4 + ks], o1, 0, 0, 0); }
    __builtin_amdgcn_s_setprio(0);
}
__device__ __forceinline__ void pack_p(bf16x8 (&pa)[4], const f32x16& p0, const f32x16& p1) {
    u32x4 w0, w1, w2, w3;
    w0.x = cvt_pk_bf16(p0[0], p0[1]); w0.y = cvt_pk_bf16(p0[2], p0[3]); w0.z = cvt_pk_bf16(p0[4], p0[5]); w0.w = cvt_pk_bf16(p0[6], p0[7]);
    w1.x = cvt_pk_bf16(p0[8], p0[9]); w1.y = cvt_pk_bf16(p0[10], p0[11]); w1.z = cvt_pk_bf16(p0[12], p0[13]); w1.w = cvt_pk_bf16(p0[14], p0[15]);
    w2.x = cvt_pk_bf16(p1[0], p1[1]); w2.y = cvt_pk_bf16(p1[2], p1[3]); w2.z = cvt_pk_bf16(p1[4], p1[5]); w2.w = cvt_pk_bf16(p1[6], p1[7]);
    w3.x = cvt_pk_bf16(p1[8], p1[9]); w3.y = cvt_pk_bf16(p1[10], p1[11]); w3.z = cvt_pk_bf16(p1[12], p1[13]); w3.w = cvt_pk_bf16(p1[14], p1[15]);
    pa[0] = __builtin_bit_cast(bf16x8, w0); pa[1] = __builtin_bit_cast(bf16x8, w1); pa[2] = __builtin_bit_cast(bf16x8, w2); pa[3] = __builtin_bit_cast(bf16x8, w3);
}

#define ATT_WAIT_BAR(N) asm volatile("s_waitcnt vmcnt(" #N ") lgkmcnt(0)\n\ts_barrier" ::: "memory")
#define ATT_BAR() asm volatile("s_waitcnt lgkmcnt(0)\n\ts_barrier" ::: "memory")
__device__ __forceinline__ void sb_probs(f32x16& p0, f32x16& p1) {
#pragma unroll
    for (int r = 0; r < 16; ++r) { p0[r] = __builtin_amdgcn_rcpf(1.0f + __builtin_amdgcn_exp2f(p0[r])); p1[r] = __builtin_amdgcn_rcpf(1.0f + __builtin_amdgcn_exp2f(p1[r])); }
}
__device__ __forceinline__ void sb_mask(f32x16& p0, f32x16& p1, int lim, int hi) {
#pragma unroll
    for (int r = 0; r < 16; ++r) { const int kl = crow(r, hi); if (kl >= lim) p0[r] = 1.0f; if (kl + 32 >= lim) p1[r] = 1.0f; }
}
__device__ __forceinline__ void sb_scan(f32x16& p0, f32x16& p1, float& carry, bool hib) {
    float G[8], Gp[8];
#pragma unroll
    for (int gi = 0; gi < 4; ++gi) { G[gi] = (p0[4 * gi] * p0[4 * gi + 1]) * (p0[4 * gi + 2] * p0[4 * gi + 3]); G[4 + gi] = (p1[4 * gi] * p1[4 * gi + 1]) * (p1[4 * gi + 2] * p1[4 * gi + 3]); }
#pragma unroll
    for (int gi = 0; gi < 8; ++gi) Gp[gi] = partner32(G[gi], hib);
    float u = carry;
#pragma unroll
    for (int gi = 7; gi >= 0; --gi) {
        const float ug = u * Gp[gi]; float tt = hib ? u : ug;
#pragma unroll
        for (int i = 3; i >= 0; --i) { if (gi >= 4) { const float tn = tt * p1[4 * (gi - 4) + i]; p1[4 * (gi - 4) + i] = tt - tn; tt = tn; } else { const float tn = tt * p0[4 * gi + i]; p0[4 * gi + i] = tt - tn; tt = tn; } }
        u = ug * G[gi];
    }
    carry = u;
}
__device__ __forceinline__ void sb_head(LAS unsigned char* lds, const bf16_t* PROJ, const bf16_t* METAKV, bf16_t* MIX, int b, int h) {
    int tid = threadIdx.x; asm volatile("" : "+v"(tid));
    const int lane = tid & 63, r32 = lane & 31, hi = lane >> 5; const int wid = __builtin_amdgcn_readfirstlane(tid >> 6);
    const bool hib = hi != 0;
    const bf16_t* Kg = PROJ + (size_t)b * SEQ * DIN + COL_SBK + h * 64; const bf16_t* Vg = PROJ + (size_t)b * SEQ * DIN + COL_SBV + h * 64;
    const bf16_t* Km = METAKV + COL_SBK + h * 64; const bf16_t* Vm = METAKV + COL_SBV + h * 64;
    const int vrow = 16 * (wid & 3) + (lane >> 2), vcol = (wid >> 2) * 32 + (lane & 3) * 8;
    const int voff_lane = ((lane >> 4) & 1) * 32 + (lane & 3) * 8 + (4 * hi + ((lane & 15) >> 2)) * 64;
    int c_qb = 7, c_ip = 0, n_iss = 0, s_iss = 0;
#define SB_ISSUE_NEXT() do { if (c_qb >= 0) { LAS unsigned char* bb_ = lds + s_iss * 32768; const int NT_ = 4 * c_qb + 4, NP_ = NT_ >> 1; \
        if (c_ip < NP_) { const int keyA_ = 64 * (NT_ - 1 - 2 * c_ip), keyB_ = keyA_ - 64; \
            glds16(Kg + (size_t)(keyA_ + lane) * DIN + wid * 8, bb_ + wid * 1024); glds16(Vg + (size_t)(keyA_ + vrow) * DIN + vcol, bb_ + 8192 + wid * 1024); \
            glds16(Kg + (size_t)(keyB_ + lane) * DIN + wid * 8, bb_ + 16384 + wid * 1024); glds16(Vg + (size_t)(keyB_ + vrow) * DIN + vcol, bb_ + 24576 + wid * 1024); } \
        else { glds16(Km + (size_t)(lane < 16 ? lane : 15) * DIN + wid * 8, bb_ + wid * 1024); glds16(Vm + (size_t)(vrow < 16 ? vrow : 15) * DIN + vcol, bb_ + 8192 + wid * 1024); \
            glds16(Km + (size_t)(lane < 16 ? lane : 15) * DIN + wid * 8, bb_ + 16384 + wid * 1024); glds16(Vm + (size_t)(vrow < 16 ? vrow : 15) * DIN + vcol, bb_ + 24576 + wid * 1024); } \
        ++n_iss; s_iss = s_iss == 2 ? 0 : s_iss + 1; if (++c_ip > NP_) { c_ip = 0; --c_qb; } } } while (0)
    SB_ISSUE_NEXT(); SB_ISSUE_NEXT();
    bf16x8 qr[4];
    { const bf16_t* qp = PROJ + ((size_t)b * SEQ + 7 * 256 + wid * 32 + r32) * DIN + COL_SBQ + h * 64 + hi * 8;
#pragma unroll
      for (int d0 = 0; d0 < 4; ++d0) qr[d0] = *(const bf16x8*)(qp + d0 * 16); }
    asm volatile("" : "+v"(qr[0]), "+v"(qr[1]), "+v"(qr[2]), "+v"(qr[3]));
    int js = 0, s_cmp = 0;
    for (int qb = 7; qb >= 0; --qb) {
        const int NT = 4 * qb + 4, NP = NT / 2, q0w = qb * 256 + wid * 32, my_diag = 4 * qb + (wid >> 1);
        f32x16 o0 = {}, o1 = {}; float carry = 1.0f;
        bf16x8 qn[4] = {qr[0], qr[1], qr[2], qr[3]};
        for (int ip = 0; ip <= NP; ++ip) {
            if (ip == 0) ATT_BAR(); else if (js + 1 < n_iss) ATT_WAIT_BAR(4); else ATT_WAIT_BAR(0);
            SB_ISSUE_NEXT();
            if (ip == NP && qb > 0) { const bf16_t* qp = PROJ + ((size_t)b * SEQ + (qb - 1) * 256 + wid * 32 + r32) * DIN + COL_SBQ + h * 64 + hi * 8;
#pragma unroll
                for (int d0 = 0; d0 < 4; ++d0) qn[d0] = *(const bf16x8*)(qp + d0 * 16); }
            lptr bb = lds + s_cmp * 32768;
            const f32x16 z16 = {};
            if (ip == NP) {
                f32x16 p0;
                { lptr kb = bb + hi * 1024 + r32 * 16; bf16x8 k4[4];
#pragma unroll
                  for (int d0 = 0; d0 < 4; ++d0) k4[d0] = *(const LAS bf16x8*)(kb + d0 * 2048);
                  p0 = __builtin_amdgcn_mfma_f32_32x32x16_bf16(k4[0], qr[0], z16, 0, 0, 0);
#pragma unroll
                  for (int d0 = 1; d0 < 4; ++d0) p0 = __builtin_amdgcn_mfma_f32_32x32x16_bf16(k4[d0], qr[d0], p0, 0, 0, 0); }
                lptr vp = bb + 8192 + voff_lane;
                const s16x4 vl0 = vtr(vp), vh0 = vtr(vp + 512), vl1 = vtr(vp + 4096), vh1 = vtr(vp + 4096 + 512);
                float pm[8];
#pragma unroll
                for (int r = 0; r < 8; ++r) pm[r] = __builtin_amdgcn_rcpf(1.0f + __builtin_amdgcn_exp2f(p0[r]));
                const float G0 = (pm[0] * pm[1]) * (pm[2] * pm[3]), G1 = (pm[4] * pm[5]) * (pm[6] * pm[7]);
                const float Gp0 = partner32(G0, hib), Gp1 = partner32(G1, hib);
                float u = carry;
                { const float ug = u * Gp1; float tt = hib ? u : ug;
#pragma unroll
                  for (int i = 3; i >= 0; --i) { const float tn = tt * pm[4 + i]; pm[4 + i] = tt - tn; tt = tn; }
                  u = ug * G1; }
                { const float ug = u * Gp0; float tt = hib ? u : ug;
#pragma unroll
                  for (int i = 3; i >= 0; --i) { const float tn = tt * pm[i]; pm[i] = tt - tn; tt = tn; } }
                u32x4 w0; w0.x = cvt_pk_bf16(pm[0], pm[1]); w0.y = cvt_pk_bf16(pm[2], pm[3]); w0.z = cvt_pk_bf16(pm[4], pm[5]); w0.w = cvt_pk_bf16(pm[6], pm[7]);
                const bf16x8 pa0 = __builtin_bit_cast(bf16x8, w0);
                o0 = __builtin_amdgcn_mfma_f32_32x32x16_bf16(pa0, (bf16x8){vl0[0], vl0[1], vl0[2], vl0[3], vh0[0], vh0[1], vh0[2], vh0[3]}, o0, 0, 0, 0);
                o1 = __builtin_amdgcn_mfma_f32_32x32x16_bf16(pa0, (bf16x8){vl1[0], vl1[1], vl1[2], vl1[3], vh1[0], vh1[1], vh1[2], vh1[3]}, o1, 0, 0, 0);
            } else {
                const int tA = NT - 1 - 2 * ip, tB = tA - 1;
                if (tA <= my_diag) {
                    f32x16 a0, a1, b0, b1; bf16x8 kf[8];
                    kload(kf, bb, r32, hi); qkt(a0, a1, kf, qr, z16);
                    kload(kf, bb + 16384, r32, hi); qkt(b0, b1, kf, qr, z16);
                    sb_probs(a0, a1); sb_probs(b0, b1);
                    if (tA == my_diag) sb_mask(a0, a1, q0w + r32 - 64 * tA, hi);
                    sb_scan(a0, a1, carry, hib);
                    { bf16x8 vf[8]; vload(vf, bb + 8192 + voff_lane); bf16x8 pa[4]; pack_p(pa, a0, a1); pv64(o0, o1, vf, pa); }
                    sb_scan(b0, b1, carry, hib);
                    { bf16x8 vf[8]; vload(vf, bb + 24576 + voff_lane); bf16x8 pa[4]; pack_p(pa, b0, b1); pv64(o0, o1, vf, pa); }
                } else if (tB <= my_diag) {
                    f32x16 p0, p1; bf16x8 kf[8]; kload(kf, bb + 16384, r32, hi); qkt(p0, p1, kf, qr, z16);
                    bf16x8 vf[8]; vload(vf, bb + 24576 + voff_lane);
                    sb_probs(p0, p1); if (tB == my_diag) sb_mask(p0, p1, q0w + r32 - 64 * tB, hi); sb_scan(p0, p1, carry, hib);
                    bf16x8 pa[4]; pack_p(pa, p0, p1); pv64(o0, o1, vf, pa);
                }
            }
            ++js; s_cmp = s_cmp == 2 ? 0 : s_cmp + 1;
        }
        if (qb > 0) asm volatile("" : "+v"(qn[0]), "+v"(qn[1]), "+v"(qn[2]), "+v"(qn[3]));
        { LAS bf16_t* stg = (LAS bf16_t*)(lds + 98304 + wid * 4096);
#pragma unroll
          for (int r = 0; r < 16; ++r) { const int orow = crow(r, hi); stg[orow * 64 + r32] = (bf16_t)f2bf(o0[r]); stg[orow * 64 + 32 + r32] = (bf16_t)f2bf(o1[r]); }
          bf16_t* Ow = MIX + ((size_t)b * SEQ + q0w) * D + h * 64;
#pragma unroll
          for (int i = 0; i < 4; ++i) { const int row = i * 8 + (lane >> 3), ch = lane & 7; const u32x4 v = *(const LAS u32x4*)(stg + row * 64 + ch * 8); *(u32x4*)(Ow + (size_t)row * D + ch * 8) = v; } }
#pragma unroll
        for (int d0 = 0; d0 < 4; ++d0) qr[d0] = qn[d0];
    }
    asm volatile("s_waitcnt vmcnt(0) lgkmcnt(0)\n\ts_barrier" ::: "memory");
#undef SB_ISSUE_NEXT
}

constexpr float DF_THR = 8.0f;
__device__ __forceinline__ void df_head(LAS unsigned char* lds, LAS float* wsf_all, const LAS float* btab, float lam, const float* sgain, const bf16_t* PROJ, const bf16_t* METAKV, bf16_t* MIX, int b, int hd, int which) {
    int tid = threadIdx.x; asm volatile("" : "+v"(tid));
    const int lane = tid & 63, r32 = lane & 31, hi = lane >> 5; const int wid = __builtin_amdgcn_readfirstlane(tid >> 6);
    const bool hib = hi != 0; const int s = wid >> 2, qw = wid & 3;
    const size_t rb = (size_t)b * SEQ * DIN;
    const bf16_t* K0g = PROJ + rb + COL_DFK + (2 * hd) * 64; const bf16_t* K1g = K0g + 64; const bf16_t* Vg = PROJ + rb + COL_DFV + hd * 128;
    const bf16_t* K0m = METAKV + COL_DFK + (2 * hd) * 64; const bf16_t* K1m = K0m + 64; const bf16_t* Vm = METAKV + COL_DFV + hd * 128;
    const int vrow = 16 * (wid & 3) + (lane >> 2), vcol = (wid >> 2) * 32 + (lane & 3) * 8;
    const int voff_lane = ((lane >> 4) & 1) * 32 + (lane & 3) * 8 + (4 * hi + ((lane & 15) >> 2)) * 64;
    LAS float* wsf = wsf_all + wid * 64;
    const LAS float* bt = btab + hd * 288 + 96;
    const float bfar = bt[0];
#define DF_UNIT(i8_) (2 * (i8_) + (which ? 1 - ((i8_) & 1) : ((i8_) & 1)))
    int c_i8 = 0, c_it = 0, n_iss = 0, s_iss = 0;
#define DF_ISSUE_NEXT() do { if (c_i8 < 8) { LAS unsigned char* bb_ = lds + s_iss * 32768; const int NTL_ = 2 * DF_UNIT(c_i8) + 2; \
        if (c_it < NTL_) { const int key0_ = 64 * c_it; const size_t ko_ = (size_t)(key0_ + lane) * DIN + wid * 8, vo_ = (size_t)(key0_ + vrow) * DIN + vcol; \
            glds16(K0g + ko_, bb_ + wid * 1024); glds16(K1g + ko_, bb_ + 8192 + wid * 1024); glds16(Vg + vo_, bb_ + 16384 + wid * 1024); glds16(Vg + vo_ + 64, bb_ + 24576 + wid * 1024); } \
        else { const size_t ko_ = (size_t)(lane < 16 ? lane : 15) * DIN + wid * 8, vo_ = (size_t)(vrow < 16 ? vrow : 15) * DIN + vcol; \
            glds16(K0m + ko_, bb_ + wid * 1024); glds16(K1m + ko_, bb_ + 8192 + wid * 1024); glds16(Vm + vo_, bb_ + 16384 + wid * 1024); glds16(Vm + vo_ + 64, bb_ + 24576 + wid * 1024); } \
        ++n_iss; s_iss = s_iss == 2 ? 0 : s_iss + 1; if (++c_it > NTL_) { c_it = 0; ++c_i8; } } } while (0)
    DF_ISSUE_NEXT(); DF_ISSUE_NEXT();
    bf16x8 qr[4];
    { const bf16_t* qp = PROJ + ((size_t)b * SEQ + DF_UNIT(0) * 128 + qw * 32 + r32) * DIN + COL_DFQ + (2 * hd + s) * 64 + hi * 8;
#pragma unroll
      for (int d0 = 0; d0 < 4; ++d0) qr[d0] = *(const bf16x8*)(qp + d0 * 16); }
    float gnv[4];
#pragma unroll
    for (int db = 0; db < 4; ++db) gnv[db] = sgain[db * 32 + r32];
    asm volatile("" : "+v"(qr[0]), "+v"(qr[1]), "+v"(qr[2]), "+v"(qr[3]), "+v"(gnv[0]), "+v"(gnv[1]), "+v"(gnv[2]), "+v"(gnv[3]));
    int js = 0, s_cmp = 0;
    for (int i8 = 0; i8 < 8; ++i8) {
        const int u = DF_UNIT(i8);
        const int NTL = 2 * u + 2;
        const int q0w = u * 128 + qw * 32, mychunk = 2 * u + (qw >> 1);
        f32x16 o[4] = {{}, {}, {}, {}}; float mrun = -1e30f, lsum = 0.f;
        bf16x8 qn[4] = {qr[0], qr[1], qr[2], qr[3]};
        for (int it = 0; it < NTL; ++it) {
            if (it == 0) ATT_BAR(); else ATT_WAIT_BAR(4);
            DF_ISSUE_NEXT();
            if (it <= mychunk) {
                lptr bb = lds + s_cmp * 32768;
                const int kbase = 64 * it;
                const bool near = (q0w - (kbase + 63)) < 128;
                f32x16 p0, p1; const f32x16 c0 = {};
                const float badd = near ? 0.f : bfar;
                bf16x8 kf[8]; kload(kf, bb + s * 8192, r32, hi); __builtin_amdgcn_sched_barrier(0);
                qkt(p0, p1, kf, qr, c0);
                if (near) { const LAS float* btl = bt + (kbase - (q0w + r32) + 128 + 4 * hi);
#pragma unroll
                    for (int r = 0; r < 16; ++r) { p0[r] += btl[crow(r, 0)]; p1[r] += btl[crow(r, 0) + 32]; } }
                float tm = fmaxf(p0[0], p1[0]);
#pragma unroll
                for (int r = 1; r < 16; ++r) tm = fmaxf(tm, fmaxf(p0[r], p1[r]));
                tm = fmaxf(tm, partner32(tm, hib)) + badd;
                if (__any(tm > mrun + DF_THR)) {
                    const float mn = fmaxf(mrun, tm); const float f = __builtin_amdgcn_exp2f(mrun - mn); mrun = mn; lsum *= f;
                    if (!hib) wsf[r32] = f;
#pragma unroll
                    for (int r = 0; r < 16; ++r) { const float fr_ = wsf[crow(r, hi)]; o[0][r] *= fr_; o[1][r] *= fr_; o[2][r] *= fr_; o[3][r] *= fr_; }
                }
                float ps = 0.f;
                const float msub = mrun - badd;
#pragma unroll
                for (int r = 0; r < 16; ++r) { p0[r] = __builtin_amdgcn_exp2f(p0[r] - msub); p1[r] = __builtin_amdgcn_exp2f(p1[r] - msub); ps += p0[r] + p1[r]; }
                lsum += ps;
                bf16x8 pa[4]; pack_p(pa, p0, p1);
                bf16x8 vf[8]; vload(vf, bb + 16384 + voff_lane); __builtin_amdgcn_sched_barrier(0);
                pv64(o[0], o[1], vf, pa);
                vload(vf, bb + 24576 + voff_lane); __builtin_amdgcn_sched_barrier(0);
                pv64(o[2], o[3], vf, pa);
            }
            ++js; s_cmp = s_cmp == 2 ? 0 : s_cmp + 1;
        }
        {
            if (js + 1 < n_iss) ATT_WAIT_BAR(4); else ATT_WAIT_BAR(0);
            DF_ISSUE_NEXT();
            if (i8 < 7) { const bf16_t* qp = PROJ + ((size_t)b * SEQ + DF_UNIT(i8 + 1) * 128 + qw * 32 + r32) * DIN + COL_DFQ + (2 * hd + s) * 64 + hi * 8;
#pragma unroll
                for (int d0 = 0; d0 < 4; ++d0) qn[d0] = *(const bf16x8*)(qp + d0 * 16); }
            {
                lptr bb = lds + s_cmp * 32768;
                const bool near = (q0w + 16 - 15) < 128;
                const float badd = near ? 0.f : bfar;
                f32x16 p0; const f32x16 c0 = {};
                { lptr kb = bb + s * 8192 + hi * 1024 + r32 * 16; bf16x8 k4[4];
#pragma unroll
                  for (int d0 = 0; d0 < 4; ++d0) k4[d0] = *(const LAS bf16x8*)(kb + d0 * 2048);
                  p0 = __builtin_amdgcn_mfma_f32_32x32x16_bf16(k4[0], qr[0], c0, 0, 0, 0);
#pragma unroll
                  for (int d0 = 1; d0 < 4; ++d0) p0 = __builtin_amdgcn_mfma_f32_32x32x16_bf16(k4[d0], qr[d0], p0, 0, 0, 0); }
                lptr vpa = bb + 16384 + voff_lane; lptr vpb = bb + 24576 + voff_lane;
                const s16x4 al0 = vtr(vpa), ah0 = vtr(vpa + 512), al1 = vtr(vpa + 4096), ah1 = vtr(vpa + 4096 + 512);
                const s16x4 bl0 = vtr(vpb), bh0 = vtr(vpb + 512), bl1 = vtr(vpb + 4096), bh1 = vtr(vpb + 4096 + 512);
                float pm[8];
#pragma unroll
                for (int r = 0; r < 8; ++r) pm[r] = p0[r];
                if (near) { const int base = -16 - (q0w + r32) + 128;
#pragma unroll
                    for (int r = 0; r < 8; ++r) pm[r] += bt[base + crow(r, hi)]; }
                float tm = fmaxf(fmaxf(pm[0], pm[1]), fmaxf(pm[2], pm[3])); tm = fmaxf(tm, fmaxf(fmaxf(pm[4], pm[5]), fmaxf(pm[6], pm[7])));
                tm = fmaxf(tm, partner32(tm, hib)) + badd;
                if (__any(tm > mrun + DF_THR)) {
                    const float mn = fmaxf(mrun, tm); const float f = __builtin_amdgcn_exp2f(mrun - mn); mrun = mn; lsum *= f;
                    if (!hib) wsf[r32] = f;
#pragma unroll
                    for (int r = 0; r < 16; ++r) { const float fr_ = wsf[crow(r, hi)]; o[0][r] *= fr_; o[1][r] *= fr_; o[2][r] *= fr_; o[3][r] *= fr_; }
                }
                float ps = 0.f; const float msub = mrun - badd;
#pragma unroll
                for (int r = 0; r < 8; ++r) { pm[r] = __builtin_amdgcn_exp2f(pm[r] - msub); ps += pm[r]; }
                lsum += ps;
                u32x4 w0; w0.x = cvt_pk_bf16(pm[0], pm[1]); w0.y = cvt_pk_bf16(pm[2], pm[3]); w0.z = cvt_pk_bf16(pm[4], pm[5]); w0.w = cvt_pk_bf16(pm[6], pm[7]);
                const bf16x8 pa0 = __builtin_bit_cast(bf16x8, w0);
#define DF_FR(l_, h_) (bf16x8){l_[0], l_[1], l_[2], l_[3], h_[0], h_[1], h_[2], h_[3]}
                o[0] = __builtin_amdgcn_mfma_f32_32x32x16_bf16(pa0, DF_FR(al0, ah0), o[0], 0, 0, 0); o[1] = __builtin_amdgcn_mfma_f32_32x32x16_bf16(pa0, DF_FR(al1, ah1), o[1], 0, 0, 0);
                o[2] = __builtin_amdgcn_mfma_f32_32x32x16_bf16(pa0, DF_FR(bl0, bh0), o[2], 0, 0, 0); o[3] = __builtin_amdgcn_mfma_f32_32x32x16_bf16(pa0, DF_FR(bl1, bh1), o[3], 0, 0, 0);
#undef DF_FR
            }
            ++js; s_cmp = s_cmp == 2 ? 0 : s_cmp + 1;
        }
        if (i8 < 7) asm volatile("" : "+v"(qn[0]), "+v"(qn[1]), "+v"(qn[2]), "+v"(qn[3]));
        const float ltot = lsum + partner32(lsum, hib);
        if (!hib) wsf[r32] = (s ? lam : 1.0f) / ltot;
        float sc[16];
#pragma unroll
        for (int r = 0; r < 16; ++r) sc[r] = wsf[crow(r, hi)];
        LAS unsigned* X = (LAS unsigned*)(lds + 98304 + qw * 8192);
        if (s == 1) {
#pragma unroll
            for (int db = 0; db < 4; ++db)
#pragma unroll
                for (int rp = 0; rp < 8; ++rp) X[(db * 8 + rp) * 64 + lane] = cvt_pk_bf16(o[db][2 * rp] * sc[2 * rp], o[db][2 * rp + 1] * sc[2 * rp + 1]);
        }
        ATT_BAR();
        if (s == 0) {
            float ssq[16];
#pragma unroll
            for (int r = 0; r < 16; ++r) ssq[r] = 0.f;
#pragma unroll
            for (int db = 0; db < 4; ++db)
#pragma unroll
                for (int rp = 0; rp < 8; ++rp) { const unsigned xx = X[(db * 8 + rp) * 64 + lane];
                    const float a0 = o[db][2 * rp] * sc[2 * rp] - bf_lo(xx), a1 = o[db][2 * rp + 1] * sc[2 * rp + 1] - bf_hi(xx);
                    o[db][2 * rp] = a0; o[db][2 * rp + 1] = a1; ssq[2 * rp] += a0 * a0; ssq[2 * rp + 1] += a1 * a1; }
#pragma unroll
            for (int r = 0; r < 16; ++r) {
#pragma unroll
                for (int of = 1; of < 32; of <<= 1) ssq[r] += __shfl_xor(ssq[r], of);
                ssq[r] = (1.0f - LAMBDA_INIT) / sqrtf(ssq[r] * (1.0f / 128.0f) + SUBLN_EPS); }
            LAS bf16_t* stg = (LAS bf16_t*)X;
#pragma unroll
            for (int db = 0; db < 4; ++db)
#pragma unroll
                for (int r = 0; r < 16; ++r) stg[crow(r, hi) * 128 + db * 32 + r32] = (bf16_t)f2bf(o[db][r] * ssq[r] * gnv[db]);
            bf16_t* Ow = MIX + ((size_t)b * SEQ + q0w) * D + 512 + hd * 128;
            const int row0 = lane >> 4, ch = lane & 15;
#pragma unroll
            for (int i = 0; i < 8; ++i) { const int row = row0 + 4 * i; const u32x4 v = *(const LAS u32x4*)(stg + row * 128 + ch * 8); *(u32x4*)(Ow + (size_t)row * D + ch * 8) = v; }
        }
#pragma unroll
        for (int d0 = 0; d0 < 4; ++d0) qr[d0] = qn[d0];
    }
    asm volatile("s_waitcnt vmcnt(0) lgkmcnt(0)\n\ts_barrier" ::: "memory");
#undef DF_ISSUE_NEXT
#undef DF_UNIT
}
}

#define XB_TMO      128
#define XB_XCNT(j)  (256  + 64 * (j))
#define XB_XSUB(j)  (1280 + 64 * (j))
#define XB_XGEN(j)  (2304 + 64 * (j))
#define XB_TOP      3328
#define XB_TOPGEN   3392
#define XCD_BAR_WORDS 3456
#define XB_SPIN_CAP (1u << 18)
__device__ __forceinline__ unsigned xb_ld(unsigned* p)              { return __hip_atomic_load(p, __ATOMIC_RELAXED, __HIP_MEMORY_SCOPE_AGENT); }
__device__ __forceinline__ unsigned xb_add(unsigned* p, unsigned v) { return __hip_atomic_fetch_add(p, v, __ATOMIC_RELAXED, __HIP_MEMORY_SCOPE_AGENT); }
__device__ __forceinline__ unsigned xb_xcc_id() { return (unsigned)__builtin_amdgcn_s_getreg((3 << 11) | 20) & 0xFu; }
#define XB_SPIN(cond, bar) do { unsigned _sp = 0; while (cond) { __builtin_amdgcn_s_sleep(1); \
    if ((++_sp & 255u) == 0u) { if (xb_ld(&(bar)[XB_TMO])) break; if (_sp > XB_SPIN_CAP) { atomicAdd(&(bar)[XB_TMO], 1u); break; } } } } while (0)
struct XcdBarrier { unsigned* bar; unsigned x; volatile LAS unsigned* st; };
__device__ __forceinline__ XcdBarrier xcd_barrier_post(unsigned* bar, volatile LAS unsigned* st) {
    XcdBarrier b; b.bar = bar; b.x = xb_xcc_id(); b.st = st;
    if (threadIdx.x == 0) (void)xb_add(&bar[XB_XCNT(b.x)], 1u);
    return b;
}
__device__ __forceinline__ void xcd_barrier_complete(unsigned* bar, unsigned x, unsigned& nloc, unsigned& nx) {
    const unsigned G = gridDim.x * gridDim.y * gridDim.z;
    unsigned sum, cnt, mine, sp = 0u;
    for (;;) {
        sum = 0u; cnt = 0u; mine = 0u;
#pragma unroll
        for (unsigned j = 0; j < 16; ++j) { const unsigned c = xb_ld(&bar[XB_XCNT(j)]); sum += c; cnt += (c > 0u) ? 1u : 0u; mine = (j == x) ? c : mine; }
        if (sum == G) break;
        __builtin_amdgcn_s_sleep(1);
        if ((++sp & 255u) == 0u) { if (xb_ld(&bar[XB_TMO])) break; if (sp > XB_SPIN_CAP) { atomicAdd(&bar[XB_TMO], 1u); break; } }
    }
    nloc = mine > 0u ? mine : 1u; nx = cnt > 0u ? cnt : 1u;
}
__device__ __forceinline__ void xcd_barrier(const XcdBarrier& b) {
    asm volatile("s_waitcnt vmcnt(0)" ::: "memory");
    __syncthreads();
    if (threadIdx.x == 0) {
        unsigned* bar = b.bar;
        __builtin_amdgcn_s_waitcnt(0);
        unsigned nloc = b.st[0], nx = b.st[1];
        if (nloc == 0u) { xcd_barrier_complete(bar, b.x, nloc, nx); b.st[0] = nloc; b.st[1] = nx; }
        const unsigned old = xb_add(&bar[XB_XSUB(b.x)], 1u);
        const unsigned gen = old / nloc;
        if (old + 1u == (gen + 1u) * nloc) {
            __builtin_amdgcn_fence(__ATOMIC_RELEASE, "agent");
            asm volatile("s_waitcnt vmcnt(0)" ::: "memory");
            const unsigned og = xb_add(&bar[XB_TOP], 1u);
            const unsigned tg = og / nx;
            if (og + 1u == (tg + 1u) * nx) xb_add(&bar[XB_TOPGEN], 1u);
            else XB_SPIN(xb_ld(&bar[XB_TOPGEN]) == tg, bar);
            __builtin_amdgcn_fence(__ATOMIC_ACQUIRE, "agent");
            xb_add(&bar[XB_XGEN(b.x)], 1u);
            asm volatile("s_waitcnt vmcnt(0)" ::: "memory");
        } else {
            XB_SPIN(xb_ld(&bar[XB_XGEN(b.x)]) == gen, bar);
            __builtin_amdgcn_fence(__ATOMIC_ACQUIRE, "agent");
            asm volatile("s_waitcnt vmcnt(0)" ::: "memory");
        }
    }
    __syncthreads();
}

struct Args { const float* in[19]; float* out; unsigned char* ws; int ph_lo, ph_hi; };
enum { I_X = 0, I_META, I_RELB, I_ANORM, I_WIN, I_WOUT, I_LQ1, I_LK1, I_LQ2, I_LK2, I_SUBLN, I_FNORM, I_WR, I_BR, I_W1, I_B1, I_W2, I_B2, I_FINAL };

__device__ __forceinline__ void rms_row_to_bf16(const float* xrow, const f32x4 (&gn)[4], bf16_t* orow, int lane) {
    const f32x4* xr = (const f32x4*)xrow + lane;
    f32x4 v[4]; float s = 0.f;
#pragma unroll
    for (int j = 0; j < 4; ++j) { v[j] = xr[64 * j]; s += (v[j].x * v[j].x + v[j].y * v[j].y) + (v[j].z * v[j].z + v[j].w * v[j].w); }
    const float r = 1.0f / sqrtf(wave_sum(s) * (1.f / D) + NORM_EPS);
    unsigned long long* o8 = (unsigned long long*)orow + lane;
#pragma unroll
    for (int j = 0; j < 4; ++j) { const f32x4 y = v[j] * r * gn[j]; o8[64 * j] = (unsigned long long)pk2(y.x, y.y) | ((unsigned long long)pk2(y.z, y.w) << 32); }
}

__device__ __forceinline__ void p0_transpose_item(const float* W, int K, int N, bf16_t* WT, LAS float* scr, int item, int lane, int mode) {
    const int nblk = N / 32, kb = item / nblk, nb = item % nblk, k0 = 64 * kb, n0 = 32 * nb;
#pragma unroll 8
    for (int i = 0; i < 32; ++i) { const int kk = 2 * i + (lane >> 5); scr[kk * 33 + (lane & 31)] = W[(size_t)(k0 + kk) * N + n0 + (lane & 31)]; }
    LDS_WAIT(); asm volatile("" ::: "memory");
    int d0 = n0;
    if (mode == 1) { const int half = n0 >> 10, jj = n0 & 1023; d0 = (jj >> 7) * 256 + half * 128 + (jj & 127); }
    const int c = lane & 7;
#pragma unroll
    for (int j = 0; j < 4; ++j) { const int n = (lane >> 3) + 8 * j; const LAS float* s = scr + (8 * c) * 33 + n;
        u32x4 o; o.x = pk2(s[0 * 33], s[1 * 33]); o.y = pk2(s[2 * 33], s[3 * 33]); o.z = pk2(s[4 * 33], s[5 * 33]); o.w = pk2(s[6 * 33], s[7 * 33]);
        *(u32x4*)(WT + (size_t)(d0 + n) * K + k0 + 8 * c) = o; }
    LDS_WAIT(); asm volatile("" ::: "memory");
}

__device__ __forceinline__ void p0_transpose_item8(const float* W, int K, int N, unsigned char* WT, LAS float* scr, int item, int lane, int mode) {
    const int nblk = N / 32, kb = item / nblk, nb = item % nblk, k0 = 64 * kb, n0 = 32 * nb;
#pragma unroll 8
    for (int i = 0; i < 32; ++i) { const int kk = 2 * i + (lane >> 5); scr[kk * 33 + (lane & 31)] = W[(size_t)(k0 + kk) * N + n0 + (lane & 31)]; }
    LDS_WAIT(); asm volatile("" ::: "memory");
    int d0 = n0;
    if (mode == 1) { const int half = n0 >> 10, jj = n0 & 1023; d0 = (jj >> 7) * 256 + half * 128 + (jj & 127); }
    const int c = lane & 3;
#pragma unroll
    for (int j = 0; j < 2; ++j) { const int n = (lane >> 2) + 16 * j; const LAS float* sp = scr + (16 * c) * 33 + n;
        u32x4 o;
        o.x = pk4_fp8(sp[0 * 33] * 32.f, sp[1 * 33] * 32.f, sp[2 * 33] * 32.f, sp[3 * 33] * 32.f); o.y = pk4_fp8(sp[4 * 33] * 32.f, sp[5 * 33] * 32.f, sp[6 * 33] * 32.f, sp[7 * 33] * 32.f);
        o.z = pk4_fp8(sp[8 * 33] * 32.f, sp[9 * 33] * 32.f, sp[10 * 33] * 32.f, sp[11 * 33] * 32.f); o.w = pk4_fp8(sp[12 * 33] * 32.f, sp[13 * 33] * 32.f, sp[14 * 33] * 32.f, sp[15 * 33] * 32.f);
        *(u32x4*)(WT + (size_t)(d0 + n) * K + k0 + 16 * c) = o; }
    LDS_WAIT(); asm volatile("" ::: "memory");
}

__device__ __forceinline__ int t5_bucket(int rel) {
    const int n = rel < 0 ? -rel : rel; int b = rel > 0 ? 16 : 0;
    int large = 8 + (n >= 12) + (n >= 16) + (n >= 23) + (n >= 32) + (n >= 46) + (n >= 64) + (n >= 91);
    return b + (n < 8 ? n : large);
}

template <int CLS> __global__ void __launch_bounds__(NWAVES * 64, 2) fwd_kernel(Args args) {
    extern __shared__ __attribute__((aligned(16))) unsigned char lds_raw[];
    LAS unsigned char* lds = (LAS unsigned char*)lds_raw;
    volatile LAS unsigned* MISC = (volatile LAS unsigned*)(lds + MISC_OFF);
    const int tid = threadIdx.x, lane = tid & 63, wave = __builtin_amdgcn_readfirstlane(tid >> 6);
    const int G = gridDim.x, bx = blockIdx.x;
    const int gw = bx * NWAVES + wave, NGW = G * NWAVES;
    unsigned char* ws = args.ws;
    unsigned* ctl = (unsigned*)(ws + WS_CTL);
    const float* x = args.in[I_X];
    bf16_t* WinT = (bf16_t*)(ws + WS_WIN); bf16_t* WoutT = (bf16_t*)(ws + WS_WOUT); unsigned char* W1T = ws + WS_W1; unsigned char* W2T = ws + WS_W2; unsigned char* XN8 = ws + WS_XN8;
    bf16_t* METAKV = (bf16_t*)(ws + WS_METAKV); bf16_t* XN = (bf16_t*)(ws + WS_XN); bf16_t* PROJ = (bf16_t*)(ws + WS_PROJ); bf16_t* MIX = (bf16_t*)(ws + WS_MIX);
    float* TMP = (float*)(ws + WS_TMP); unsigned char* Y = ws + WS_Y; unsigned char* ACT = ws + WS_ACT;
    int* tok_e = (int*)(ws + WS_TOKE); float* tok_g = (float*)(ws + WS_TOKG); int* tok_lr = (int*)(ws + WS_TOKLR); int* cnt = (int*)(ws + WS_CNT);
    unsigned* rowtok = (unsigned*)(ws + WS_ROWTOK); int* rowsg = (int*)(ws + WS_ROWSG); int* tilee_hdr = (int*)(ws + WS_TILEE); unsigned char* tilee = (unsigned char*)(ws + WS_TILEE) + 64;
    bf16_t* H1 = (bf16_t*)(ws + WS_H1);

    if (tid < 32) MISC[tid] = 0u;
    __syncthreads();
#if ONE_LAUNCH
    XcdBarrier bar = xcd_barrier_post(ctl + CW_BAR, MISC + 8);
#define GRID_BAR() xcd_barrier(bar)
#else
#define GRID_BAR() do {} while (0)
#endif
    const int lo = args.ph_lo, hi = args.ph_hi;
#define INC(k, cls) ((CLS == -1 || CLS == (cls)) && lo <= (k) && (k) < hi)
#define IN(k) INC(k, k)
#define BOTH(k) (CLS == -1 && lo <= (k) && (k) + 1 < hi)

    if (IN(0)) {
        REP_BEGIN(0)
        int tid = threadIdx.x; asm volatile("" : "+v"(tid)); const int lane = tid & 63;
        LAS float* scr = (LAS float*)(lds + wave * 16384);
        constexpr int I_IN = 16 * 96, I_OUT = 16 * 32, I_1 = 16 * 64, I_2 = 16 * 32;
        constexpr int NITEMS = I_IN + I_OUT + NEXP * (I_1 + I_2);
        for (int it = gw; it < NITEMS; it += NGW) {
            int r = it;
            if (r < I_IN) { p0_transpose_item(args.in[I_WIN], D, DIN, WinT, scr, r, lane, 0); continue; } r -= I_IN;
            if (r < I_OUT) { p0_transpose_item(args.in[I_WOUT], D, D, WoutT, scr, r, lane, 0); continue; } r -= I_OUT;
            if (r < NEXP * I_1) { const int e = r / I_1; p0_transpose_item8(args.in[I_W1] + (size_t)e * D * 2048, D, 2048, W1T + (size_t)e * 2048 * D, scr, r % I_1, lane, 1); continue; } r -= NEXP * I_1;
            { const int e = r / I_2; p0_transpose_item8(args.in[I_W2] + (size_t)e * D * D, D, D, W2T + (size_t)e * D * D, scr, r % I_2, lane, 0); }
        }
        f32x4 gn[4];
#pragma unroll
        for (int j = 0; j < 4; ++j) gn[j] = ((const f32x4*)args.in[I_ANORM])[lane + 64 * j];
        for (int m = gw; m < T; m += NGW) rms_row_to_bf16(x + (size_t)m * D, gn, XN + (size_t)m * D, lane);
        __syncthreads();
        LAS float* xm = (LAS float*)lds;
        for (int rr = 0; rr < 2; ++rr) { const int m = wave * 2 + rr; const f32x4* xr = (const f32x4*)(args.in[I_META] + (size_t)m * D) + lane;
            f32x4 v[4]; float s = 0.f;
#pragma unroll
            for (int j = 0; j < 4; ++j) { v[j] = xr[64 * j]; s += (v[j].x * v[j].x + v[j].y * v[j].y) + (v[j].z * v[j].z + v[j].w * v[j].w); }
            const float r = 1.0f / sqrtf(wave_sum(s) * (1.f / D) + NORM_EPS);
#pragma unroll
            for (int j = 0; j < 4; ++j) { const f32x4 y = v[j] * r * gn[j]; *(LAS f32x4*)(xm + m * D + 4 * lane + 256 * j) = y; } }
        __syncthreads();
        for (int cb = bx; cb < 256; cb += G) {
            const int q0 = cb * 8; const int n0 = q0 < 1024 ? q0 + 512 : q0 + 1024;
            const int m = tid >> 5, kp = tid & 31; float a8[8];
#pragma unroll
            for (int c = 0; c < 8; ++c) a8[c] = 0.f;
            const float* win = args.in[I_WIN];
            for (int kk = 0; kk < 32; ++kk) { const int k = kk * 32 + kp; const float xv = xm[m * D + k];
                const f32x4 w0 = *(const f32x4*)(win + (size_t)k * DIN + n0), w1 = *(const f32x4*)(win + (size_t)k * DIN + n0 + 4);
                a8[0] += xv * w0.x; a8[1] += xv * w0.y; a8[2] += xv * w0.z; a8[3] += xv * w0.w; a8[4] += xv * w1.x; a8[5] += xv * w1.y; a8[6] += xv * w1.z; a8[7] += xv * w1.w; }
#pragma unroll
            for (int c = 0; c < 8; ++c) {
#pragma unroll
                for (int o = 1; o < 32; o <<= 1) a8[c] += __shfl_xor(a8[c], o); }
            if (kp == 0) { u32x4 w; w.x = pk2(a8[0], a8[1]); w.y = pk2(a8[2], a8[3]); w.z = pk2(a8[4], a8[5]); w.w = pk2(a8[6], a8[7]); *(u32x4*)(METAKV + (size_t)m * DIN + n0) = w; }
        }
        __syncthreads();
        REP_END(0)
        if (BOTH(0)) GRID_BAR();
    }

    if (IN(1)) {
        REP_BEGIN(1)
        pg8::Gemm g{XN, WinT, 0, nullptr}; pg8::StaticOrder S; S.init(T, DIN, G, bx);
        pg8::EpiProj E{PROJ};
        pg8::gemm_phase<pg8::EpiProj, pg8::StaticOrder, false, false>(lds, g, S, E, 0);
        REP_END(1)
        if (BOTH(1)) GRID_BAR();
    }

    if (IN(2)) {
        int tid = threadIdx.x; asm volatile("" : "+v"(tid)); const int lane = tid & 63;
        LAS float* btab = (LAS float*)(lds + GIDX_OFF + 2048);
        LAS float* lamp = (LAS float*)(lds + EXTRA_OFF);
        for (int i = tid; i < 1152; i += NWAVES * 64) { const int h = i / 288, idx = i % 288 - 96; const int rel = idx < 0 ? -128 : idx - 128; btab[i] = args.in[I_RELB][t5_bucket(rel) * 4 + h] * LOG2E; }
        if (wave == 0) { const float a = wave_sum(args.in[I_LQ1][lane] * args.in[I_LK1][lane]), b = wave_sum(args.in[I_LQ2][lane] * args.in[I_LK2][lane]); if (lane == 0) lamp[0] = expf(a) - expf(b) + LAMBDA_INIT; }
        __syncthreads();
        const float lam = lamp[0];
#if !NAIVE_SB
        REP_BEGIN(20)
        for (int vb = bx; vb < 256; vb += G) att::sb_head(lds, PROJ, METAKV, MIX, vb >> 3, vb & 7);
        REP_END(20)
#else
        for (int it = gw; it < BATCH * 8 * 32; it += NGW) {
            const int qb = it & 31, h = (it >> 5) & 7, b = it >> 8; const int r = qb * 64 + lane;
            const size_t rowq = (size_t)b * SEQ + r;
            unsigned q[32];
            { const u32x4* qp = (const u32x4*)(PROJ + rowq * DIN + COL_SBQ + h * 64);
#pragma unroll
              for (int i = 0; i < 8; ++i) { const u32x4 t4 = qp[i]; q[4 * i] = t4.x; q[4 * i + 1] = t4.y; q[4 * i + 2] = t4.z; q[4 * i + 3] = t4.w; } }
            float o[64];
#pragma unroll
            for (int d = 0; d < 64; ++d) o[d] = 0.f;
            float carry = 1.0f;
            const int jmax = qb * 64 + 62;
            for (int jj = jmax + 16; jj >= 0; --jj) {
                const bool meta = jj < 16; const int j = jj - 16;
                const bf16_t* krow = meta ? METAKV + (size_t)jj * DIN : PROJ + ((size_t)b * SEQ + j) * DIN;
                const u32x4* kp = (const u32x4*)(krow + COL_SBK + h * 64); const u32x4* vp = (const u32x4*)(krow + COL_SBV + h * 64);
                float z = 0.f;
#pragma unroll
                for (int i = 0; i < 8; ++i) { const u32x4 k4 = kp[i];
                    z += bf_lo(q[4 * i]) * bf_lo(k4.x) + bf_hi(q[4 * i]) * bf_hi(k4.x); z += bf_lo(q[4 * i + 1]) * bf_lo(k4.y) + bf_hi(q[4 * i + 1]) * bf_hi(k4.y);
                    z += bf_lo(q[4 * i + 2]) * bf_lo(k4.z) + bf_hi(q[4 * i + 2]) * bf_hi(k4.z); z += bf_lo(q[4 * i + 3]) * bf_lo(k4.w) + bf_hi(q[4 * i + 3]) * bf_hi(k4.w); }
                const float e = __builtin_amdgcn_exp2f(fminf(z, 100.f)); const float p = 1.0f / (1.0f + e);
                const bool vis = meta || (j < r);
                const float w = vis ? (1.0f - p) * carry : 0.f; carry = vis ? carry * p : carry;
#pragma unroll
                for (int i = 0; i < 8; ++i) { const u32x4 v4 = vp[i];
                    o[8 * i] += w * bf_lo(v4.x); o[8 * i + 1] += w * bf_hi(v4.x); o[8 * i + 2] += w * bf_lo(v4.y); o[8 * i + 3] += w * bf_hi(v4.y);
                    o[8 * i + 4] += w * bf_lo(v4.z); o[8 * i + 5] += w * bf_hi(v4.z); o[8 * i + 6] += w * bf_lo(v4.w); o[8 * i + 7] += w * bf_hi(v4.w); }
            }
            u32x4* op = (u32x4*)(MIX + rowq * D + h * 64);
#pragma unroll
            for (int i = 0; i < 8; ++i) { u32x4 w; w.x = pk2(o[8 * i], o[8 * i + 1]); w.y = pk2(o[8 * i + 2], o[8 * i + 3]); w.z = pk2(o[8 * i + 4], o[8 * i + 5]); w.w = pk2(o[8 * i + 6], o[8 * i + 7]); op[i] = w; }
        }
#endif
#if !NAIVE_DF
        __syncthreads();
        REP_BEGIN(21)
        for (int vb = bx; vb < 256; vb += G) { const int pairi = (vb >> 4) * 8 + (vb & 7), which = (vb >> 3) & 1;
            att::df_head(lds, (LAS float*)(lds + GIDX_OFF), btab, lam, args.in[I_SUBLN], PROJ, METAKV, MIX, pairi >> 2, pairi & 3, which); }
        REP_END(21)
#else
        for (int it = gw; it < BATCH * 4 * 32; it += NGW) {
            const int c = it & 31, hd = (it >> 5) & 3, b = it >> 7; const int r = c * 64 + lane;
            const size_t rowq = (size_t)b * SEQ + r;
            float* tmp = TMP + (rowq * 4 + hd) * 128;
            const int nreal = c * 64 + 64;
            for (int s = 0; s < 2; ++s) {
                const int gh = 2 * hd + s;
                unsigned q[32];
                { const u32x4* qp = (const u32x4*)(PROJ + rowq * DIN + COL_DFQ + gh * 64);
#pragma unroll
                  for (int i = 0; i < 8; ++i) { const u32x4 t4 = qp[i]; q[4 * i] = t4.x; q[4 * i + 1] = t4.y; q[4 * i + 2] = t4.z; q[4 * i + 3] = t4.w; } }
                float mx = -1e30f, l = 0.f, ss = 0.f;
                for (int pass = 0; pass < 3; ++pass) {
                    float o[64];
#pragma unroll
                    for (int d = 0; d < 64; ++d) o[d] = 0.f;
                    const float il = pass >= 1 ? 1.0f / l : 0.f; const int dh = pass == 2 ? 64 : 0;
                    for (int jj = 0; jj < nreal + 16; ++jj) {
                        const bool meta = jj < 16; const int j = jj - 16;
                        const bf16_t* krow = meta ? METAKV + (size_t)jj * DIN : PROJ + ((size_t)b * SEQ + j) * DIN;
                        const u32x4* kp = (const u32x4*)(krow + COL_DFK + gh * 64);
                        float z = 0.f;
#pragma unroll
                        for (int i = 0; i < 8; ++i) { const u32x4 k4 = kp[i];
                            z += bf_lo(q[4 * i]) * bf_lo(k4.x) + bf_hi(q[4 * i]) * bf_hi(k4.x); z += bf_lo(q[4 * i + 1]) * bf_lo(k4.y) + bf_hi(q[4 * i + 1]) * bf_hi(k4.y);
                            z += bf_lo(q[4 * i + 2]) * bf_lo(k4.z) + bf_hi(q[4 * i + 2]) * bf_hi(k4.z); z += bf_lo(q[4 * i + 3]) * bf_lo(k4.w) + bf_hi(q[4 * i + 3]) * bf_hi(k4.w); }
                        int rel = meta ? (jj - 16 - r) : (j - r); rel = rel < -128 ? -128 : rel;
                        z += btab[hd * 192 + rel + 128];
                        if (pass == 0) { const float mn = fmaxf(mx, z); l = l * __builtin_amdgcn_exp2f(mx - mn) + __builtin_amdgcn_exp2f(z - mn); mx = mn; }
                        else { const float w = __builtin_amdgcn_exp2f(z - mx) * il; const u32x4* vp = (const u32x4*)(krow + COL_DFV + hd * 128 + dh);
#pragma unroll
                            for (int i = 0; i < 8; ++i) { const u32x4 v4 = vp[i];
                                o[8 * i] += w * bf_lo(v4.x); o[8 * i + 1] += w * bf_hi(v4.x); o[8 * i + 2] += w * bf_lo(v4.y); o[8 * i + 3] += w * bf_hi(v4.y);
                                o[8 * i + 4] += w * bf_lo(v4.z); o[8 * i + 5] += w * bf_hi(v4.z); o[8 * i + 6] += w * bf_lo(v4.w); o[8 * i + 7] += w * bf_hi(v4.w); } }
                    }
                    if (pass >= 1) {
                        if (s == 0) {
#pragma unroll
                            for (int d = 0; d < 64; d += 4) *(f32x4*)(tmp + dh + d) = (f32x4){o[d], o[d + 1], o[d + 2], o[d + 3]};
                        } else {
#pragma unroll
                            for (int d = 0; d < 64; d += 4) { const f32x4 o0 = *(const f32x4*)(tmp + dh + d); f32x4 a; a.x = o0.x - lam * o[d]; a.y = o0.y - lam * o[d + 1]; a.z = o0.z - lam * o[d + 2]; a.w = o0.w - lam * o[d + 3];
                                ss += (a.x * a.x + a.y * a.y) + (a.z * a.z + a.w * a.w); *(f32x4*)(tmp + dh + d) = a; }
                        }
                    }
                }
                if (s == 1) {
                    const float rr = (1.0f - LAMBDA_INIT) / sqrtf(ss * (1.0f / 128.0f) + SUBLN_EPS);
                    const float* sg = args.in[I_SUBLN];
                    u32x4* op = (u32x4*)(MIX + rowq * D + 512 + hd * 128);
#pragma unroll 4
                    for (int i = 0; i < 16; ++i) { const f32x4 a0 = *(const f32x4*)(tmp + 8 * i), a1 = *(const f32x4*)(tmp + 8 * i + 4); const f32x4 g0 = *(const f32x4*)(sg + 8 * i), g1 = *(const f32x4*)(sg + 8 * i + 4);
                        u32x4 w; w.x = pk2(a0.x * rr * g0.x, a0.y * rr * g0.y); w.y = pk2(a0.z * rr * g0.z, a0.w * rr * g0.w); w.z = pk2(a1.x * rr * g1.x, a1.y * rr * g1.y); w.w = pk2(a1.z * rr * g1.z, a1.w * rr * g1.w); op[i] = w; }
                }
            }
        }
#endif
        if (BOTH(2)) GRID_BAR();
    }

    if (IN(3)) {
        REP_BEGIN(3)
        pg8::Gemm g{MIX, WoutT, 0, nullptr}; pg8::StaticOrder S; S.init(T, D, G, bx);
        pg8::EpiRes E{x, H1, (float*)(ws + WS_ROWSS)};
        pg8::gemm_phase<pg8::EpiRes, pg8::StaticOrder, false, false>(lds, g, S, E, 0);
        REP_END(3)
        if (BOTH(3)) GRID_BAR();
    }

    if (IN(4)) {
        REP_BEGIN(4)
        int tid = threadIdx.x; asm volatile("" : "+v"(tid)); const int lane = tid & 63, r32 = lane & 31, hi = lane >> 5; const bool hib = hi != 0;
        LAS bf16_t* wt = (LAS bf16_t*)lds;
        LAS float* gl = (LAS float*)(lds + 66048);
        LAS int* hist = (LAS int*)(lds + EXTRA_OFF);
        const float* wr_g = args.in[I_WR];
        for (int idx = tid; idx < 32 * 1024; idx += NWAVES * 64) wt[(idx & 31) * 1032 + (idx >> 5)] = (bf16_t)f2bf(wr_g[idx]);
        for (int idx = tid; idx < 1024; idx += NWAVES * 64) gl[idx] = args.in[I_FNORM][idx];
        const float* rowss = (const float*)(ws + WS_ROWSS);
        float bias[16];
#pragma unroll
        for (int r = 0; r < 16; ++r) bias[r] = args.in[I_BR][att::crow(r, hi)];
        for (int blk = bx; blk < 256; blk += G) {
            __syncthreads();
            if (tid < 32) hist[tid] = 0;
            __syncthreads();
            const int tok = blk * 256 + wave * 32 + r32;
            float rs;
            { const f32x4* sp = (const f32x4*)(rowss + (size_t)tok * 16); const f32x4 s0 = sp[0], s1 = sp[1], s2 = sp[2], s3 = sp[3];
              const float ssum = (((s0[0] + s0[1]) + (s0[2] + s0[3])) + ((s1[0] + s1[1]) + (s1[2] + s1[3]))) + (((s2[0] + s2[1]) + (s2[2] + s2[3])) + ((s3[0] + s3[1]) + (s3[2] + s3[3])));
              rs = 1.0f / sqrtf(ssum * (1.f / D) + NORM_EPS); }
            const bf16_t* xrow = H1 + (size_t)tok * D + 8 * hi;
            unsigned char* orow = XN8 + (size_t)tok * D + 8 * hi;
            const LAS bf16_t* wrow = wt + r32 * 1032 + 8 * hi;
            att::f32x16 acc = {};
#pragma unroll 1
            for (int sc = 0; sc < 8; ++sc) {
                f32x4 xv[16];
#pragma unroll
                for (int s8 = 0; s8 < 8; ++s8) { const u32x4 hb = *(const u32x4*)(xrow + (sc * 8 + s8) * 16);
                    xv[2 * s8] = (f32x4){bf_lo(hb.x), bf_hi(hb.x), bf_lo(hb.y), bf_hi(hb.y)}; xv[2 * s8 + 1] = (f32x4){bf_lo(hb.z), bf_hi(hb.z), bf_lo(hb.w), bf_hi(hb.w)}; }
#pragma unroll
                for (int s8 = 0; s8 < 8; ++s8) { const int sk = (sc * 8 + s8) * 16;
                    const f32x4 g0 = *(const LAS f32x4*)(gl + sk + 8 * hi), g1 = *(const LAS f32x4*)(gl + sk + 8 * hi + 4);
                    const f32x4 y0 = xv[2 * s8] * g0 * rs, y1 = xv[2 * s8 + 1] * g1 * rs;
                    u32x4 bw; bw.x = cvt_pk_bf16(y0[0], y0[1]); bw.y = cvt_pk_bf16(y0[2], y0[3]); bw.z = cvt_pk_bf16(y1[0], y1[1]); bw.w = cvt_pk_bf16(y1[2], y1[3]);
                    u32x2 o8; o8.x = pk4_fp8(y0[0], y0[1], y0[2], y0[3]); o8.y = pk4_fp8(y1[0], y1[1], y1[2], y1[3]);
                    *(u32x2*)(orow + sk) = o8;
                    const bf16x8 af = *(const LAS bf16x8*)(wrow + sk);
                    acc = __builtin_amdgcn_mfma_f32_32x32x16_bf16(af, __builtin_bit_cast(bf16x8, bw), acc, 0, 0, 0); }
            }
            float v[16];
#pragma unroll
            for (int r = 0; r < 16; ++r) v[r] = acc[r] + bias[r];
            float cv[8]; int ce[8];
#pragma unroll
            for (int k = 0; k < 4; ++k) { float m = v[0]; int mi = 0;
#pragma unroll
                for (int r = 1; r < 16; ++r) { const bool c = v[r] > m; m = c ? v[r] : m; mi = c ? r : mi; }
#pragma unroll
                for (int r = 0; r < 16; ++r) v[r] = (r == mi) ? -3.0e38f : v[r];
                cv[k] = m; ce[k] = (mi & 3) + 8 * (mi >> 2) + 4 * hi; }
#pragma unroll
            for (int k = 0; k < 4; ++k) { cv[4 + k] = att::partner32(cv[k], hib); ce[4 + k] = __builtin_bit_cast(int, att::partner32(__builtin_bit_cast(float, ce[k]), hib)); }
            float tv[4]; int te4[4];
#pragma unroll
            for (int k = 0; k < 4; ++k) { float m = cv[0]; int mi = 0, me = ce[0];
#pragma unroll
                for (int c8 = 1; c8 < 8; ++c8) { const bool c = cv[c8] > m || (cv[c8] == m && ce[c8] < me); m = c ? cv[c8] : m; mi = c ? c8 : mi; me = c ? ce[c8] : me; }
                tv[k] = m; te4[k] = me;
#pragma unroll
                for (int c8 = 0; c8 < 8; ++c8) cv[c8] = (c8 == mi) ? -3.0e38f : cv[c8]; }
            const float e1 = __expf(tv[1] - tv[0]), e2 = __expf(tv[2] - tv[0]), e3 = __expf(tv[3] - tv[0]); const float inv = 1.0f / (((1.0f + e1) + e2) + e3);
            if (!hib) {
                { const int lr = atomicAdd((int*)(hist + te4[0]), 1); tok_e[tok * 4 + 0] = te4[0]; tok_g[tok * 4 + 0] = inv; tok_lr[tok * 4 + 0] = lr; }
                { const int lr = atomicAdd((int*)(hist + te4[1]), 1); tok_e[tok * 4 + 1] = te4[1]; tok_g[tok * 4 + 1] = e1 * inv; tok_lr[tok * 4 + 1] = lr; }
                { const int lr = atomicAdd((int*)(hist + te4[2]), 1); tok_e[tok * 4 + 2] = te4[2]; tok_g[tok * 4 + 2] = e2 * inv; tok_lr[tok * 4 + 2] = lr; }
                { const int lr = atomicAdd((int*)(hist + te4[3]), 1); tok_e[tok * 4 + 3] = te4[3]; tok_g[tok * 4 + 3] = e3 * inv; tok_lr[tok * 4 + 3] = lr; } }
            __syncthreads();
            if (tid < 32) cnt[blk * 32 + tid] = hist[tid];
        }
        __syncthreads();
        REP_END(4)
        if (BOTH(4)) GRID_BAR();
    }

    if (IN(5)) {
        int tid = threadIdx.x; asm volatile("" : "+v"(tid)); const int lane = tid & 63;
        LAS int* tot = (LAS int*)(lds + EXTRA_OFF); LAS int* tstart = tot + 32; LAS int* pref = tstart + 40;
        if (tid < 32) { int s = 0; for (int w = 0; w < 256; ++w) s += cnt[w * 32 + tid]; tot[tid] = s; }
        __syncthreads();
        if (tid == 0) { int a = 0; for (int e = 0; e < 32; ++e) { tstart[e] = a; a += (tot[e] + 255) >> 8; } tstart[32] = a; }
        __syncthreads();
        for (int blk = bx; blk < 256; blk += G) {
            if (tid < 32) { int s = 0; for (int w = 0; w < blk; ++w) s += cnt[w * 32 + tid]; pref[tid] = s; }
            __syncthreads();
            for (int a = tid; a < 1024; a += NWAVES * 64) { const int idx = blk * 1024 + a; const int e = tok_e[idx]; const int pos = tstart[e] * 256 + pref[e] + tok_lr[idx];
                rowtok[pos] = (unsigned)(idx >> 2); rowsg[2 * pos] = idx; rowsg[2 * pos + 1] = __builtin_bit_cast(int, tok_g[idx]); }
            __syncthreads();
        }
        for (int e = bx; e < 32; e += G)
            for (int p = tstart[e] * 256 + tot[e] + tid; p < tstart[e + 1] * 256; p += NWAVES * 64) { rowtok[p] = 0u; rowsg[2 * p] = -1; rowsg[2 * p + 1] = 0; }
        if (bx == 0) { if (tid < 32) for (int tl = tstart[tid]; tl < tstart[tid + 1]; ++tl) tilee[tl] = (unsigned char)tid; if (tid == 0) tilee_hdr[0] = tstart[32]; }
        __syncthreads();
        if (BOTH(5)) GRID_BAR();
    }

    if (IN(6)) {
        REP_BEGIN(6)
        int tid = threadIdx.x; asm volatile("" : "+v"(tid)); const int lane = tid & 63;
        const int NTl = tilee_hdr[0];
        LAS unsigned char* te = lds + TE_OFF; LAS unsigned short* gidx = (LAS unsigned short*)(lds + GIDX_OFF);
        for (int i = tid; i < MAXTILES; i += NWAVES * 64) te[i] = i < NTl ? tilee[i] : (unsigned char)0;
        __syncthreads();
        pg8::GroupedOrder S; S.init(NTl, 8, G, bx, 0, te);
        for (int i = 0; i < MAXSLOTS; ++i) { pg8::Unit u; if (S.next(i, u)) { if (tid < 256) gidx[i * 256 + tid] = (unsigned short)rowtok[u.pm * 256 + tid]; } }
        __syncthreads();
        pg8::Gemm g{XN8, W1T, (size_t)2048 * D, gidx};
        pg8::EpiSwiglu E{ACT, args.in[I_B1]};
        pg8::gemm_phase<pg8::EpiSwiglu, pg8::GroupedOrder, true, true>(lds, g, S, E, 0);
        REP_END(6)
        if (BOTH(6)) GRID_BAR();
    }
    if (IN(7)) {
        REP_BEGIN(7)
        int tid = threadIdx.x; asm volatile("" : "+v"(tid)); const int lane = tid & 63;
        const int NTl = tilee_hdr[0];
        LAS unsigned char* te = lds + TE_OFF;
        __syncthreads();
        for (int i = tid; i < MAXTILES; i += NWAVES * 64) te[i] = i < NTl ? tilee[i] : (unsigned char)0;
        __syncthreads();
        pg8::GroupedOrder S; S.init(NTl, 4, G, bx, 0, te, true);
        pg8::Gemm g{ACT, W2T, (size_t)D * D, nullptr};
        pg8::EpiDown E{Y, args.in[I_B2], rowsg, ws + WS_DUMP};
        pg8::gemm_phase<pg8::EpiDown, pg8::GroupedOrder, false, true>(lds, g, S, E, 0);
        REP_END(7)
        if (BOTH(7)) GRID_BAR();
    }

    if (IN(8)) {
        int tid = threadIdx.x; asm volatile("" : "+v"(tid)); const int lane = tid & 63;
        f32x4 gn[4];
#pragma unroll
        for (int j = 0; j < 4; ++j) gn[j] = ((const f32x4*)args.in[I_FINAL])[lane + 64 * j];
        for (int tok = gw; tok < T; tok += NGW) {
            f32x4* hp = (f32x4*)(args.out + (size_t)tok * D) + lane; const u32x2* hb = (const u32x2*)(H1 + (size_t)tok * D) + lane; f32x4 v[4]; float s = 0.f;
#pragma unroll
            for (int j = 0; j < 4; ++j) { const u32x2 h2 = hb[64 * j]; v[j] = (f32x4){bf_lo(h2.x), bf_hi(h2.x), bf_lo(h2.y), bf_hi(h2.y)}; }
#pragma unroll
            for (int k = 0; k < 4; ++k) { const unsigned* yp = (const unsigned*)(Y + ((size_t)tok * 4 + k) * D) + lane;
#pragma unroll
                for (int j = 0; j < 4; ++j) { const int y4 = (int)yp[64 * j]; v[j].x += __builtin_amdgcn_cvt_f32_fp8(y4, 0); v[j].y += __builtin_amdgcn_cvt_f32_fp8(y4, 1); v[j].z += __builtin_amdgcn_cvt_f32_fp8(y4, 2); v[j].w += __builtin_amdgcn_cvt_f32_fp8(y4, 3); } }
#pragma unroll
            for (int j = 0; j < 4; ++j) s += (v[j].x * v[j].x + v[j].y * v[j].y) + (v[j].z * v[j].z + v[j].w * v[j].w);
            const float r = 1.0f / sqrtf(wave_sum(s) * (1.f / D) + NORM_EPS);
#pragma unroll
            for (int j = 0; j < 4; ++j) hp[64 * j] = v[j] * r * gn[j];
        }
    }
#undef IN
#undef INC
#undef BOTH
}

#if ONE_LAUNCH
constexpr int NKERN = 1;
static const void* kern_of(int) { return (const void*)fwd_kernel<-1>; }
#else
constexpr int NKERN = 9;
static const void* kern_of(int c) {
    switch (c) { case 0: return (const void*)fwd_kernel<0>; case 1: return (const void*)fwd_kernel<1>; case 2: return (const void*)fwd_kernel<2>; case 3: return (const void*)fwd_kernel<3>; case 4: return (const void*)fwd_kernel<4>;
        case 5: return (const void*)fwd_kernel<5>; case 6: return (const void*)fwd_kernel<6>; case 7: return (const void*)fwd_kernel<7>; default: return (const void*)fwd_kernel<8>; }
}
#endif
extern "C" void kernel_launch(void* const* d_in, const int* in_sizes, int n_in, void* d_out, int out_size, void* d_ws, size_t ws_size, hipStream_t stream) {
    static int grid = 0;
    if (grid == 0) {
        if (n_in != 19 || out_size != T * D || ws_size < WS_END) { fprintf(stderr, "kernel_launch: unexpected shapes (n_in %d, out %d, ws %zu)\n", n_in, out_size, ws_size); grid = -1; return; }
        for (int c = 0; c < NKERN; ++c) if (hipFuncSetAttribute(kern_of(c), hipFuncAttributeMaxDynamicSharedMemorySize, LDS_BYTES) != hipSuccess) { fprintf(stderr, "kernel_launch: hipFuncSetAttribute failed\n"); grid = -1; return; }
        int dev = 0, cus = 0, per_cu = 0;
        (void)hipGetDevice(&dev); (void)hipDeviceGetAttribute(&cus, hipDeviceAttributeMultiprocessorCount, dev);
        (void)hipOccupancyMaxActiveBlocksPerMultiprocessor(&per_cu, kern_of(0), NWAVES * 64, LDS_BYTES);
        (void)hipGetLastError();
        grid = cus > 0 ? cus : 256;
        if (grid > 256) grid = 256;
    }
    if (grid < 0) return;
    (void)hipMemsetAsync((char*)d_ws + WS_CTL, 0, CTL_ZERO_BYTES, stream);
    Args a{};
    for (int i = 0; i < 19; ++i) a.in[i] = (const float*)d_in[i];
    a.out = (float*)d_out; a.ws = (unsigned char*)d_ws;
    constexpr int NPH = 9;
#if ONE_LAUNCH
    a.ph_lo = 0; a.ph_hi = NPH;
    hipLaunchKernelGGL(fwd_kernel<-1>, dim3(grid), dim3(NWAVES * 64), LDS_BYTES, stream, a);
#else
    for (int p = 0; p < NPH; ++p) { a.ph_lo = p; a.ph_hi = p + 1; const int cls = p; void* kargs[] = {&a};
        (void)hipLaunchKernel(kern_of(cls), dim3(grid), dim3(NWAVES * 64), kargs, LDS_BYTES, stream); }
#endif
}
```

```cpp
#include <hip/hip_runtime.h>
#include <cstdio>
#include <cstdint>

#ifndef ONE_LAUNCH
#define ONE_LAUNCH 1
#endif
#ifndef REP_PHASE
#define REP_PHASE -1
#endif
#define REP_COUNT 3
#define NREP(k) ((REP_PHASE == (k)) ? REP_COUNT : 1)
#define REP_BEGIN(k) for (int rep_ = 0; rep_ < NREP(k); ++rep_) {
#define REP_END(k) if (rep_ + 1 < NREP(k)) GRID_BAR(); }

#define LAS __attribute__((address_space(3)))
#define GAS __attribute__((address_space(1)))
typedef unsigned short bf16_t;
typedef short bf16x8 __attribute__((ext_vector_type(8)));
typedef float f32x4 __attribute__((ext_vector_type(4)));
typedef float f32x2 __attribute__((ext_vector_type(2)));
typedef unsigned u32x4 __attribute__((ext_vector_type(4)));
typedef unsigned u32x2 __attribute__((ext_vector_type(2)));

constexpr int D = 1024, BATCH = 32, SEQ = 2048, T = BATCH * SEQ, NMETA = 16, DIN = 3072, NEXP = 32, TOPK = 4;
constexpr int COL_SBQ = 0, COL_SBK = 512, COL_SBV = 1024, COL_DFQ = 1536, COL_DFK = 2048, COL_DFV = 2560;
constexpr int MAXTILES = 1024 + 32, MAXSLOTS = 33;
constexpr float LOG2E = 1.4426950408889634f;
constexpr float C2 = 0.125f * LOG2E;
constexpr float NORM_EPS = 1e-6f, SUBLN_EPS = 1e-5f, LAMBDA_INIT = 0.2f;
constexpr int NWAVES = 8;

constexpr size_t MiB = 1u << 20;
constexpr size_t WS_CTL = 0, CTL_ZERO_BYTES = 32768;
constexpr size_t WS_WIN = 2 * MiB;
constexpr size_t WS_WOUT = 8 * MiB;
constexpr size_t WS_W1 = 10 * MiB;
constexpr size_t WS_W2 = 74 * MiB;
constexpr size_t WS_SMALL = 106 * MiB;
constexpr size_t WS_METAKV = WS_SMALL;
constexpr size_t WS_TOKE = WS_SMALL + 1 * MiB;
constexpr size_t WS_TOKG = WS_SMALL + 2 * MiB;
constexpr size_t WS_TOKLR = WS_SMALL + 3 * MiB;
constexpr size_t WS_CNT = WS_SMALL + 4 * MiB;
constexpr size_t WS_ROWTOK = WS_SMALL + 5 * MiB;
constexpr size_t WS_ROWSG = WS_SMALL + 7 * MiB;
constexpr size_t WS_TILEE = WS_SMALL + 10 * MiB;
constexpr size_t WS_DUMP = WS_SMALL + 11 * MiB;
constexpr size_t WS_ROWSS = WS_SMALL + 12 * MiB;
constexpr size_t WS_XN8 = 122 * MiB;
constexpr size_t WS_Y = 186 * MiB;
constexpr size_t WS_PROJ = WS_Y;
constexpr size_t WS_MIX = WS_Y + 384 * MiB;
constexpr size_t WS_H1 = 442 * MiB;
constexpr size_t WS_ACT = 698 * MiB;
constexpr size_t WS_XN = WS_ACT;
constexpr size_t WS_END = 962 * MiB;
constexpr int CW_BAR = 4096;

constexpr int RING_BYTES = 131072;
constexpr int GIDX_OFF = RING_BYTES;
constexpr int TE_OFF = GIDX_OFF + 16896;
constexpr int EXTRA_OFF = TE_OFF + 1088;
constexpr int MISC_OFF = EXTRA_OFF + 4096;
constexpr int LDS_BYTES = 155648;
static_assert(MISC_OFF + 128 <= LDS_BYTES, "LDS map");

#define LDS_WAIT() asm volatile("s_waitcnt lgkmcnt(0)" ::: "memory")
#define VM_WAIT() asm volatile("s_waitcnt vmcnt(0)" ::: "memory")
__device__ __forceinline__ unsigned f2bf(float f) { unsigned u = __builtin_bit_cast(unsigned, f); return (u + 0x7fffu + ((u >> 16) & 1u)) >> 16; }
__device__ __forceinline__ unsigned pk2(float lo, float hi) { return f2bf(lo) | (f2bf(hi) << 16); }
__device__ __forceinline__ float bf_lo(unsigned u) { return __builtin_bit_cast(float, u << 16); }
__device__ __forceinline__ float bf_hi(unsigned u) { return __builtin_bit_cast(float, u & 0xffff0000u); }
__device__ __forceinline__ unsigned cvt_pk_bf16(float lo, float hi) { unsigned r; asm volatile("v_cvt_pk_bf16_f32 %0, %1, %2" : "=v"(r) : "v"(lo), "v"(hi)); return r; }
__device__ __forceinline__ unsigned pk4_fp8(float a, float b, float c, float d) { int w = __builtin_amdgcn_cvt_pk_fp8_f32(a, b, 0, false); w = __builtin_amdgcn_cvt_pk_fp8_f32(c, d, w, true); return (unsigned)w; }
__device__ __forceinline__ void swap16(unsigned& a, unsigned& b) { auto rr = __builtin_amdgcn_permlane16_swap(a, b, false, false); a = rr[0]; b = rr[1]; }
template <int CTRL> __device__ __forceinline__ float dpp_f(float x) { return __builtin_bit_cast(float, __builtin_amdgcn_update_dpp(0, __builtin_bit_cast(int, x), CTRL, 0xf, 0xf, true)); }
__device__ __forceinline__ float allsum32(float x) {
    x += dpp_f<0xB1>(x); x += dpp_f<0x4E>(x); x += dpp_f<0x141>(x); x += dpp_f<0x140>(x);
    unsigned a = __float_as_uint(x), b = a; swap16(a, b); return __uint_as_float(a) + __uint_as_float(b);
}
__device__ __forceinline__ float wave_sum(float v) {
    v = allsum32(v);
    auto rr = __builtin_amdgcn_permlane32_swap(__float_as_uint(v), __float_as_uint(v), false, false);
    return __uint_as_float(rr[0]) + __uint_as_float(rr[1]);
}

namespace pg8 {
constexpr int BM = 256, BK = 64, HALF = 128, HTB = HALF * BK * 2, STAGE_BYTES = 8 * HTB, NXCD = 8, WGM = 8, K = 1024, NT_K = K / BK;
__host__ __device__ __forceinline__ int swz8(int r) { const int h = (r >> 1) & 7; return h ^ ((h & 2) << 1); }
__host__ __device__ __forceinline__ int lds_off(int r, int chunk) { return r * 128 + ((chunk ^ swz8(r)) << 4); }
__host__ __device__ __forceinline__ void stage_rc(int b, int& R, int& CB) { R = b >> 7; CB = (((b >> 4) & 7) ^ swz8(R)) << 4; }
__host__ __device__ __forceinline__ int perm32(int rho) { const int n = rho >> 4, i = rho & 15; return 8 * (i >> 2) + 4 * n + (i & 3); }

struct Unit { int pm, pn, e; };
struct Gemm { const void* A; const void* Bt; size_t estride; const LAS unsigned short* gidx; };

struct StaticOrder {
    int nM, nN, nwg, G, c;
    __device__ void init(int M, int N, int G_, int c_) { nM = M / BM; nN = N / BM; nwg = nM * nN; G = G_; c = c_; }
    __device__ bool next(int i, Unit& u) const {
        const long L = (long)i * G + c; if (L >= nwg) return false;
        int wgid = (int)L; { const int q = nwg / NXCD, r = nwg % NXCD, xcd = wgid % NXCD, off = wgid / NXCD; wgid = (xcd < r ? xcd * (q + 1) : r * (q + 1) + (xcd - r) * q) + off; }
        const int nig = WGM * nN, gid = wgid / nig, fm = gid * WGM, gsz = (nM - fm) < WGM ? (nM - fm) : WGM;
        u.pm = fm + ((wgid % nig) % gsz); u.pn = (wgid % nig) / gsz; u.e = 0; return true;
    }
};
struct GroupedOrder {
    int nM, nN, nwg, G, c, tile0; const LAS unsigned char* te; bool rev;
    __device__ void init(int ntiles, int nN_, int G_, int c_, int tile0_, const LAS unsigned char* te_, bool rev_ = false) { nM = ntiles; nN = nN_; nwg = nM * nN; G = G_; c = c_; tile0 = tile0_; te = te_; rev = rev_; }
    __device__ bool next(int i, Unit& u) const {
        const long L = (long)i * G + c; if (L >= nwg) return false;
        int wgid = (int)L; { const int q = nwg / NXCD, r = nwg % NXCD, xcd = wgid % NXCD, off = wgid / NXCD; wgid = (xcd < r ? xcd * (q + 1) : r * (q + 1) + (xcd - r) * q) + off; }
        if (rev) wgid = nwg - 1 - wgid;
        const int nig = WGM * nN, gid = wgid / nig, fm = gid * WGM, gsz = (nM - fm) < WGM ? (nM - fm) : WGM;
        u.pm = tile0 + fm + ((wgid % nig) % gsz); u.pn = (wgid % nig) / gsz; u.e = __builtin_amdgcn_readfirstlane((int)te[u.pm]); return true;
    }
};

struct NoPre {};
struct EpiProj {
    static constexpr bool PERM = true;
    using Pre = NoPre; static constexpr bool HAS_PRE = false;
    bf16_t* O;
    __device__ __forceinline__ void operator()(const f32x4 (&acc)[2][2][4][2], const Unit& u, int wr, int wc, int fr, int fq, const Pre& pre) const {
        const int row0 = u.pm * BM + wr * 64 + fr; const int col0 = u.pn * BM + wc * 32 + 8 * fq;
        const float sc = (u.pn < 2 || u.pn == 6 || u.pn == 7) ? C2 : 1.0f;
#pragma unroll
        for (int ai = 0; ai < 2; ++ai)
#pragma unroll
            for (int m = 0; m < 4; ++m) { bf16_t* rowp = O + (size_t)(row0 + ai * HALF + m * 16) * DIN + col0;
#pragma unroll
                for (int bj = 0; bj < 2; ++bj) { const f32x4 v0 = acc[ai][bj][m][0] * sc, v1 = acc[ai][bj][m][1] * sc;
                    u32x4 w; w.x = cvt_pk_bf16(v0[0], v0[1]); w.y = cvt_pk_bf16(v0[2], v0[3]); w.z = cvt_pk_bf16(v1[0], v1[1]); w.w = cvt_pk_bf16(v1[2], v1[3]);
                    *(u32x4*)(rowp + bj * HALF) = w; } }
    }
};
struct EpiRes {
    static constexpr bool PERM = true;
    using Pre = NoPre; static constexpr bool HAS_PRE = false;
    const float* base; bf16_t* out; float* rowss;
    __device__ __forceinline__ void operator()(const f32x4 (&acc)[2][2][4][2], const Unit& u, int wr, int wc, int fr, int fq, const Pre& pre) const {
        const int col0 = u.pn * BM + wc * 32 + 8 * fq;
#pragma unroll
        for (int ai = 0; ai < 2; ++ai) {
            f32x4 rs[4][2][2];
#pragma unroll
            for (int m = 0; m < 4; ++m) { const float* rp = base + (size_t)(u.pm * BM + ai * HALF + wr * 64 + m * 16 + fr) * D + col0;
#pragma unroll
                for (int bj = 0; bj < 2; ++bj) { rs[m][bj][0] = *(const f32x4*)(rp + bj * HALF); rs[m][bj][1] = *(const f32x4*)(rp + bj * HALF + 4); } }
#pragma unroll
            for (int m = 0; m < 4; ++m) { const int row = u.pm * BM + ai * HALF + wr * 64 + m * 16 + fr; bf16_t* op = out + (size_t)row * D + col0; float ss = 0.f;
#pragma unroll
                for (int bj = 0; bj < 2; ++bj) { const f32x4 v0 = rs[m][bj][0] + acc[ai][bj][m][0], v1 = rs[m][bj][1] + acc[ai][bj][m][1];
                    u32x4 w; w.x = cvt_pk_bf16(v0[0], v0[1]); w.y = cvt_pk_bf16(v0[2], v0[3]); w.z = cvt_pk_bf16(v1[0], v1[1]); w.w = cvt_pk_bf16(v1[2], v1[3]);
                    *(u32x4*)(op + bj * HALF) = w;
                    ss += ((v0[0] * v0[0] + v0[1] * v0[1]) + (v0[2] * v0[2] + v0[3] * v0[3])) + ((v1[0] * v1[0] + v1[1] * v1[1]) + (v1[2] * v1[2] + v1[3] * v1[3])); }
                { unsigned a = __float_as_uint(ss), b2 = a; swap16(a, b2); ss = __uint_as_float(a) + __uint_as_float(b2);
                  auto rr = __builtin_amdgcn_permlane32_swap(__float_as_uint(ss), __float_as_uint(ss), false, false); ss = __uint_as_float(rr[0]) + __uint_as_float(rr[1]); }
                if (fq == 0) rowss[(size_t)row * 16 + u.pn * 4 + wc] = ss; }
            asm volatile("" ::: "memory");
        }
    }
};
struct EpiSwiglu {
    static constexpr bool PERM = true;
    struct Pre { f32x4 g[2], l[2]; }; static constexpr bool HAS_PRE = true;
    __device__ __forceinline__ void prefetch(Pre& pre, const Unit& u, int wc, int fq) const {
        const int lc = u.pn * HALF + wc * 32 + 8 * fq; const float* bg = b1 + (size_t)u.e * 2048 + lc; const float* bl = bg + 1024;
        asm volatile("global_load_dwordx4 %0, %4, off\n\tglobal_load_dwordx4 %1, %4, off offset:16\n\tglobal_load_dwordx4 %2, %5, off\n\tglobal_load_dwordx4 %3, %5, off offset:16"
                     : "=&v"(pre.g[0]), "=&v"(pre.g[1]), "=&v"(pre.l[0]), "=&v"(pre.l[1]) : "v"(bg), "v"(bl) : "memory"); }
    __device__ __forceinline__ void landed(Pre& pre) const { asm volatile("" : "+v"(pre.g[0]), "+v"(pre.g[1]), "+v"(pre.l[0]), "+v"(pre.l[1])); }
    unsigned char* act; const float* b1;
    __device__ __forceinline__ void operator()(const f32x4 (&acc)[2][2][4][2], const Unit& u, int wr, int wc, int fr, int fq, const Pre& pre) const {
        const int row0 = u.pm * BM + wr * 64 + fr; const int lc = u.pn * HALF + wc * 32 + 8 * fq;
        constexpr float CS = 1.702f * LOG2E, ICS = 1.0f / CS;
        f32x4 bgv[2], blv[2];
#pragma unroll
        for (int n = 0; n < 2; ++n) { bgv[n] = pre.g[n] * CS; blv[n] = (pre.l[n] + 1.0f) * ICS; }
        unsigned char* const sp = act + (size_t)(row0 + (fq & 1) * 16) * D + (lc - (fq & 1) * 8);
#pragma unroll
        for (int ai = 0; ai < 2; ++ai)
#pragma unroll
            for (int mp = 0; mp < 2; ++mp) { unsigned wx[2], wy[2];
#pragma unroll
                for (int mm = 0; mm < 2; ++mm) { const int m = 2 * mp + mm; float r[8];
#pragma unroll
                    for (int n = 0; n < 2; ++n)
#pragma unroll
                        for (int x = 0; x < 4; ++x) { float g = acc[ai][0][m][n][x] * (CS / 32.0f) + bgv[n][x], l = acc[ai][1][m][n][x] * (ICS / 32.0f) + blv[n][x];
                            g = fminf(g, 7.0f * CS); l = fminf(fmaxf(l, -6.0f * ICS), 8.0f * ICS);
                            const float sg = __builtin_amdgcn_rcpf(1.0f + __builtin_amdgcn_exp2f(-g));
                            r[n * 4 + x] = g * sg * l; }
                    wx[mm] = pk4_fp8(r[0], r[1], r[2], r[3]); wy[mm] = pk4_fp8(r[4], r[5], r[6], r[7]); }
                swap16(wx[0], wx[1]); swap16(wy[0], wy[1]);
                u32x4 o; o.x = wx[0]; o.y = wy[0]; o.z = wx[1]; o.w = wy[1];
                *(u32x4*)(sp + (size_t)(ai * HALF + mp * 32) * D) = o; }
    }
};
struct EpiDown {
    static constexpr bool PERM = true;
    using Pre = NoPre; static constexpr bool HAS_PRE = false;
    unsigned char* Y; const float* b2; const int* rowsg; unsigned char* dump;
    __device__ __forceinline__ void operator()(const f32x4 (&acc)[2][2][4][2], const Unit& u, int wr, int wc, int fr, int fq, const Pre& pre) const {
        const int col0 = u.pn * BM + wc * 32 + 8 * fq;
        f32x4 bv[2][2];
#pragma unroll
        for (int bj = 0; bj < 2; ++bj)
#pragma unroll
            for (int n = 0; n < 2; ++n) bv[bj][n] = *(const f32x4*)(b2 + (size_t)u.e * D + col0 + bj * HALF + 4 * n);
        int slotv[8]; float gtv[8];
#pragma unroll
        for (int ai = 0; ai < 2; ++ai)
#pragma unroll
            for (int m = 0; m < 4; ++m) { const int arow = u.pm * BM + ai * HALF + wr * 64 + m * 16 + fr; slotv[ai * 4 + m] = rowsg[2 * arow]; gtv[ai * 4 + m] = __builtin_bit_cast(float, rowsg[2 * arow + 1]); }
#pragma unroll
        for (int i = 0; i < 8; ++i) asm volatile("" : "+v"(slotv[i]), "+v"(gtv[i]));
        const bool odd = (fq & 1) != 0; const int cs = col0 - (odd ? 8 : 0);
#pragma unroll
        for (int ai = 0; ai < 2; ++ai)
#pragma unroll
            for (int mp = 0; mp < 2; ++mp) {
                const int slot = odd ? slotv[ai * 4 + 2 * mp + 1] : slotv[ai * 4 + 2 * mp];
                unsigned char* rowp = (slot >= 0 ? Y + (size_t)slot * D : dump) + cs;
#pragma unroll
                for (int bj = 0; bj < 2; ++bj) { unsigned wx[2], wy[2];
#pragma unroll
                    for (int mm = 0; mm < 2; ++mm) { const int m = 2 * mp + mm; const float gt = gtv[ai * 4 + m];
                        const f32x4 v0 = (acc[ai][bj][m][0] * (1.0f / 32.0f) + bv[bj][0]) * gt, v1 = (acc[ai][bj][m][1] * (1.0f / 32.0f) + bv[bj][1]) * gt;
                        wx[mm] = pk4_fp8(v0[0], v0[1], v0[2], v0[3]); wy[mm] = pk4_fp8(v1[0], v1[1], v1[2], v1[3]); }
                    swap16(wx[0], wx[1]); swap16(wy[0], wy[1]);
                    u32x4 o; o.x = wx[0]; o.y = wy[0]; o.z = wx[1]; o.w = wy[1];
                    *(u32x4*)(rowp + bj * HALF) = o; }
                asm volatile("" ::: "memory"); }
    }
};

typedef int i32x8 __attribute__((ext_vector_type(8)));
typedef int i32x4 __attribute__((ext_vector_type(4)));
template <bool FP8> struct FragT { typedef bf16x8 A[4][2]; typedef bf16x8 B[2][2]; };
template <> struct FragT<true> { typedef i32x8 A[4]; typedef i32x8 B[2]; };
template <class Epi, class Sched, bool GATHER, bool FP8>
__device__ __forceinline__ void gemm_phase(LAS unsigned char* lds, const Gemm g, const Sched& S, const Epi& E, int tileA0) {
    int tid = threadIdx.x; asm volatile("" : "+v"(tid));
    const int wid = __builtin_amdgcn_readfirstlane(tid >> 6), lane = tid & 63, wr = wid >> 2, wc = wid & 3, fr = lane & 15, fq = lane >> 4;
    constexpr int KB = FP8 ? K : 2 * K;
    constexpr int nt = FP8 ? K / 128 : K / 64;
    unsigned cA[2], voffB[2]; int rA[2];
#pragma unroll
    for (int i = 0; i < 2; ++i) { int R, CB; stage_rc(tid * 16 + i * 8192, R, CB); const int Rb = Epi::PERM ? ((R & ~31) + perm32(R & 31)) : R;
        cA[i] = (unsigned)CB; rA[i] = R; voffB[i] = (unsigned)(Rb * KB + CB); }
    constexpr size_t kstep = 128;
    constexpr size_t hstep = (size_t)HALF * KB;
    constexpr size_t tstep = 2 * hstep;
    const unsigned ldsw = (unsigned)wid * 1024u;
    const int aoff = lds_off(wr * 64 + fr, FP8 ? 2 * fq : fq), boff = lds_off(wc * 32 + fr, FP8 ? 2 * fq : fq);
    const int aoff1 = aoff ^ (FP8 ? 16 : 64), boff1 = boff ^ (FP8 ? 16 : 64);
#define PG8_SA(b, h) (((b) * 2 + (h)) * HTB)
#define PG8_SB(b, h) ((4 + (b) * 2 + (h)) * HTB)
#define PG8_STAGE(bufoff, gbase, voff) do { _Pragma("unroll") for (int _i = 0; _i < 2; ++_i) \
        __builtin_amdgcn_global_load_lds((const unsigned*)((const char*)(gbase) + (voff)[_i]), (LAS unsigned*)(lds + (bufoff) + ldsw + _i * 8192), 16, 0, 0); } while (0)
#define PG8_LDA(dst, b, h) do { if constexpr (FP8) { _Pragma("unroll") for (int m = 0; m < 4; ++m) { dst[m].lo = *(const LAS i32x4*)(lds + PG8_SA(b, h) + aoff + m * 2048); dst[m].hi = *(const LAS i32x4*)(lds + PG8_SA(b, h) + aoff1 + m * 2048); } } \
        else { _Pragma("unroll") for (int m = 0; m < 4; ++m) _Pragma("unroll") for (int k = 0; k < 2; ++k) dst[m][k] = *(const LAS bf16x8*)(lds + PG8_SA(b, h) + (k ? aoff1 : aoff) + m * 2048); } } while (0)
#define PG8_LDB(dst, b, h) do { if constexpr (FP8) { _Pragma("unroll") for (int n = 0; n < 2; ++n) { dst[n].lo = *(const LAS i32x4*)(lds + PG8_SB(b, h) + boff + n * 2048); dst[n].hi = *(const LAS i32x4*)(lds + PG8_SB(b, h) + boff1 + n * 2048); } } \
        else { _Pragma("unroll") for (int n = 0; n < 2; ++n) _Pragma("unroll") for (int k = 0; k < 2; ++k) dst[n][k] = *(const LAS bf16x8*)(lds + PG8_SB(b, h) + (k ? boff1 : boff) + n * 2048); } } while (0)
#define PG8_MMA(ai, bj, At, Bt) do { __builtin_amdgcn_s_setprio(1); if constexpr (FP8) { _Pragma("unroll") for (int m = 0; m < 4; ++m) _Pragma("unroll") for (int n = 0; n < 2; ++n) \
            acc[ai][bj][m][n] = __builtin_amdgcn_mfma_scale_f32_16x16x128_f8f6f4(Bt[n], At[m], acc[ai][bj][m][n], 0, 0, 0, 0, 0, 0); } \
        else { _Pragma("unroll") for (int m = 0; m < 4; ++m) _Pragma("unroll") for (int n = 0; n < 2; ++n) _Pragma("unroll") for (int k = 0; k < 2; ++k) \
            acc[ai][bj][m][n] = __builtin_amdgcn_mfma_f32_16x16x32_bf16(Bt[n][k], At[m][k], acc[ai][bj][m][n], 0, 0, 0); } __builtin_amdgcn_s_setprio(0); } while (0)
#define PG8_WAIT_V(n) asm volatile("s_waitcnt vmcnt(" #n ")" ::: "memory")
#define PG8_WAIT_L(n) asm volatile("s_waitcnt lgkmcnt(" #n ")" ::: "memory")
#define PG8_BAR __builtin_amdgcn_s_barrier()
#define PG8_SCHED __builtin_amdgcn_sched_barrier(0)
#define PG8_GLOAD(dst, slot, u) do { _Pragma("unroll") for (int h = 0; h < 2; ++h) _Pragma("unroll") for (int i = 0; i < 2; ++i) \
        dst[h][i] = (GATHER ? (unsigned)g.gidx[(slot) * 256 + h * HALF + rA[i]] : (unsigned)(((u).pm - tileA0) * BM + h * HALF + rA[i])) * (unsigned)KB + cA[i]; } while (0)
#define PG8_STAGE_A(bufoff, ptr, h, VG) PG8_STAGE(bufoff, ptr, VG[h])
    Unit cur, nxt; int ui = 0; typename Epi::Pre pre;
    if (!S.next(0, cur)) return;
    f32x4 acc[2][2][4][2];
#pragma unroll
    for (int a = 0; a < 2; ++a)
#pragma unroll
        for (int b = 0; b < 2; ++b)
#pragma unroll
            for (int m = 0; m < 4; ++m)
#pragma unroll
                for (int n = 0; n < 2; ++n) acc[a][b][m][n] = (f32x4){0.f, 0.f, 0.f, 0.f};
    typename FragT<FP8>::A At; typename FragT<FP8>::B B0, B1;
    unsigned vC[2][2];
    PG8_GLOAD(vC, 0, cur);
    const char* const Ab = (const char*)g.A;
    const char* cB = (const char*)g.Bt + (size_t)cur.e * g.estride + (size_t)cur.pn * tstep;
    PG8_STAGE(PG8_SB(0, 0), cB, voffB); PG8_STAGE(PG8_SB(0, 1), cB + hstep, voffB); PG8_STAGE_A(PG8_SA(0, 0), Ab, 0, vC); PG8_STAGE_A(PG8_SA(0, 1), Ab, 1, vC);
    if (wr == 1) PG8_BAR;
    PG8_WAIT_V(2); PG8_BAR;
    PG8_STAGE(PG8_SB(1, 0), cB + kstep, voffB); PG8_STAGE_A(PG8_SA(1, 0), Ab + kstep, 0, vC); PG8_STAGE(PG8_SB(1, 1), cB + hstep + kstep, voffB);
    PG8_WAIT_V(6); PG8_BAR;
    for (;;) {
        const bool has_next = S.next(ui + 1, nxt);
        const char* nB = has_next ? (const char*)g.Bt + (size_t)nxt.e * g.estride + (size_t)nxt.pn * tstep : cB;
#pragma unroll 1
        for (int t = 0; t < nt; t += 2) {
            const bool last = (t == nt - 2);
            if constexpr (Epi::HAS_PRE) { if (last) { int fq_p = fq; asm volatile("" : "+v"(fq_p)); E.prefetch(pre, cur, wc, fq_p); } }
            const char* a1 = Ab + (size_t)(t + 1) * kstep;
            const char* a2 = last ? Ab : Ab + (size_t)(t + 2) * kstep; const char* b2 = last ? nB : cB + (size_t)(t + 2) * kstep;
            const char* a3 = a2 + kstep; const char* b3 = b2 + kstep;
            PG8_LDB(B0, 0, 0); PG8_LDB(B1, 0, 1); PG8_SCHED; PG8_LDA(At, 0, 0); PG8_STAGE_A(PG8_SA(1, 1), a1, 1, vC);
            if (last && has_next) { PG8_GLOAD(vC, ui + 1, nxt); }
            PG8_WAIT_V(8); PG8_WAIT_L(0); PG8_BAR; PG8_MMA(0, 0, At, B0); PG8_MMA(0, 1, At, B1); PG8_BAR; PG8_SCHED;
            PG8_LDA(At, 0, 1); PG8_STAGE(PG8_SB(0, 0), b2, voffB); PG8_STAGE(PG8_SB(0, 1), b2 + hstep, voffB); PG8_STAGE_A(PG8_SA(0, 0), a2, 0, vC);
            PG8_WAIT_V(8); PG8_WAIT_L(0); PG8_BAR; PG8_MMA(1, 0, At, B0); PG8_MMA(1, 1, At, B1); PG8_BAR; PG8_SCHED;
            PG8_LDB(B0, 1, 0); PG8_LDB(B1, 1, 1); PG8_SCHED; PG8_LDA(At, 1, 0); PG8_STAGE_A(PG8_SA(0, 1), a2, 1, vC);
            PG8_WAIT_V(8); PG8_WAIT_L(0); PG8_BAR; PG8_MMA(0, 0, At, B0); PG8_MMA(0, 1, At, B1); PG8_BAR; PG8_SCHED;
            PG8_LDA(At, 1, 1); PG8_STAGE(PG8_SB(1, 0), b3, voffB); PG8_STAGE(PG8_SB(1, 1), b3 + hstep, voffB); PG8_STAGE_A(PG8_SA(1, 0), a3, 0, vC);
            PG8_WAIT_V(8); PG8_WAIT_L(0); PG8_BAR;
            if constexpr (Epi::HAS_PRE) { if (last) E.landed(pre); }
            PG8_MMA(1, 0, At, B0); PG8_MMA(1, 1, At, B1); PG8_BAR; PG8_SCHED;
        }
        if (wr == 0) PG8_BAR;
        { int fr_ = fr, fq_ = fq; asm volatile("" : "+v"(fr_), "+v"(fq_));
          E(acc, cur, wr, wc, fr_, fq_, pre); }
        if (!has_next) break;
#pragma unroll
        for (int a = 0; a < 2; ++a)
#pragma unroll
            for (int b = 0; b < 2; ++b)
#pragma unroll
                for (int m = 0; m < 4; ++m)
#pragma unroll
                    for (int n = 0; n < 2; ++n) acc[a][b][m][n] = (f32x4){0.f, 0.f, 0.f, 0.f};
        cur = nxt; cB = nB; ++ui;
        if (wr == 1) PG8_BAR;
    }
    PG8_WAIT_V(0);
    PG8_BAR;
#undef PG8_SA
#undef PG8_SB
#undef PG8_STAGE
#undef PG8_LDA
#undef PG8_LDB
#undef PG8_MMA
#undef PG8_WAIT_V
#undef PG8_WAIT_L
#undef PG8_BAR
#undef PG8_SCHED
#undef PG8_GLOAD
#undef PG8_STAGE_A
}
}


namespace att {
typedef float f32x16 __attribute__((ext_vector_type(16)));
typedef short s16x4 __attribute__((ext_vector_type(4)));
typedef short v4i16_t __attribute__((ext_vector_type(4)));
typedef const LAS unsigned char* lptr;
__device__ __forceinline__ int crow(int r, int hi) { return (r & 3) + 8 * (r >> 2) + 4 * hi; }
__device__ __forceinline__ s16x4 vtr(lptr p) { return __builtin_bit_cast(s16x4, __builtin_amdgcn_ds_read_tr16_b64_v4i16((LAS v4i16_t*)p)); }
__device__ __forceinline__ void glds16(const void* g, LAS unsigned char* l) {
    const unsigned dst = (unsigned)__builtin_amdgcn_readfirstlane((int)(unsigned)(size_t)l); unsigned keep;
    asm volatile("s_mov_b32 %0, m0\n\ts_mov_b32 m0, %2\n\ts_nop 0\n\tglobal_load_lds_dwordx4 %1, off\n\ts_mov_b32 m0, %0" : "=&s"(keep) : "v"(g), "s"(dst) : "memory");
}
__device__ __forceinline__ float partner32(float x, bool hi) { auto rr = __builtin_amdgcn_permlane32_swap(__float_as_uint(x), __float_as_uint(x), false, false); return __uint_as_float(hi ? rr[0] : rr[1]); }
__device__ __forceinline__ int koff(int r32, int hi) { return r32 * 128 + ((hi ^ ((r32 >> 1) & 7)) << 4); }
__device__ __forceinline__ void kload(bf16x8 (&kf)[8], lptr kslot, int r32, int hi) {
    const int a = koff(r32, hi);
#pragma unroll
    for (int d0 = 0; d0 < 4; ++d0) { lptr p = kslot + (a ^ (d0 << 5)); kf[2 * d0] = *(const LAS bf16x8*)p; kf[2 * d0 + 1] = *(const LAS bf16x8*)(p + 4096); }
}
__device__ __forceinline__ float max3f_mfma(float a, float b, float c) { float d; asm("s_nop 11\n\tv_max3_f32 %0, %1, %2, %3" : "=v"(d) : "v"(a), "v"(b), "v"(c)); return d; }
__device__ __forceinline__ float max16_mfma(const f32x16& p) { float d;
    asm("s_nop 11\n\tv_max3_f32 %0, %1, %2, %3\n\tv_max3_f32 %0, %0, %4, %5\n\tv_max3_f32 %0, %0, %6, %7\n\tv_max3_f32 %0, %0, %8, %9\n\tv_max3_f32 %0, %0, %10, %11\n\tv_max3_f32 %0, %0, %12, %13\n\tv_max3_f32 %0, %0, %14, %15\n\tv_max_f32 %0, %0, %16"
        : "=&v"(d) : "v"(p[0]), "v"(p[1]), "v"(p[2]), "v"(p[3]), "v"(p[4]), "v"(p[5]), "v"(p[6]), "v"(p[7]), "v"(p[8]), "v"(p[9]), "v"(p[10]), "v"(p[11]), "v"(p[12]), "v"(p[13]), "v"(p[14]), "v"(p[15]));
    return d; }
__device__ __forceinline__ float max16_acc(float t, const f32x16& p) {
    asm("v_max3_f32 %0, %0, %1, %2\n\tv_max3_f32 %0, %0, %3, %4\n\tv_max3_f32 %0, %0, %5, %6\n\tv_max3_f32 %0, %0, %7, %8\n\tv_max3_f32 %0, %0, %9, %10\n\tv_max3_f32 %0, %0, %11, %12\n\tv_max3_f32 %0, %0, %13, %14\n\tv_max3_f32 %0, %0, %15, %16"
        : "+v"(t) : "v"(p[0]), "v"(p[1]), "v"(p[2]), "v"(p[3]), "v"(p[4]), "v"(p[5]), "v"(p[6]), "v"(p[7]), "v"(p[8]), "v"(p[9]), "v"(p[10]), "v"(p[11]), "v"(p[12]), "v"(p[13]), "v"(p[14]), "v"(p[15]));
    return t; }
__device__ __forceinline__ float max3f(float a, float b, float c) { float d; asm("v_max3_f32 %0, %1, %2, %3" : "=v"(d) : "v"(a), "v"(b), "v"(c)); return d; }
__device__ __forceinline__ void qkt(f32x16& p0, f32x16& p1, const bf16x8 (&kf)[8], const bf16x8 (&qr)[4], const f32x16& c0) {
    p0 = __builtin_amdgcn_mfma_f32_32x32x16_bf16(kf[0], qr[0], c0, 0, 0, 0); p1 = __builtin_amdgcn_mfma_f32_32x32x16_bf16(kf[1], qr[0], c0, 0, 0, 0);
#pragma unroll
    for (int d0 = 1; d0 < 4; ++d0) { p0 = __builtin_amdgcn_mfma_f32_32x32x16_bf16(kf[2 * d0], qr[d0], p0, 0, 0, 0); p1 = __builtin_amdgcn_mfma_f32_32x32x16_bf16(kf[2 * d0 + 1], qr[d0], p1, 0, 0, 0); }
}
__device__ __forceinline__ int voff_of(int lane) { const int rl = 4 * (lane >> 5) + ((lane & 15) >> 2); return rl * 128 + ((rl >> 1) & 1) * 64 + ((lane >> 4) & 1) * 32 + (lane & 3) * 8; }
__device__ __forceinline__ void vload(bf16x8 (&vf)[8], lptr base, int voff) {
#pragma unroll
    for (int d0 = 0; d0 < 2; ++d0) { lptr vp = base + (voff ^ (d0 << 6));
#pragma unroll
        for (int ks = 0; ks < 4; ++ks) { const s16x4 lo = vtr(vp + ks * 2048), hi4 = vtr(vp + ks * 2048 + 1024);
            vf[d0 * 4 + ks] = (bf16x8){lo[0], lo[1], lo[2], lo[3], hi4[0], hi4[1], hi4[2], hi4[3]}; } }
}
__device__ __forceinline__ void pv64(f32x16& o0, f32x16& o1, const bf16x8 (&vf)[8], const bf16x8 (&pa)[4]) {
#pragma unroll
    for (int ks = 0; ks < 4; ++ks) { o0 = __builtin_amdgcn_mfma_f32_32x32x16_bf16(pa[ks], vf[ks], o0, 0, 0, 0); o1 = __builtin_amdgcn_mfma_f32_32x32x16_bf16(pa[ks], vf[4 + ks], o1, 0, 0, 0); }
}
__device__ __forceinline__ void pack_p(bf16x8 (&pa)[4], const f32x16& p0, const f32x16& p1) {
    u32x4 w0, w1, w2, w3;
    w0.x = cvt_pk_bf16(p0[0], p0[1]); w0.y = cvt_pk_bf16(p0[2], p0[3]); w0.z = cvt_pk_bf16(p0[4], p0[5]); w0.w = cvt_pk_bf16(p0[6], p0[7]);
    w1.x = cvt_pk_bf16(p0[8], p0[9]); w1.y = cvt_pk_bf16(p0[10], p0[11]); w1.z = cvt_pk_bf16(p0[12], p0[13]); w1.w = cvt_pk_bf16(p0[14], p0[15]);
    w2.x = cvt_pk_bf16(p1[0], p1[1]); w2.y = cvt_pk_bf16(p1[2], p1[3]); w2.z = cvt_pk_bf16(p1[4], p1[5]); w2.w = cvt_pk_bf16(p1[6], p1[7]);
    w3.x = cvt_pk_bf16(p1[8], p1[9]); w3.y = cvt_pk_bf16(p1[10], p1[11]); w3.z = cvt_pk_bf16(p1[12], p1[13]); w3.w = cvt_pk_bf16(p1[14], p1[15]);
    pa[0] = __builtin_bit_cast(bf16x8, w0); pa[1] = __builtin_bit_cast(bf16x8, w1); pa[2] = __builtin_bit_cast(bf16x8, w2); pa[3] = __builtin_bit_cast(bf16x8, w3);
}

#define ATT_WAIT_BAR(N) asm volatile("s_waitcnt vmcnt(" #N ") lgkmcnt(0)\n\ts_barrier" ::: "memory")
#define ATT_BAR() asm volatile("s_waitcnt lgkmcnt(0)\n\ts_barrier" ::: "memory")
__device__ __forceinline__ void sb_probs(f32x16& p0, f32x16& p1) {
#pragma unroll
    for (int r = 0; r < 16; r += 2) {
        p0[r] = __builtin_amdgcn_exp2f(p0[r]); p1[r] = __builtin_amdgcn_exp2f(p1[r]); p0[r + 1] = __builtin_amdgcn_exp2f(p0[r + 1]); p1[r + 1] = __builtin_amdgcn_exp2f(p1[r + 1]);
        p0[r] = 1.0f + p0[r]; p1[r] = 1.0f + p1[r]; p0[r + 1] = 1.0f + p0[r + 1]; p1[r + 1] = 1.0f + p1[r + 1];
        p0[r] = __builtin_amdgcn_rcpf(p0[r]); p1[r] = __builtin_amdgcn_rcpf(p1[r]); p0[r + 1] = __builtin_amdgcn_rcpf(p0[r + 1]); p1[r + 1] = __builtin_amdgcn_rcpf(p1[r + 1]);
        __builtin_amdgcn_sched_group_barrier(0x400, 4, 0); __builtin_amdgcn_sched_group_barrier(0x2, 4, 0); __builtin_amdgcn_sched_group_barrier(0x400, 4, 0);
    }
}
__device__ __forceinline__ void sb_mask(f32x16& p0, f32x16& p1, int lim, int hi) {
#pragma unroll
    for (int r = 0; r < 16; ++r) { const int kl = crow(r, hi); if (kl >= lim) p0[r] = 1.0f; if (kl + 32 >= lim) p1[r] = 1.0f; }
}
__device__ __forceinline__ void sb_scan(f32x16& p0, f32x16& p1, float& carry, bool hib) {
    float G[8], Gp[8];
#pragma unroll
    for (int gi = 0; gi < 4; ++gi) { G[gi] = (p0[4 * gi] * p0[4 * gi + 1]) * (p0[4 * gi + 2] * p0[4 * gi + 3]); G[4 + gi] = (p1[4 * gi] * p1[4 * gi + 1]) * (p1[4 * gi + 2] * p1[4 * gi + 3]); }
#pragma unroll
    for (int gi = 0; gi < 8; ++gi) Gp[gi] = partner32(G[gi], hib);
    float u = carry;
#pragma unroll
    for (int gi = 7; gi >= 0; --gi) {
        const float ug = u * Gp[gi]; float tt = hib ? u : ug;
#pragma unroll
        for (int i = 3; i >= 0; --i) { if (gi >= 4) { const float tn = tt * p1[4 * (gi - 4) + i]; p1[4 * (gi - 4) + i] = tt - tn; tt = tn; } else { const float tn = tt * p0[4 * gi + i]; p0[4 * gi + i] = tt - tn; tt = tn; } }
        u = ug * G[gi];
    }
    carry = u;
}
__device__ __forceinline__ void sb_head(LAS unsigned char* lds, const bf16_t* PROJ, const bf16_t* METAKV, bf16_t* MIX, int b, int h) {
    int tid = threadIdx.x; asm volatile("" : "+v"(tid));
    const int lane = tid & 63, r32 = lane & 31, hi = lane >> 5; const int wid = __builtin_amdgcn_readfirstlane(tid >> 6);
    const bool hib = hi != 0;
    const bf16_t* Kg = PROJ + (size_t)b * SEQ * DIN + COL_SBK + h * 64; const bf16_t* Vg = PROJ + (size_t)b * SEQ * DIN + COL_SBV + h * 64;
    const bf16_t* Km = METAKV + COL_SBK + h * 64; const bf16_t* Vm = METAKV + COL_SBV + h * 64;
    const int voff_lane = voff_of(lane);
    if (wid >= 4) __builtin_amdgcn_s_setprio(1);
    LAS unsigned* flags = (LAS unsigned*)(lds + 139264);
    int c_qb = 7, c_ip = 0, n_iss = 0, s_iss = 0;
#define SB_ISSUE_NEXT() do { if (c_qb >= 0) { LAS unsigned char* bb_ = lds + s_iss * 32768; const int NT_ = 4 * c_qb + 4, NP_ = NT_ >> 1; \
        int l_ = lane; asm volatile("" : "+v"(l_)); const int krow = 8 * wid + (l_ >> 3), kcol = ((l_ & 7) ^ ((krow >> 1) & 7)) * 8, vrow = krow, vcol = ((l_ & 7) ^ (((krow >> 1) & 1) << 2)) * 8;     \
        if (c_ip < NP_) { const int keyA_ = 64 * (NT_ - 1 - 2 * c_ip), keyB_ = keyA_ - 64; \
            glds16(Kg + (size_t)(keyA_ + krow) * DIN + kcol, bb_ + wid * 1024); glds16(Vg + (size_t)(keyA_ + vrow) * DIN + vcol, bb_ + 8192 + wid * 1024); \
            glds16(Kg + (size_t)(keyB_ + krow) * DIN + kcol, bb_ + 16384 + wid * 1024); glds16(Vg + (size_t)(keyB_ + vrow) * DIN + vcol, bb_ + 24576 + wid * 1024); } \
        else { glds16(Km + (size_t)(krow < 16 ? krow : 15) * DIN + kcol, bb_ + wid * 1024); glds16(Vm + (size_t)(vrow < 16 ? vrow : 15) * DIN + vcol, bb_ + 8192 + wid * 1024); \
            glds16(Km + (size_t)(krow < 16 ? krow : 15) * DIN + kcol, bb_ + 16384 + wid * 1024); glds16(Vm + (size_t)(vrow < 16 ? vrow : 15) * DIN + vcol, bb_ + 24576 + wid * 1024); } \
        ++n_iss; s_iss = s_iss == 2 ? 0 : s_iss + 1; if (++c_ip > NP_) { c_ip = 0; --c_qb; } } } while (0)
    SB_ISSUE_NEXT(); SB_ISSUE_NEXT();
    bf16x8 qr[4];
    { const bf16_t* qp = PROJ + ((size_t)b * SEQ + 7 * 256 + wid * 32 + r32) * DIN + COL_SBQ + h * 64 + hi * 8;
#pragma unroll
      for (int d0 = 0; d0 < 4; ++d0) qr[d0] = *(const bf16x8*)(qp + d0 * 16); }
    asm volatile("" : "+v"(qr[0]), "+v"(qr[1]), "+v"(qr[2]), "+v"(qr[3]));
    int js = 0, s_cmp = 0;
    for (int qb = 7; qb >= 0; --qb) {
        const int NT = 4 * qb + 4, NP = NT / 2, q0w = qb * 256 + wid * 32, my_diag = 4 * qb + (wid >> 1);
        f32x16 o0 = {}, o1 = {}; float carry = 1.0f;
        bf16x8 qn[4] = {qr[0], qr[1], qr[2], qr[3]};
        int last = NP; bool wdone = false, udone = false;
        for (int ip = 0; ip <= last; ++ip) {
            if (ip == 0) ATT_BAR(); else if (js + 1 < n_iss) ATT_WAIT_BAR(4); else ATT_WAIT_BAR(0);
            if (ip > 0 && !udone) { const LAS unsigned* fl = flags + ((ip - 1) & 1) * 8; const u32x4 f0 = *(const LAS u32x4*)fl, f1 = *(const LAS u32x4*)(fl + 4);
                if (__builtin_amdgcn_readfirstlane((int)(((f0.x & f0.y) & (f0.z & f0.w)) & ((f1.x & f1.y) & (f1.z & f1.w))))) {
                    udone = true; last = ip + 1 <= NP ? ip + 1 : NP; if (c_qb == qb) { c_ip = 0; c_qb = qb - 1; } } }
            SB_ISSUE_NEXT();
            if (ip == last && qb > 0) { const bf16_t* qp = PROJ + ((size_t)b * SEQ + (qb - 1) * 256 + wid * 32 + r32) * DIN + COL_SBQ + h * 64 + hi * 8;
#pragma unroll
                for (int d0 = 0; d0 < 4; ++d0) qn[d0] = *(const bf16x8*)(qp + d0 * 16); }
            lptr bb = lds + s_cmp * 32768;
            const f32x16 z16 = {};
            if (udone || wdone) {
            } else if (ip == NP) {
                f32x16 p0;
                { const int ka = koff(r32, hi); bf16x8 k4[4];
#pragma unroll
                  for (int d0 = 0; d0 < 4; ++d0) k4[d0] = *(const LAS bf16x8*)(bb + (ka ^ (d0 << 5)));
                  p0 = __builtin_amdgcn_mfma_f32_32x32x16_bf16(k4[0], qr[0], z16, 0, 0, 0);
#pragma unroll
                  for (int d0 = 1; d0 < 4; ++d0) p0 = __builtin_amdgcn_mfma_f32_32x32x16_bf16(k4[d0], qr[d0], p0, 0, 0, 0); }
                lptr vp = bb + 8192 + voff_lane; lptr vq = bb + 8192 + (voff_lane ^ 64);
                const s16x4 vl0 = vtr(vp), vh0 = vtr(vp + 1024), vl1 = vtr(vq), vh1 = vtr(vq + 1024);
                float pm[8];
#pragma unroll
                for (int r = 0; r < 8; ++r) pm[r] = __builtin_amdgcn_rcpf(1.0f + __builtin_amdgcn_exp2f(p0[r]));
                const float G0 = (pm[0] * pm[1]) * (pm[2] * pm[3]), G1 = (pm[4] * pm[5]) * (pm[6] * pm[7]);
                const float Gp0 = partner32(G0, hib), Gp1 = partner32(G1, hib);
                float u = carry;
                { const float ug = u * Gp1; float tt = hib ? u : ug;
#pragma unroll
                  for (int i = 3; i >= 0; --i) { const float tn = tt * pm[4 + i]; pm[4 + i] = tt - tn; tt = tn; }
                  u = ug * G1; }
                { const float ug = u * Gp0; float tt = hib ? u : ug;
#pragma unroll
                  for (int i = 3; i >= 0; --i) { const float tn = tt * pm[i]; pm[i] = tt - tn; tt = tn; } }
                u32x4 w0; w0.x = cvt_pk_bf16(pm[0], pm[1]); w0.y = cvt_pk_bf16(pm[2], pm[3]); w0.z = cvt_pk_bf16(pm[4], pm[5]); w0.w = cvt_pk_bf16(pm[6], pm[7]);
                const bf16x8 pa0 = __builtin_bit_cast(bf16x8, w0);
                o0 = __builtin_amdgcn_mfma_f32_32x32x16_bf16(pa0, (bf16x8){vl0[0], vl0[1], vl0[2], vl0[3], vh0[0], vh0[1], vh0[2], vh0[3]}, o0, 0, 0, 0);
                o1 = __builtin_amdgcn_mfma_f32_32x32x16_bf16(pa0, (bf16x8){vl1[0], vl1[1], vl1[2], vl1[3], vh1[0], vh1[1], vh1[2], vh1[3]}, o1, 0, 0, 0);
            } else {
                const int tA = NT - 1 - 2 * ip, tB = tA - 1;
                if (tA <= my_diag) {
                    f32x16 a0, a1, b0, b1; bf16x8 kf[8];
                    kload(kf, bb, r32, hi); qkt(a0, a1, kf, qr, z16);
                    kload(kf, bb + 16384, r32, hi); qkt(b0, b1, kf, qr, z16);
                    sb_probs(a0, a1); sb_probs(b0, b1);
                    if (tA == my_diag) sb_mask(a0, a1, q0w + r32 - 64 * tA, hi);
                    sb_scan(a0, a1, carry, hib);
                    { bf16x8 vf[8]; vload(vf, bb + 8192, voff_lane); bf16x8 pa[4]; pack_p(pa, a0, a1); pv64(o0, o1, vf, pa); }
                    sb_scan(b0, b1, carry, hib);
                    { bf16x8 vf[8]; vload(vf, bb + 24576, voff_lane); bf16x8 pa[4]; pack_p(pa, b0, b1); pv64(o0, o1, vf, pa); }
                } else if (tB <= my_diag) {
                    f32x16 p0, p1; bf16x8 kf[8]; kload(kf, bb + 16384, r32, hi); qkt(p0, p1, kf, qr, z16);
                    bf16x8 vf[8]; vload(vf, bb + 24576, voff_lane);
                    sb_probs(p0, p1); if (tB == my_diag) sb_mask(p0, p1, q0w + r32 - 64 * tB, hi); sb_scan(p0, p1, carry, hib);
                    bf16x8 pa[4]; pack_p(pa, p0, p1); pv64(o0, o1, vf, pa);
                }
            }
            if (!udone) { if (!wdone) wdone = __ballot(carry != 0.0f) == 0ull; if (lane == 0) flags[(ip & 1) * 8 + wid] = wdone ? 1u : 0u; }
            ++js; s_cmp = s_cmp == 2 ? 0 : s_cmp + 1;
        }
        { LAS bf16_t* stg = (LAS bf16_t*)(lds + 98304 + wid * 4096);
#pragma unroll
          for (int r = 0; r < 16; ++r) { const int orow = crow(r, hi); const unsigned pk = cvt_pk_bf16(o0[r], o1[r]); stg[orow * 64 + r32] = (bf16_t)(pk & 0xffffu); stg[orow * 64 + 32 + r32] = (bf16_t)(pk >> 16); }
          bf16_t* Ow = MIX + ((size_t)b * SEQ + q0w) * D + h * 64;
#pragma unroll
          for (int i = 0; i < 4; ++i) { const int row = i * 8 + (lane >> 3), ch = lane & 7; const u32x4 v = *(const LAS u32x4*)(stg + row * 64 + ch * 8); *(u32x4*)(Ow + (size_t)row * D + ch * 8) = v; } }
        if (qb > 0) asm volatile("" : "+v"(qn[0]), "+v"(qn[1]), "+v"(qn[2]), "+v"(qn[3]));
#pragma unroll
        for (int d0 = 0; d0 < 4; ++d0) qr[d0] = qn[d0];
    }
    asm volatile("s_waitcnt vmcnt(0) lgkmcnt(0)\n\ts_barrier" ::: "memory");
    __builtin_amdgcn_s_setprio(0);
#undef SB_ISSUE_NEXT
}

constexpr float DF_THR = 8.0f;
__device__ __forceinline__ void df_head(LAS unsigned char* lds, LAS float* wsf_all, const LAS float* btab, float lam, const float* sgain, const bf16_t* PROJ, const bf16_t* METAKV, bf16_t* MIX, int b, int hd, int which) {
    int tid = threadIdx.x; asm volatile("" : "+v"(tid));
    const int lane = tid & 63, r32 = lane & 31, hi = lane >> 5; const int wid = __builtin_amdgcn_readfirstlane(tid >> 6);
    const bool hib = hi != 0; const int s = wid >> 2, qw = wid & 3;
    const size_t rb = (size_t)b * SEQ * DIN;
    const bf16_t* K0g = PROJ + rb + COL_DFK + (2 * hd) * 64; const bf16_t* K1g = K0g + 64; const bf16_t* Vg = PROJ + rb + COL_DFV + hd * 128;
    const bf16_t* K0m = METAKV + COL_DFK + (2 * hd) * 64; const bf16_t* K1m = K0m + 64; const bf16_t* Vm = METAKV + COL_DFV + hd * 128;
    const int voff_lane = voff_of(lane);
    LAS float* wsf = wsf_all + wid * 64;
    const LAS float* bt = btab + hd * 288 + 96;
    const float bfar = bt[0];
#define DF_UNIT(i8_) (2 * (i8_) + (which ? 1 - ((i8_) & 1) : ((i8_) & 1)))
    if (wid >= 4) __builtin_amdgcn_s_setprio(1);
    int c_i8 = 0, c_it = 0, n_iss = 0, s_iss = 0;
#define DF_ISSUE_NEXT() do { if (c_i8 < 8) { LAS unsigned char* bb_ = lds + s_iss * 32768; const int NTL_ = 2 * DF_UNIT(c_i8) + 2; \
        int l_ = lane; asm volatile("" : "+v"(l_)); const int krow = 8 * wid + (l_ >> 3), kcol = ((l_ & 7) ^ ((krow >> 1) & 7)) * 8, vrow = krow, vcol = ((l_ & 7) ^ (((krow >> 1) & 1) << 2)) * 8; \
        if (c_it < NTL_) { const int key0_ = 64 * c_it; const size_t ko_ = (size_t)(key0_ + krow) * DIN + kcol, vo_ = (size_t)(key0_ + vrow) * DIN + vcol; \
            glds16(K0g + ko_, bb_ + wid * 1024); glds16(K1g + ko_, bb_ + 8192 + wid * 1024); glds16(Vg + vo_, bb_ + 16384 + wid * 1024); glds16(Vg + vo_ + 64, bb_ + 24576 + wid * 1024); } \
        else { const size_t ko_ = (size_t)(krow < 16 ? krow : 15) * DIN + kcol, vo_ = (size_t)(vrow < 16 ? vrow : 15) * DIN + vcol; \
            glds16(K0m + ko_, bb_ + wid * 1024); glds16(K1m + ko_, bb_ + 8192 + wid * 1024); glds16(Vm + vo_, bb_ + 16384 + wid * 1024); glds16(Vm + vo_ + 64, bb_ + 24576 + wid * 1024); } \
        ++n_iss; s_iss = s_iss == 2 ? 0 : s_iss + 1; if (++c_it > NTL_) { c_it = 0; ++c_i8; } } } while (0)
    DF_ISSUE_NEXT(); DF_ISSUE_NEXT();
    bf16x8 qr[4];
    { const bf16_t* qp = PROJ + ((size_t)b * SEQ + DF_UNIT(0) * 128 + qw * 32 + r32) * DIN + COL_DFQ + (2 * hd + s) * 64 + hi * 8;
#pragma unroll
      for (int d0 = 0; d0 < 4; ++d0) qr[d0] = *(const bf16x8*)(qp + d0 * 16); }
    float gnv[4];
#pragma unroll
    for (int db = 0; db < 4; ++db) gnv[db] = sgain[db * 32 + r32];
    asm volatile("" : "+v"(qr[0]), "+v"(qr[1]), "+v"(qr[2]), "+v"(qr[3]), "+v"(gnv[0]), "+v"(gnv[1]), "+v"(gnv[2]), "+v"(gnv[3]));
    int js = 0, s_cmp = 0;
    f32x16 cm = {}; float cmv = 0.f;
    for (int i8 = 0; i8 < 8; ++i8) {
        const int u = DF_UNIT(i8);
        const int NTL = 2 * u + 2;
        const int q0w = u * 128 + qw * 32, mychunk = 2 * u + (qw >> 1);
        f32x16 o[4] = {{}, {}, {}, {}}; float mrun = -1e30f, lsum = 0.f;
        float mref = 0.f;
        bf16x8 qn[4] = {qr[0], qr[1], qr[2], qr[3]};
        for (int it = 0; it < NTL; ++it) {
            if (it == 0) ATT_BAR(); else ATT_WAIT_BAR(4);
            bf16x8 kf[8]; kload(kf, lds + s_cmp * 32768 + s * 8192, r32, hi);
            DF_ISSUE_NEXT();
            if (it <= mychunk) {
                lptr bb = lds + s_cmp * 32768;
                const int kbase = 64 * it;
                const bool near = (q0w - (kbase + 63)) < 128;
                f32x16 p0, p1;
                const float badd = near ? 0.f : bfar;
                { const float want = badd - mref;
                  if (__any(want != cmv)) { cmv = want;
#pragma unroll
                      for (int r = 0; r < 16; ++r) cm[r] = want;
                      asm volatile("" ::: "memory"); } }
                __builtin_amdgcn_sched_barrier(0);
                qkt(p0, p1, kf, qr, cm);
                bf16x8 vf[8]; vload(vf, bb + 16384, voff_lane); __builtin_amdgcn_sched_barrier(0);
                if (near) { const LAS float* btl = bt + (kbase - (q0w + r32) + 128 + 4 * hi);
#pragma unroll
                    for (int r = 0; r < 16; ++r) { p0[r] += btl[crow(r, 0)]; p1[r] += btl[crow(r, 0) + 32]; } }
                float tm = max16_mfma(p0); tm = max16_acc(tm, p1);
                tm = fmaxf(tm, partner32(tm, hib)) + mref;
                if (__any(tm > mrun + DF_THR)) {
                    const float mn = fmaxf(mrun, tm); const float f = __builtin_amdgcn_exp2f(mrun - mn); mrun = mn; lsum *= f;
                    if (!hib) wsf[r32] = f;
#pragma unroll
                    for (int r = 0; r < 16; ++r) { const float fr_ = wsf[crow(r, hi)]; o[0][r] *= fr_; o[1][r] *= fr_; o[2][r] *= fr_; o[3][r] *= fr_; }
                    const float dsh = mn - mref; mref = mn;
#pragma unroll
                    for (int r = 0; r < 16; ++r) { p0[r] -= dsh; p1[r] -= dsh; }
                }
                float ps = 0.f;
#pragma unroll
                for (int r = 0; r < 16; ++r) { p0[r] = __builtin_amdgcn_exp2f(p0[r]); p1[r] = __builtin_amdgcn_exp2f(p1[r]); }
#pragma unroll
                for (int r = 0; r < 16; ++r) { ps += p0[r]; ps += p1[r]; }
                lsum += ps;
                bf16x8 pa[4]; pack_p(pa, p0, p1);
                pv64(o[0], o[1], vf, pa);
                vload(vf, bb + 24576, voff_lane); __builtin_amdgcn_sched_barrier(0);
                pv64(o[2], o[3], vf, pa);
            }
            ++js; s_cmp = s_cmp == 2 ? 0 : s_cmp + 1;
        }
        {
            if (js + 1 < n_iss) ATT_WAIT_BAR(4); else ATT_WAIT_BAR(0);
            DF_ISSUE_NEXT();
            if (i8 < 7) { const bf16_t* qp = PROJ + ((size_t)b * SEQ + DF_UNIT(i8 + 1) * 128 + qw * 32 + r32) * DIN + COL_DFQ + (2 * hd + s) * 64 + hi * 8;
#pragma unroll
                for (int d0 = 0; d0 < 4; ++d0) qn[d0] = *(const bf16x8*)(qp + d0 * 16); }
            {
                lptr bb = lds + s_cmp * 32768;
                const bool near = (q0w + 16 - 15) < 128;
                const float badd = near ? 0.f : bfar;
                f32x16 p0; const f32x16 c0 = {};
                { const int ka = koff(r32, hi); bf16x8 k4[4];
#pragma unroll
                  for (int d0 = 0; d0 < 4; ++d0) k4[d0] = *(const LAS bf16x8*)(bb + s * 8192 + (ka ^ (d0 << 5)));
                  p0 = __builtin_amdgcn_mfma_f32_32x32x16_bf16(k4[0], qr[0], c0, 0, 0, 0);
#pragma unroll
                  for (int d0 = 1; d0 < 4; ++d0) p0 = __builtin_amdgcn_mfma_f32_32x32x16_bf16(k4[d0], qr[d0], p0, 0, 0, 0); }
                lptr vpa = bb + 16384 + voff_lane; lptr vpb = bb + 24576 + voff_lane; lptr vqa = bb + 16384 + (voff_lane ^ 64); lptr vqb = bb + 24576 + (voff_lane ^ 64);
                const s16x4 al0 = vtr(vpa), ah0 = vtr(vpa + 1024), al1 = vtr(vqa), ah1 = vtr(vqa + 1024);
                const s16x4 bl0 = vtr(vpb), bh0 = vtr(vpb + 1024), bl1 = vtr(vqb), bh1 = vtr(vqb + 1024);
                float pm[8];
#pragma unroll
                for (int r = 0; r < 8; ++r) pm[r] = p0[r];
                if (near) { const int base = -16 - (q0w + r32) + 128;
#pragma unroll
                    for (int r = 0; r < 8; ++r) pm[r] += bt[base + crow(r, hi)]; }
                float tm = max3f_mfma(pm[0], pm[1], pm[2]); tm = max3f(tm, pm[3], pm[4]); tm = max3f(tm, pm[5], pm[6]); tm = max3f(tm, pm[7], pm[7]);
                tm = fmaxf(tm, partner32(tm, hib)) + badd;
                if (__any(tm > mrun + DF_THR)) {
                    const float mn = fmaxf(mrun, tm); const float f = __builtin_amdgcn_exp2f(mrun - mn); mrun = mn; lsum *= f;
                    if (!hib) wsf[r32] = f;
#pragma unroll
                    for (int r = 0; r < 16; ++r) { const float fr_ = wsf[crow(r, hi)]; o[0][r] *= fr_; o[1][r] *= fr_; o[2][r] *= fr_; o[3][r] *= fr_; }
                }
                float ps = 0.f; const float msub = mrun - badd;
#pragma unroll
                for (int r = 0; r < 8; ++r) { pm[r] = __builtin_amdgcn_exp2f(pm[r] - msub); ps += pm[r]; }
                lsum += ps;
                u32x4 w0; w0.x = cvt_pk_bf16(pm[0], pm[1]); w0.y = cvt_pk_bf16(pm[2], pm[3]); w0.z = cvt_pk_bf16(pm[4], pm[5]); w0.w = cvt_pk_bf16(pm[6], pm[7]);
                const bf16x8 pa0 = __builtin_bit_cast(bf16x8, w0);
#define DF_FR(l_, h_) (bf16x8){l_[0], l_[1], l_[2], l_[3], h_[0], h_[1], h_[2], h_[3]}
                o[0] = __builtin_amdgcn_mfma_f32_32x32x16_bf16(pa0, DF_FR(al0, ah0), o[0], 0, 0, 0); o[1] = __builtin_amdgcn_mfma_f32_32x32x16_bf16(pa0, DF_FR(al1, ah1), o[1], 0, 0, 0);
                o[2] = __builtin_amdgcn_mfma_f32_32x32x16_bf16(pa0, DF_FR(bl0, bh0), o[2], 0, 0, 0); o[3] = __builtin_amdgcn_mfma_f32_32x32x16_bf16(pa0, DF_FR(bl1, bh1), o[3], 0, 0, 0);
#undef DF_FR
            }
            ++js; s_cmp = s_cmp == 2 ? 0 : s_cmp + 1;
        }
        if (i8 < 7) asm volatile("" : "+v"(qn[0]), "+v"(qn[1]), "+v"(qn[2]), "+v"(qn[3]));
        const float ltot = lsum + partner32(lsum, hib);
        if (!hib) wsf[r32] = (s ? lam : 1.0f) / ltot;
        float sc[16];
#pragma unroll
        for (int r = 0; r < 16; ++r) sc[r] = wsf[crow(r, hi)];
        LAS unsigned* X = (LAS unsigned*)(lds + 98304 + qw * 8192);
        if (s == 1) {
#pragma unroll
            for (int db = 0; db < 4; ++db)
#pragma unroll
                for (int rp = 0; rp < 8; ++rp) X[(db * 8 + rp) * 64 + lane] = cvt_pk_bf16(o[db][2 * rp] * sc[2 * rp], o[db][2 * rp + 1] * sc[2 * rp + 1]);
        }
        ATT_BAR();
        if (s == 0) {
            float ssq[16];
#pragma unroll
            for (int r = 0; r < 16; ++r) ssq[r] = 0.f;
#pragma unroll
            for (int db = 0; db < 4; ++db)
#pragma unroll
                for (int rp = 0; rp < 8; ++rp) { const unsigned xx = X[(db * 8 + rp) * 64 + lane];
                    const float a0 = o[db][2 * rp] * sc[2 * rp] - bf_lo(xx), a1 = o[db][2 * rp + 1] * sc[2 * rp + 1] - bf_hi(xx);
                    o[db][2 * rp] = a0; o[db][2 * rp + 1] = a1; ssq[2 * rp] += a0 * a0; ssq[2 * rp + 1] += a1 * a1; }
#pragma unroll
            for (int r = 0; r < 16; ++r) ssq[r] = (1.0f - LAMBDA_INIT) * __builtin_amdgcn_rsqf(allsum32(ssq[r]) * (1.0f / 128.0f) + SUBLN_EPS);
            LAS bf16_t* stg = (LAS bf16_t*)X;
#pragma unroll
            for (int db = 0; db < 4; ++db)
#pragma unroll
                for (int r = 0; r < 16; r += 2) { const unsigned pk = cvt_pk_bf16(o[db][r] * ssq[r] * gnv[db], o[db][r + 1] * ssq[r + 1] * gnv[db]);
                    stg[crow(r, hi) * 128 + db * 32 + r32] = (bf16_t)(pk & 0xffffu); stg[crow(r + 1, hi) * 128 + db * 32 + r32] = (bf16_t)(pk >> 16); }
            bf16_t* Ow = MIX + ((size_t)b * SEQ + q0w) * D + 512 + hd * 128;
            const int row0 = lane >> 4, ch = lane & 15;
#pragma unroll
            for (int i = 0; i < 8; ++i) { const int row = row0 + 4 * i; const u32x4 v = *(const LAS u32x4*)(stg + row * 128 + ch * 8); *(u32x4*)(Ow + (size_t)row * D + ch * 8) = v; }
        }
#pragma unroll
        for (int d0 = 0; d0 < 4; ++d0) qr[d0] = qn[d0];
    }
    asm volatile("s_waitcnt vmcnt(0) lgkmcnt(0)\n\ts_barrier" ::: "memory");
    __builtin_amdgcn_s_setprio(0);
#undef DF_ISSUE_NEXT
#undef DF_UNIT
}
}

#define XB_TMO      128
#define XB_XCNT(j)  (256  + 64 * (j))
#define XB_XSUB(j)  (1280 + 64 * (j))
#define XB_XGEN(j)  (2304 + 64 * (j))
#define XB_TOP      3328
#define XB_TOPGEN   3392
#define XCD_BAR_WORDS 3456
#define XB_SPIN_CAP (1u << 18)
__device__ __forceinline__ unsigned xb_ld(unsigned* p)              { return __hip_atomic_load(p, __ATOMIC_RELAXED, __HIP_MEMORY_SCOPE_AGENT); }
__device__ __forceinline__ unsigned xb_add(unsigned* p, unsigned v) { return __hip_atomic_fetch_add(p, v, __ATOMIC_RELAXED, __HIP_MEMORY_SCOPE_AGENT); }
__device__ __forceinline__ unsigned xb_xcc_id() { return (unsigned)__builtin_amdgcn_s_getreg((3 << 11) | 20) & 0xFu; }
#define XB_SPIN(cond, bar) do { unsigned _sp = 0; while (cond) { __builtin_amdgcn_s_sleep(1); \
    if ((++_sp & 255u) == 0u) { if (xb_ld(&(bar)[XB_TMO])) break; if (_sp > XB_SPIN_CAP) { atomicAdd(&(bar)[XB_TMO], 1u); break; } } } } while (0)
struct XcdBarrier { unsigned* bar; unsigned x; volatile LAS unsigned* st; };
__device__ __forceinline__ XcdBarrier xcd_barrier_post(unsigned* bar, volatile LAS unsigned* st) {
    XcdBarrier b; b.bar = bar; b.x = xb_xcc_id(); b.st = st;
    if (threadIdx.x == 0) (void)xb_add(&bar[XB_XCNT(b.x)], 1u);
    return b;
}
__device__ __forceinline__ void xcd_barrier_complete(unsigned* bar, unsigned x, unsigned& nloc, unsigned& nx) {
    const unsigned G = gridDim.x * gridDim.y * gridDim.z;
    unsigned sum, cnt, mine, sp = 0u;
    for (;;) {
        sum = 0u; cnt = 0u; mine = 0u;
#pragma unroll
        for (unsigned j = 0; j < 16; ++j) { const unsigned c = xb_ld(&bar[XB_XCNT(j)]); sum += c; cnt += (c > 0u) ? 1u : 0u; mine = (j == x) ? c : mine; }
        if (sum == G) break;
        __builtin_amdgcn_s_sleep(1);
        if ((++sp & 255u) == 0u) { if (xb_ld(&bar[XB_TMO])) break; if (sp > XB_SPIN_CAP) { atomicAdd(&bar[XB_TMO], 1u); break; } }
    }
    nloc = mine > 0u ? mine : 1u; nx = cnt > 0u ? cnt : 1u;
}
__device__ __forceinline__ void xcd_barrier(const XcdBarrier& b) {
    asm volatile("s_waitcnt vmcnt(0)" ::: "memory");
    __syncthreads();
    if (threadIdx.x == 0) {
        unsigned* bar = b.bar;
        __builtin_amdgcn_s_waitcnt(0);
        unsigned nloc = b.st[0], nx = b.st[1];
        if (nloc == 0u) { xcd_barrier_complete(bar, b.x, nloc, nx); b.st[0] = nloc; b.st[1] = nx; }
        const unsigned old = xb_add(&bar[XB_XSUB(b.x)], 1u);
        const unsigned gen = old / nloc;
        if (old + 1u == (gen + 1u) * nloc) {
            __builtin_amdgcn_fence(__ATOMIC_RELEASE, "agent");
            asm volatile("s_waitcnt vmcnt(0)" ::: "memory");
            const unsigned og = xb_add(&bar[XB_TOP], 1u);
            const unsigned tg = og / nx;
            if (og + 1u == (tg + 1u) * nx) xb_add(&bar[XB_TOPGEN], 1u);
            else XB_SPIN(xb_ld(&bar[XB_TOPGEN]) == tg, bar);
            __builtin_amdgcn_fence(__ATOMIC_ACQUIRE, "agent");
            xb_add(&bar[XB_XGEN(b.x)], 1u);
            asm volatile("s_waitcnt vmcnt(0)" ::: "memory");
        } else {
            XB_SPIN(xb_ld(&bar[XB_XGEN(b.x)]) == gen, bar);
            __builtin_amdgcn_fence(__ATOMIC_ACQUIRE, "agent");
            asm volatile("s_waitcnt vmcnt(0)" ::: "memory");
        }
    }
    __syncthreads();
}

struct Args { const float* in[19]; float* out; unsigned char* ws; int ph_lo, ph_hi; };
enum { I_X = 0, I_META, I_RELB, I_ANORM, I_WIN, I_WOUT, I_LQ1, I_LK1, I_LQ2, I_LK2, I_SUBLN, I_FNORM, I_WR, I_BR, I_W1, I_B1, I_W2, I_B2, I_FINAL };

__device__ __forceinline__ void rms_row_to_bf16(const float* xrow, const f32x4 (&gn)[4], bf16_t* orow, int lane) {
    const f32x4* xr = (const f32x4*)xrow + lane;
    f32x4 v[4]; float s = 0.f;
#pragma unroll
    for (int j = 0; j < 4; ++j) { v[j] = xr[64 * j]; s += (v[j].x * v[j].x + v[j].y * v[j].y) + (v[j].z * v[j].z + v[j].w * v[j].w); }
    const float r = 1.0f / sqrtf(wave_sum(s) * (1.f / D) + NORM_EPS);
    unsigned long long* o8 = (unsigned long long*)orow + lane;
#pragma unroll
    for (int j = 0; j < 4; ++j) { const f32x4 y = v[j] * r * gn[j]; o8[64 * j] = (unsigned long long)pk2(y.x, y.y) | ((unsigned long long)pk2(y.z, y.w) << 32); }
}

__device__ __forceinline__ void p0_transpose_item(const float* W, int K, int N, bf16_t* WT, LAS float* scr, int item, int lane, int mode) {
    const int nblk = N / 32, kb = item / nblk, nb = item % nblk, k0 = 64 * kb, n0 = 32 * nb;
#pragma unroll 8
    for (int i = 0; i < 32; ++i) { const int kk = 2 * i + (lane >> 5); scr[kk * 33 + (lane & 31)] = W[(size_t)(k0 + kk) * N + n0 + (lane & 31)]; }
    LDS_WAIT(); asm volatile("" ::: "memory");
    int d0 = n0;
    if (mode == 1) { const int half = n0 >> 10, jj = n0 & 1023; d0 = (jj >> 7) * 256 + half * 128 + (jj & 127); }
    const int c = lane & 7;
#pragma unroll
    for (int j = 0; j < 4; ++j) { const int n = (lane >> 3) + 8 * j; const LAS float* s = scr + (8 * c) * 33 + n;
        u32x4 o; o.x = pk2(s[0 * 33], s[1 * 33]); o.y = pk2(s[2 * 33], s[3 * 33]); o.z = pk2(s[4 * 33], s[5 * 33]); o.w = pk2(s[6 * 33], s[7 * 33]);
        *(u32x4*)(WT + (size_t)(d0 + n) * K + k0 + 8 * c) = o; }
    LDS_WAIT(); asm volatile("" ::: "memory");
}

__device__ __forceinline__ void p0_transpose_item8(const float* W, int K, int N, unsigned char* WT, LAS float* scr, int item, int lane, int mode) {
    const int nblk = N / 32, kb = item / nblk, nb = item % nblk, k0 = 64 * kb, n0 = 32 * nb;
#pragma unroll 8
    for (int i = 0; i < 32; ++i) { const int kk = 2 * i + (lane >> 5); scr[kk * 33 + (lane & 31)] = W[(size_t)(k0 + kk) * N + n0 + (lane & 31)]; }
    LDS_WAIT(); asm volatile("" ::: "memory");
    int d0 = n0;
    if (mode == 1) { const int half = n0 >> 10, jj = n0 & 1023; d0 = (jj >> 7) * 256 + half * 128 + (jj & 127); }
    const int c = lane & 3;
#pragma unroll
    for (int j = 0; j < 2; ++j) { const int n = (lane >> 2) + 16 * j; const LAS float* sp = scr + (16 * c) * 33 + n;
        u32x4 o;
        o.x = pk4_fp8(sp[0 * 33] * 32.f, sp[1 * 33] * 32.f, sp[2 * 33] * 32.f, sp[3 * 33] * 32.f); o.y = pk4_fp8(sp[4 * 33] * 32.f, sp[5 * 33] * 32.f, sp[6 * 33] * 32.f, sp[7 * 33] * 32.f);
        o.z = pk4_fp8(sp[8 * 33] * 32.f, sp[9 * 33] * 32.f, sp[10 * 33] * 32.f, sp[11 * 33] * 32.f); o.w = pk4_fp8(sp[12 * 33] * 32.f, sp[13 * 33] * 32.f, sp[14 * 33] * 32.f, sp[15 * 33] * 32.f);
        *(u32x4*)(WT + (size_t)(d0 + n) * K + k0 + 16 * c) = o; }
    LDS_WAIT(); asm volatile("" ::: "memory");
}

__device__ __forceinline__ int t5_bucket(int rel) {
    const int n = rel < 0 ? -rel : rel; int b = rel > 0 ? 16 : 0;
    int large = 8 + (n >= 12) + (n >= 16) + (n >= 23) + (n >= 32) + (n >= 46) + (n >= 64) + (n >= 91);
    return b + (n < 8 ? n : large);
}

template <int CLS> __global__ void __launch_bounds__(NWAVES * 64, 2) fwd_kernel(Args args) {
    extern __shared__ __attribute__((aligned(16))) unsigned char lds_raw[];
    LAS unsigned char* lds = (LAS unsigned char*)lds_raw;
    volatile LAS unsigned* MISC = (volatile LAS unsigned*)(lds + MISC_OFF);
    const int tid = threadIdx.x, lane = tid & 63, wave = __builtin_amdgcn_readfirstlane(tid >> 6);
    const int G = gridDim.x, bx = blockIdx.x;
    const int gw = bx * NWAVES + wave, NGW = G * NWAVES;
    unsigned char* ws = args.ws;
    unsigned* ctl = (unsigned*)(ws + WS_CTL);
    const float* x = args.in[I_X];
    bf16_t* WinT = (bf16_t*)(ws + WS_WIN); bf16_t* WoutT = (bf16_t*)(ws + WS_WOUT); unsigned char* W1T = ws + WS_W1; unsigned char* W2T = ws + WS_W2; unsigned char* XN8 = ws + WS_XN8;
    bf16_t* METAKV = (bf16_t*)(ws + WS_METAKV); bf16_t* XN = (bf16_t*)(ws + WS_XN); bf16_t* PROJ = (bf16_t*)(ws + WS_PROJ); bf16_t* MIX = (bf16_t*)(ws + WS_MIX);
    unsigned char* Y = ws + WS_Y; unsigned char* ACT = ws + WS_ACT;
    int* tok_e = (int*)(ws + WS_TOKE); float* tok_g = (float*)(ws + WS_TOKG); int* tok_lr = (int*)(ws + WS_TOKLR); int* cnt = (int*)(ws + WS_CNT);
    unsigned* rowtok = (unsigned*)(ws + WS_ROWTOK); int* rowsg = (int*)(ws + WS_ROWSG); int* tilee_hdr = (int*)(ws + WS_TILEE); unsigned char* tilee = (unsigned char*)(ws + WS_TILEE) + 64;
    bf16_t* H1 = (bf16_t*)(ws + WS_H1);

    if (tid < 32) MISC[tid] = 0u;
    __syncthreads();
#if ONE_LAUNCH
    XcdBarrier bar = xcd_barrier_post(ctl + CW_BAR, MISC + 8);
#define GRID_BAR() xcd_barrier(bar)
#else
#define GRID_BAR() do {} while (0)
#endif
    const int lo = args.ph_lo, hi = args.ph_hi;
#define INC(k, cls) ((CLS == -1 || CLS == (cls)) && lo <= (k) && (k) < hi)
#define IN(k) INC(k, k)
#define BOTH(k) (CLS == -1 && lo <= (k) && (k) + 1 < hi)

#define P4_PRE() do { __syncthreads(); \
        LAS bf16_t* wt_ = (LAS bf16_t*)lds; LAS float* gl_ = (LAS float*)(lds + 66048); const f32x4* wr4_ = (const f32x4*)args.in[I_WR]; const int t_ = threadIdx.x; \
        _Pragma("unroll") for (int jb_ = 0; jb_ < 2; ++jb_) { f32x4 wv_[8]; \
            _Pragma("unroll") for (int j_ = 0; j_ < 8; ++j_) wv_[j_] = wr4_[t_ + 512 * (8 * jb_ + j_)]; \
            _Pragma("unroll") for (int j_ = 0; j_ < 8; ++j_) { const int i4_ = 4 * (t_ + 512 * (8 * jb_ + j_)); LAS bf16_t* d_ = wt_ + (i4_ & 31) * 1032 + (i4_ >> 5); \
                d_[0] = (bf16_t)f2bf(wv_[j_].x); d_[1032] = (bf16_t)f2bf(wv_[j_].y); d_[2064] = (bf16_t)f2bf(wv_[j_].z); d_[3096] = (bf16_t)f2bf(wv_[j_].w); } } \
        for (int idx_ = t_; idx_ < 1024; idx_ += NWAVES * 64) gl_[idx_] = args.in[I_FNORM][idx_]; } while (0)
#define P2_PRE() do { const int t_ = threadIdx.x; LAS float* btab_ = (LAS float*)(lds + GIDX_OFF + 2048); LAS float* lamp_ = (LAS float*)(lds + EXTRA_OFF); \
        for (int i = t_; i < 1152; i += NWAVES * 64) { const int h = i / 288, idx = i % 288 - 96; const int rel = idx < 0 ? -128 : idx - 128; btab_[i] = args.in[I_RELB][t5_bucket(rel) * 4 + h] * LOG2E; } \
        if (wave == 0) { const int l_ = t_ & 63; const float a = wave_sum(args.in[I_LQ1][l_] * args.in[I_LK1][l_]), b = wave_sum(args.in[I_LQ2][l_] * args.in[I_LK2][l_]); if (l_ == 0) lamp_[0] = expf(a) - expf(b) + LAMBDA_INIT; } } while (0)

    if (IN(0)) {
        REP_BEGIN(0)
        int tid = threadIdx.x; asm volatile("" : "+v"(tid)); const int lane = tid & 63;
        LAS float* scr = (LAS float*)(lds + wave * 16384);
        constexpr int I_IN = 16 * 96, I_OUT = 16 * 32, I_1 = 16 * 64, I_2 = 16 * 32;
        constexpr int NITEMS = I_IN + I_OUT + NEXP * (I_1 + I_2);
        for (int it = gw; it < NITEMS; it += NGW) {
            int r = it;
            if (r < I_IN) { p0_transpose_item(args.in[I_WIN], D, DIN, WinT, scr, r, lane, 0); continue; } r -= I_IN;
            if (r < I_OUT) { p0_transpose_item(args.in[I_WOUT], D, D, WoutT, scr, r, lane, 0); continue; } r -= I_OUT;
            if (r < NEXP * I_1) { const int e = r / I_1; p0_transpose_item8(args.in[I_W1] + (size_t)e * D * 2048, D, 2048, W1T + (size_t)e * 2048 * D, scr, r % I_1, lane, 1); continue; } r -= NEXP * I_1;
            { const int e = r / I_2; p0_transpose_item8(args.in[I_W2] + (size_t)e * D * D, D, D, W2T + (size_t)e * D * D, scr, r % I_2, lane, 0); }
        }
        f32x4 gn[4];
#pragma unroll
        for (int j = 0; j < 4; ++j) gn[j] = ((const f32x4*)args.in[I_ANORM])[lane + 64 * j];
        for (int m = gw; m < T; m += NGW) rms_row_to_bf16(x + (size_t)m * D, gn, XN + (size_t)m * D, lane);
        __syncthreads();
        LAS float* xm = (LAS float*)lds;
        for (int rr = 0; rr < 2; ++rr) { const int m = wave * 2 + rr; const f32x4* xr = (const f32x4*)(args.in[I_META] + (size_t)m * D) + lane;
            f32x4 v[4]; float s = 0.f;
#pragma unroll
            for (int j = 0; j < 4; ++j) { v[j] = xr[64 * j]; s += (v[j].x * v[j].x + v[j].y * v[j].y) + (v[j].z * v[j].z + v[j].w * v[j].w); }
            const float r = 1.0f / sqrtf(wave_sum(s) * (1.f / D) + NORM_EPS);
#pragma unroll
            for (int j = 0; j < 4; ++j) { const f32x4 y = v[j] * r * gn[j]; *(LAS f32x4*)(xm + m * D + 4 * lane + 256 * j) = y; } }
        __syncthreads();
        for (int cb = bx; cb < 256; cb += G) {
            const int q0 = cb * 8; const int n0 = q0 < 1024 ? q0 + 512 : q0 + 1024;
            const int m = tid >> 5, kp = tid & 31; float a8[8];
#pragma unroll
            for (int c = 0; c < 8; ++c) a8[c] = 0.f;
            const float* win = args.in[I_WIN];
            for (int kk = 0; kk < 32; ++kk) { const int k = kk * 32 + kp; const float xv = xm[m * D + k];
                const f32x4 w0 = *(const f32x4*)(win + (size_t)k * DIN + n0), w1 = *(const f32x4*)(win + (size_t)k * DIN + n0 + 4);
                a8[0] += xv * w0.x; a8[1] += xv * w0.y; a8[2] += xv * w0.z; a8[3] += xv * w0.w; a8[4] += xv * w1.x; a8[5] += xv * w1.y; a8[6] += xv * w1.z; a8[7] += xv * w1.w; }
#pragma unroll
            for (int c = 0; c < 8; ++c) a8[c] = allsum32(a8[c]);
            if (kp == 0) { u32x4 w; w.x = pk2(a8[0], a8[1]); w.y = pk2(a8[2], a8[3]); w.z = pk2(a8[4], a8[5]); w.w = pk2(a8[6], a8[7]); *(u32x4*)(METAKV + (size_t)m * DIN + n0) = w; }
        }
        __syncthreads();
        REP_END(0)
        if (BOTH(0)) GRID_BAR();
    }

    if (IN(1)) {
        REP_BEGIN(1)
        pg8::Gemm g{XN, WinT, 0, nullptr}; pg8::StaticOrder S; S.init(T, DIN, G, bx);
        pg8::EpiProj E{PROJ};
        pg8::gemm_phase<pg8::EpiProj, pg8::StaticOrder, false, false>(lds, g, S, E, 0);
        REP_END(1)
        if (BOTH(1)) { P2_PRE(); GRID_BAR(); }
    }

    if (IN(2)) {
        int tid = threadIdx.x; asm volatile("" : "+v"(tid)); const int lane = tid & 63;
        LAS float* btab = (LAS float*)(lds + GIDX_OFF + 2048);
        LAS float* lamp = (LAS float*)(lds + EXTRA_OFF);
        if (!BOTH(1)) P2_PRE();
        __syncthreads();
        const float lam = lamp[0];
        REP_BEGIN(20)
        for (int vb = bx; vb < 256; vb += G) att::sb_head(lds, PROJ, METAKV, MIX, vb >> 3, vb & 7);
        REP_END(20)
        __syncthreads();
        REP_BEGIN(21)
        for (int vb = bx; vb < 256; vb += G) { const int pairi = (vb >> 4) * 8 + (vb & 7), which = (vb >> 3) & 1;
            att::df_head(lds, (LAS float*)(lds + GIDX_OFF), btab, lam, args.in[I_SUBLN], PROJ, METAKV, MIX, pairi >> 2, pairi & 3, which); }
        REP_END(21)
        if (BOTH(2)) GRID_BAR();
    }

    if (IN(3)) {
        REP_BEGIN(3)
        pg8::Gemm g{MIX, WoutT, 0, nullptr}; pg8::StaticOrder S; S.init(T, D, G, bx);
        pg8::EpiRes E{x, H1, (float*)(ws + WS_ROWSS)};
        pg8::gemm_phase<pg8::EpiRes, pg8::StaticOrder, false, false>(lds, g, S, E, 0);
        REP_END(3)
        if (BOTH(3)) { P4_PRE(); GRID_BAR(); }
    }

    if (IN(4)) {
        REP_BEGIN(4)
        int tid = threadIdx.x; asm volatile("" : "+v"(tid)); const int lane = tid & 63, r32 = lane & 31, hi = lane >> 5; const bool hib = hi != 0;
        LAS bf16_t* wt = (LAS bf16_t*)lds;
        LAS float* gl = (LAS float*)(lds + 66048);
        LAS int* hist = (LAS int*)(lds + EXTRA_OFF);
        if (!BOTH(3)) P4_PRE();
        const float* rowss = (const float*)(ws + WS_ROWSS);
        float bias[16];
#pragma unroll
        for (int r = 0; r < 16; ++r) bias[r] = args.in[I_BR][att::crow(r, hi)];
        for (int blk = bx; blk < 256; blk += G) {
            __syncthreads();
            if (tid < 32) hist[tid] = 0;
            __syncthreads();
            const int tok = blk * 256 + wave * 32 + r32;
            float rs;
            { const f32x4* sp = (const f32x4*)(rowss + (size_t)tok * 16); const f32x4 s0 = sp[0], s1 = sp[1], s2 = sp[2], s3 = sp[3];
              const float ssum = (((s0[0] + s0[1]) + (s0[2] + s0[3])) + ((s1[0] + s1[1]) + (s1[2] + s1[3]))) + (((s2[0] + s2[1]) + (s2[2] + s2[3])) + ((s3[0] + s3[1]) + (s3[2] + s3[3])));
              rs = 1.0f / sqrtf(ssum * (1.f / D) + NORM_EPS); }
            const bf16_t* xrow = H1 + (size_t)tok * D + 8 * hi;
            unsigned char* orow = XN8 + (size_t)tok * D + 8 * hi;
            const LAS bf16_t* wrow = wt + r32 * 1032 + 8 * hi;
            att::f32x16 acc = {};
#pragma unroll 1
            for (int sc = 0; sc < 8; ++sc) {
                f32x4 xv[16];
#pragma unroll
                for (int s8 = 0; s8 < 8; ++s8) { const u32x4 hb = *(const u32x4*)(xrow + (sc * 8 + s8) * 16);
                    xv[2 * s8] = (f32x4){bf_lo(hb.x), bf_hi(hb.x), bf_lo(hb.y), bf_hi(hb.y)}; xv[2 * s8 + 1] = (f32x4){bf_lo(hb.z), bf_hi(hb.z), bf_lo(hb.w), bf_hi(hb.w)}; }
#pragma unroll
                for (int s8 = 0; s8 < 8; ++s8) { const int sk = (sc * 8 + s8) * 16;
                    const f32x4 g0 = *(const LAS f32x4*)(gl + sk + 8 * hi), g1 = *(const LAS f32x4*)(gl + sk + 8 * hi + 4);
                    const f32x4 y0 = xv[2 * s8] * g0 * rs, y1 = xv[2 * s8 + 1] * g1 * rs;
                    u32x4 bw; bw.x = cvt_pk_bf16(y0[0], y0[1]); bw.y = cvt_pk_bf16(y0[2], y0[3]); bw.z = cvt_pk_bf16(y1[0], y1[1]); bw.w = cvt_pk_bf16(y1[2], y1[3]);
                    u32x2 o8; o8.x = pk4_fp8(y0[0], y0[1], y0[2], y0[3]); o8.y = pk4_fp8(y1[0], y1[1], y1[2], y1[3]);
                    *(u32x2*)(orow + sk) = o8;
                    const bf16x8 af = *(const LAS bf16x8*)(wrow + sk);
                    acc = __builtin_amdgcn_mfma_f32_32x32x16_bf16(af, __builtin_bit_cast(bf16x8, bw), acc, 0, 0, 0); }
            }
            float v[16];
#pragma unroll
            for (int r = 0; r < 16; ++r) v[r] = acc[r] + bias[r];
            float cv[8]; int ce[8];
#pragma unroll
            for (int k = 0; k < 4; ++k) { float m = v[0]; int mi = 0;
#pragma unroll
                for (int r = 1; r < 16; ++r) { const bool c = v[r] > m; m = c ? v[r] : m; mi = c ? r : mi; }
#pragma unroll
                for (int r = 0; r < 16; ++r) v[r] = (r == mi) ? -3.0e38f : v[r];
                cv[k] = m; ce[k] = (mi & 3) + 8 * (mi >> 2) + 4 * hi; }
#pragma unroll
            for (int k = 0; k < 4; ++k) { cv[4 + k] = att::partner32(cv[k], hib); ce[4 + k] = __builtin_bit_cast(int, att::partner32(__builtin_bit_cast(float, ce[k]), hib)); }
            float tv[4]; int te4[4];
#pragma unroll
            for (int k = 0; k < 4; ++k) { float m = cv[0]; int mi = 0, me = ce[0];
#pragma unroll
                for (int c8 = 1; c8 < 8; ++c8) { const bool c = cv[c8] > m || (cv[c8] == m && ce[c8] < me); m = c ? cv[c8] : m; mi = c ? c8 : mi; me = c ? ce[c8] : me; }
                tv[k] = m; te4[k] = me;
#pragma unroll
                for (int c8 = 0; c8 < 8; ++c8) cv[c8] = (c8 == mi) ? -3.0e38f : cv[c8]; }
            const float e1 = __expf(tv[1] - tv[0]), e2 = __expf(tv[2] - tv[0]), e3 = __expf(tv[3] - tv[0]); const float inv = 1.0f / (((1.0f + e1) + e2) + e3);
            if (!hib) {
                { const int lr = atomicAdd((int*)(hist + te4[0]), 1); tok_e[tok * 4 + 0] = te4[0]; tok_g[tok * 4 + 0] = inv; tok_lr[tok * 4 + 0] = lr; }
                { const int lr = atomicAdd((int*)(hist + te4[1]), 1); tok_e[tok * 4 + 1] = te4[1]; tok_g[tok * 4 + 1] = e1 * inv; tok_lr[tok * 4 + 1] = lr; }
                { const int lr = atomicAdd((int*)(hist + te4[2]), 1); tok_e[tok * 4 + 2] = te4[2]; tok_g[tok * 4 + 2] = e2 * inv; tok_lr[tok * 4 + 2] = lr; }
                { const int lr = atomicAdd((int*)(hist + te4[3]), 1); tok_e[tok * 4 + 3] = te4[3]; tok_g[tok * 4 + 3] = e3 * inv; tok_lr[tok * 4 + 3] = lr; } }
            __syncthreads();
            if (tid < 32) cnt[blk * 32 + tid] = hist[tid];
        }
        __syncthreads();
        REP_END(4)
        if (BOTH(4)) GRID_BAR();
    }

    if (IN(5)) {
        int tid = threadIdx.x; asm volatile("" : "+v"(tid)); const int lane = tid & 63;
        LAS int* tot = (LAS int*)(lds + EXTRA_OFF); LAS int* tstart = tot + 32; LAS int* pref = tstart + 40;
        LAS int* part = pref + 32;
        const int pe = tid & 31, pc = tid >> 5;
        int hv[16];
#pragma unroll
        for (int j = 0; j < 16; ++j) hv[j] = cnt[(16 * pc + j) * 32 + pe];
        { int st = 0;
#pragma unroll
          for (int j = 0; j < 16; ++j) st += hv[j];
          part[pc * 32 + pe] = st; }
        __syncthreads();
        if (tid < 32) { int s = 0;
#pragma unroll
            for (int q = 0; q < 16; ++q) s += part[q * 32 + tid];
            tot[tid] = s; }
        __syncthreads();
        if (tid == 0) { int a = 0; for (int e = 0; e < 32; ++e) { tstart[e] = a; a += (tot[e] + 255) >> 8; } tstart[32] = a; }
        __syncthreads();
        for (int blk = bx; blk < 256; blk += G) {
            { int st = 0;
#pragma unroll
              for (int j = 0; j < 16; ++j) st += (16 * pc + j < blk) ? hv[j] : 0;
              part[pc * 32 + pe] = st; }
            __syncthreads();
            if (tid < 32) { int s = 0;
#pragma unroll
                for (int q = 0; q < 16; ++q) s += part[q * 32 + tid];
                pref[tid] = s; }
            __syncthreads();
            for (int a = tid; a < 1024; a += NWAVES * 64) { const int idx = blk * 1024 + a; const int e = tok_e[idx]; const int pos = tstart[e] * 256 + pref[e] + tok_lr[idx];
                rowtok[pos] = (unsigned)(idx >> 2); rowsg[2 * pos] = idx; rowsg[2 * pos + 1] = __builtin_bit_cast(int, tok_g[idx]); }
            __syncthreads();
        }
        for (int e = bx; e < 32; e += G)
            for (int p = tstart[e] * 256 + tot[e] + tid; p < tstart[e + 1] * 256; p += NWAVES * 64) { rowtok[p] = 0u; rowsg[2 * p] = -1; rowsg[2 * p + 1] = 0; }
        if (bx == 0) { if (tid < 32) for (int tl = tstart[tid]; tl < tstart[tid + 1]; ++tl) tilee[tl] = (unsigned char)tid; if (tid == 0) tilee_hdr[0] = tstart[32]; }
        __syncthreads();
        if (BOTH(5)) GRID_BAR();
    }

    if (IN(6)) {
        REP_BEGIN(6)
        int tid = threadIdx.x; asm volatile("" : "+v"(tid)); const int lane = tid & 63;
        LAS unsigned char* te = lds + TE_OFF; LAS unsigned short* gidx = (LAS unsigned short*)(lds + GIDX_OFF);
        int NTl;
        if (BOTH(5)) {
            const LAS int* ts_l = (const LAS int*)(lds + EXTRA_OFF) + 32;
            NTl = __builtin_amdgcn_readfirstlane(ts_l[32]);
            for (int i = tid; i < MAXTILES; i += NWAVES * 64) te[i] = (unsigned char)0;
            __syncthreads();
            if (tid < 32) for (int tl = ts_l[tid]; tl < ts_l[tid + 1]; ++tl) te[tl] = (unsigned char)tid;
        } else {
            NTl = tilee_hdr[0];
            for (int i = tid; i < MAXTILES; i += NWAVES * 64) te[i] = i < NTl ? tilee[i] : (unsigned char)0;
        }
        __syncthreads();
        pg8::GroupedOrder S; S.init(NTl, 8, G, bx, 0, te);
        for (int i0 = 0; i0 < MAXSLOTS; i0 += 11) {
            unsigned rv[11]; bool ok[11];
#pragma unroll
            for (int j = 0; j < 11; ++j) { pg8::Unit u; ok[j] = S.next(i0 + j, u) && tid < 256; rv[j] = ok[j] ? rowtok[u.pm * 256 + tid] : 0u; }
#pragma unroll
            for (int j = 0; j < 11; ++j) if (ok[j]) gidx[(i0 + j) * 256 + tid] = (unsigned short)rv[j];
        }
        __syncthreads();
        pg8::Gemm g{XN8, W1T, (size_t)2048 * D, gidx};
        pg8::EpiSwiglu E{ACT, args.in[I_B1]};
        pg8::gemm_phase<pg8::EpiSwiglu, pg8::GroupedOrder, true, true>(lds, g, S, E, 0);
        REP_END(6)
        if (BOTH(6)) GRID_BAR();
    }
    f32x4 gn8[4];
#define P8_PRE() do { _Pragma("unroll") for (int j = 0; j < 4; ++j) gn8[j] = ((const f32x4*)args.in[I_FINAL])[(threadIdx.x & 63) + 64 * j]; } while (0)
    if (IN(7)) {
        REP_BEGIN(7)
        int tid = threadIdx.x; asm volatile("" : "+v"(tid)); const int lane = tid & 63;
        const int NTl = (BOTH(5) && BOTH(6)) ? __builtin_amdgcn_readfirstlane(((const LAS int*)(lds + EXTRA_OFF))[64]) : tilee_hdr[0];
        LAS unsigned char* te = lds + TE_OFF;
        __syncthreads();
        if (!BOTH(6)) for (int i = tid; i < MAXTILES; i += NWAVES * 64) te[i] = i < NTl ? tilee[i] : (unsigned char)0;
        __syncthreads();
        pg8::GroupedOrder S; S.init(NTl, 4, G, bx, 0, te, true);
        pg8::Gemm g{ACT, W2T, (size_t)D * D, nullptr};
        pg8::EpiDown E{Y, args.in[I_B2], rowsg, ws + WS_DUMP};
        pg8::gemm_phase<pg8::EpiDown, pg8::GroupedOrder, false, true>(lds, g, S, E, 0);
        REP_END(7)
        if (BOTH(7)) { P8_PRE(); GRID_BAR(); }
    }

    if (IN(8)) {
        int tid = threadIdx.x; asm volatile("" : "+v"(tid)); const int lane = tid & 63;
        if (!BOTH(7)) P8_PRE();
        for (int tok = gw; tok < T; tok += NGW) {
            f32x4* hp = (f32x4*)(args.out + (size_t)tok * D) + lane; const u32x2* hb = (const u32x2*)(H1 + (size_t)tok * D) + lane; f32x4 v[4]; float s = 0.f;
#pragma unroll
            for (int j = 0; j < 4; ++j) { const u32x2 h2 = hb[64 * j]; v[j] = (f32x4){bf_lo(h2.x), bf_hi(h2.x), bf_lo(h2.y), bf_hi(h2.y)}; }
#pragma unroll
            for (int k = 0; k < 4; ++k) { const unsigned* yp = (const unsigned*)(Y + ((size_t)tok * 4 + k) * D) + lane;
#pragma unroll
                for (int j = 0; j < 4; ++j) { const int y4 = (int)yp[64 * j]; v[j].x += __builtin_amdgcn_cvt_f32_fp8(y4, 0); v[j].y += __builtin_amdgcn_cvt_f32_fp8(y4, 1); v[j].z += __builtin_amdgcn_cvt_f32_fp8(y4, 2); v[j].w += __builtin_amdgcn_cvt_f32_fp8(y4, 3); } }
#pragma unroll
            for (int j = 0; j < 4; ++j) s += (v[j].x * v[j].x + v[j].y * v[j].y) + (v[j].z * v[j].z + v[j].w * v[j].w);
            const float r = 1.0f / sqrtf(wave_sum(s) * (1.f / D) + NORM_EPS);
#pragma unroll
            for (int j = 0; j < 4; ++j) hp[64 * j] = v[j] * r * gn8[j];
        }
    }
#undef IN
#undef INC
#undef BOTH
}

#if ONE_LAUNCH
constexpr int NKERN = 1;
static const void* kern_of(int) { return (const void*)fwd_kernel<-1>; }
#else
constexpr int NKERN = 9;
static const void* kern_of(int c) {
    switch (c) { case 0: return (const void*)fwd_kernel<0>; case 1: return (const void*)fwd_kernel<1>; case 2: return (const void*)fwd_kernel<2>; case 3: return (const void*)fwd_kernel<3>; case 4: return (const void*)fwd_kernel<4>;
        case 5: return (const void*)fwd_kernel<5>; case 6: return (const void*)fwd_kernel<6>; case 7: return (const void*)fwd_kernel<7>; default: return (const void*)fwd_kernel<8>; }
}
#endif
extern "C" void kernel_launch(void* const* d_in, const int* in_sizes, int n_in, void* d_out, int out_size, void* d_ws, size_t ws_size, hipStream_t stream) {
    static int grid = 0;
    if (grid == 0) {
        if (n_in != 19 || out_size != T * D || ws_size < WS_END) { fprintf(stderr, "kernel_launch: unexpected shapes (n_in %d, out %d, ws %zu)\n", n_in, out_size, ws_size); grid = -1; return; }
        for (int c = 0; c < NKERN; ++c) if (hipFuncSetAttribute(kern_of(c), hipFuncAttributeMaxDynamicSharedMemorySize, LDS_BYTES) != hipSuccess) { fprintf(stderr, "kernel_launch: hipFuncSetAttribute failed\n"); grid = -1; return; }
        int dev = 0, cus = 0, per_cu = 0;
        (void)hipGetDevice(&dev); (void)hipDeviceGetAttribute(&cus, hipDeviceAttributeMultiprocessorCount, dev);
        (void)hipOccupancyMaxActiveBlocksPerMultiprocessor(&per_cu, kern_of(0), NWAVES * 64, LDS_BYTES);
        (void)hipGetLastError();
        grid = cus > 0 ? cus : 256;
        if (grid > 256) grid = 256;
    }
    if (grid < 0) return;
    (void)hipMemsetAsync((char*)d_ws + WS_CTL, 0, CTL_ZERO_BYTES, stream);
    Args a{};
    for (int i = 0; i < 19; ++i) a.in[i] = (const float*)d_in[i];
    a.out = (float*)d_out; a.ws = (unsigned char*)d_ws;
    constexpr int NPH = 9;
#if ONE_LAUNCH
    a.ph_lo = 0; a.ph_hi = NPH;
    hipLaunchKernelGGL(fwd_kernel<-1>, dim3(grid), dim3(NWAVES * 64), LDS_BYTES, stream, a);
#else
    for (int p = 0; p < NPH; ++p) { a.ph_lo = p; a.ph_hi = p + 1; const int cls = p; void* kargs[] = {&a};
        (void)hipLaunchKernel(kern_of(cls), dim3(grid), dim3(NWAVES * 64), kargs, LDS_BYTES, stream); }
#endif
}
```
